# Optimizing an MI355X kernel written in HIP

```python
import math
import jax, jax.numpy as jnp
from jax import lax
import numpy as np

D_MODEL = 1024
BATCH = 8
SEQ = 4096
DEPTH = 4

DH = 64
QBLK = 128
NSA_HEADS = 8
NSA_GROUPS = 2
NSA_R = NSA_HEADS // NSA_GROUPS
L_CMP = 32
D_CMP = 16
CMP_HIDDEN = 128
L_SLC = 64
N_SEL = 8
WINDOW = 512
MLA_HEADS = 4
MLA_NOPE = 64
MLA_ROPE = 32
MLA_V = 64
MLA_Q_LORA = 384
MLA_KV_LORA = 128
ROPE_THETA = 10000.0
FOX_HEADS = 4
XA_HEADS = 4
MEM_LEN = 256
D_FF = 4 * D_MODEL
T5_BUCKETS = 32
T5_MAX_DIST = 128
NSA_W = NSA_HEADS * DH
NSA_KV = NSA_GROUPS * DH
MLA_W = MLA_HEADS * MLA_V
FOX_W = FOX_HEADS * DH
XA_W = XA_HEADS * DH
IN_SIZES = (NSA_W, NSA_KV, NSA_KV, NSA_KV, NSA_KV, NSA_KV, NSA_KV, 3 * NSA_HEADS,
            MLA_Q_LORA, MLA_KV_LORA, MLA_ROPE,
            FOX_W, FOX_W, FOX_W, FOX_HEADS)
N_IN = sum(IN_SIZES)
DN_ALPHA = (2 * DEPTH) ** 0.25
DN_BETA = (8 * DEPTH) ** -0.25
LN_EPS = 1e-5
RMS_EPS = 1e-6
NEG = -1e30
FORCE = 1e4

kernel_name = 'hybrid_nsa_mla_fox_block'


def layer_norm(x, g, b):
    x32 = x.astype(jnp.float32)
    mu = jnp.mean(x32, axis=-1, keepdims=True)
    var = jnp.mean(jnp.square(x32 - mu), axis=-1, keepdims=True)
    return ((x32 - mu) * lax.rsqrt(var + LN_EPS) * g + b).astype(x.dtype)


def rms_norm(x, g):
    x32 = x.astype(jnp.float32)
    return (x32 * lax.rsqrt(jnp.mean(jnp.square(x32), axis=-1, keepdims=True) + RMS_EPS) * g).astype(x.dtype)


def rope(x, pos):
    half = x.shape[-1] // 2
    inv = ROPE_THETA ** (-jnp.arange(half, dtype=jnp.float32) / half)
    ang = pos.astype(jnp.float32)[:, None] * inv[None, :]
    cos = jnp.cos(ang)[None, :, None, :].astype(x.dtype)
    sin = jnp.sin(ang)[None, :, None, :].astype(x.dtype)
    x1, x2 = x[..., :half], x[..., half:]
    return jnp.concatenate([x1 * cos - x2 * sin, x1 * sin + x2 * cos], axis=-1)


def t5_bucket(dist):
    n = jnp.maximum(dist, 0)
    max_exact = T5_BUCKETS // 2
    nf = jnp.maximum(n, 1).astype(jnp.float32)
    large = max_exact + (jnp.log(nf / max_exact) / math.log(T5_MAX_DIST / max_exact)
                         * (T5_BUCKETS - max_exact)).astype(jnp.int32)
    large = jnp.minimum(large, T5_BUCKETS - 1)
    return jnp.where(n < max_exact, n, large)


def causal_block_attention(q, k, v, cum_log_f=None):
    B, S, H, dk = q.shape
    dv = v.shape[-1]
    nqb = S // QBLK
    scale = dk ** -0.5
    qb = q.reshape(B, nqb, QBLK, H, dk).transpose(1, 0, 2, 3, 4)
    key_pos = jnp.arange(S)
    decay_k = None if cum_log_f is None else cum_log_f.transpose(0, 2, 1)

    def one_block(args):
        i, q_i = args
        q_pos = i * QBLK + jnp.arange(QBLK)
        s = jnp.einsum('bqhd,bkhd->bhqk', q_i, k).astype(jnp.float32) * scale
        if decay_k is not None:
            decay_q = lax.dynamic_slice_in_dim(decay_k, i * QBLK, QBLK, axis=2)
            s = s + decay_q[..., None] - decay_k[:, :, None, :]
        s = jnp.where(key_pos[None, :] <= q_pos[:, None], s, NEG)
        p = jax.nn.softmax(s, axis=-1).astype(v.dtype)
        return jnp.einsum('bhqk,bkhd->bqhd', p, v)

    out = lax.map(one_block, (jnp.arange(nqb), qb))
    return out.transpose(1, 0, 2, 3, 4).reshape(B, S, H * dv)


def nsa_attention(q, k_cmp, v_cmp, k_slc, v_slc, k_win, v_win, gate_logits,
                  cmp_pe, cmp_w1, cmp_w2, t5_table):
    B, S, _ = q.shape
    G, R = NSA_GROUPS, NSA_R
    nqb = S // QBLK
    n_cmp = (S - L_CMP) // D_CMP + 1
    n_slc = S // L_SLC
    n_sel = min(N_SEL, n_slc)
    scale = DH ** -0.5
    k_cmp, v_cmp, k_slc, v_slc, k_win, v_win = [a.reshape(B, S, G, DH) for a in
                                                  (k_cmp, v_cmp, k_slc, v_slc, k_win, v_win)]

    tok_idx = jnp.arange(n_cmp)[:, None] * D_CMP + jnp.arange(L_CMP)[None, :]

    def compress(kv, pe, w1, w2):
        blocks = kv[:, tok_idx] + pe[None, None, :, None, :]
        flat = blocks.transpose(0, 1, 3, 2, 4).reshape(B, n_cmp, G, L_CMP * DH)
        return jax.nn.gelu(flat @ w1) @ w2

    kc = compress(k_cmp, cmp_pe[0], cmp_w1[0], cmp_w2[0])
    vc = compress(v_cmp, cmp_pe[1], cmp_w1[1], cmp_w2[1])
    cmp_end = jnp.arange(n_cmp) * D_CMP + (L_CMP - 1)

    c_lo = jnp.arange(n_cmp)[:, None] * D_CMP
    s_lo = jnp.arange(n_slc)[None, :] * L_SLC
    overlap = (jnp.maximum(jnp.minimum(c_lo + L_CMP, s_lo + L_SLC) - jnp.maximum(c_lo, s_lo), 0)
               .astype(jnp.float32) / D_CMP)

    ks_blk = k_slc.reshape(B, n_slc, L_SLC, G, DH).transpose(0, 3, 1, 2, 4)
    vs_blk = v_slc.reshape(B, n_slc, L_SLC, G, DH).transpose(0, 3, 1, 2, 4)
    kw_pad = jnp.pad(k_win, ((0, 0), (WINDOW, 0), (0, 0), (0, 0)))
    vw_pad = jnp.pad(v_win, ((0, 0), (WINDOW, 0), (0, 0), (0, 0)))

    qb = q.reshape(B, nqb, QBLK, G, R, DH).transpose(1, 0, 3, 4, 2, 5)
    gb = jax.nn.sigmoid(gate_logits).reshape(B, nqb, QBLK, G, R, 3).transpose(1, 0, 3, 4, 2, 5)
    bias_tab = t5_table.reshape(T5_BUCKETS, G, R).transpose(1, 2, 0)
    b_idx = jnp.arange(B)[:, None, None, None]
    g_idx = jnp.arange(G)[None, :, None, None]
    g5 = jnp.arange(G)[None, :, None, None, None]
    r5 = jnp.arange(R)[None, None, :, None, None]
    blk_ids = jnp.arange(n_slc)

    def one_block(args):
        i, q_i, g_i = args
        t = i * QBLK + jnp.arange(QBLK)
        dist_c = t[:, None] - cmp_end[None, :]
        valid_c = dist_c >= 0
        s_c = (jnp.einsum('bgrqd,bcgd->bgrqc', q_i, kc).astype(jnp.float32) * scale
               + bias_tab[:, :, t5_bucket(dist_c)])
        p_c = jax.nn.softmax(jnp.where(valid_c, s_c, NEG), axis=-1) * valid_c
        o_c = jnp.einsum('bgrqc,bcgd->bgrqd', p_c.astype(vc.dtype), vc)
        imp = jnp.einsum('bgrqc,cn->bgqn', p_c, overlap)
        cur = t // L_SLC
        forced = ((blk_ids[None, :] == 0) | (blk_ids[None, :] == cur[:, None])
                  | (blk_ids[None, :] == cur[:, None] - 1))
        causal_blk = blk_ids[None, :] * L_SLC <= t[:, None]
        imp = jnp.where(causal_blk, imp + FORCE * forced, NEG)
        _, sel = lax.top_k(imp, n_sel)
        k_sel = ks_blk[b_idx, g_idx, sel].reshape(B, G, QBLK, n_sel * L_SLC, DH)
        v_sel = vs_blk[b_idx, g_idx, sel].reshape(B, G, QBLK, n_sel * L_SLC, DH)
        pos_sel = (sel[..., None] * L_SLC + jnp.arange(L_SLC)).reshape(B, G, QBLK, n_sel * L_SLC)
        dist_s = t[:, None] - pos_sel
        s_s = (jnp.einsum('bgrqd,bgqkd->bgrqk', q_i, k_sel).astype(jnp.float32) * scale
               + bias_tab[g5, r5, t5_bucket(dist_s)[:, :, None]])
        p_s = jax.nn.softmax(jnp.where((dist_s >= 0)[:, :, None], s_s, NEG), axis=-1)
        o_s = jnp.einsum('bgrqk,bgqkd->bgrqd', p_s.astype(v_sel.dtype), v_sel)
        pos_w = i * QBLK - WINDOW + jnp.arange(WINDOW + QBLK)
        dist_w = t[:, None] - pos_w[None, :]
        valid_w = (dist_w >= 0) & (dist_w < WINDOW) & (pos_w[None, :] >= 0)
        k_w = lax.dynamic_slice_in_dim(kw_pad, i * QBLK, WINDOW + QBLK, axis=1)
        v_w = lax.dynamic_slice_in_dim(vw_pad, i * QBLK, WINDOW + QBLK, axis=1)
        s_w = (jnp.einsum('bgrqd,bkgd->bgrqk', q_i, k_w).astype(jnp.float32) * scale
               + bias_tab[:, :, t5_bucket(dist_w)])
        p_w = jax.nn.softmax(jnp.where(valid_w, s_w, NEG), axis=-1)
        o_w = jnp.einsum('bgrqk,bkgd->bgrqd', p_w.astype(v_w.dtype), v_w)
        return g_i[..., 0:1] * o_c + g_i[..., 1:2] * o_s + g_i[..., 2:3] * o_w

    out = lax.map(one_block, (jnp.arange(nqb), qb, gb))
    return out.transpose(1, 0, 4, 2, 3, 5).reshape(B, S, NSA_W)


def mla_attention(c_q, c_kv, k_rope, q_norm, w_uq, kv_norm, w_ukv):
    B, S, _ = c_q.shape
    pos = jnp.arange(S)
    q = (rms_norm(c_q, q_norm) @ w_uq).reshape(B, S, MLA_HEADS, MLA_NOPE + MLA_ROPE)
    q = jnp.concatenate([q[..., :MLA_NOPE], rope(q[..., MLA_NOPE:], pos)], axis=-1)
    kv = (rms_norm(c_kv, kv_norm) @ w_ukv).reshape(B, S, MLA_HEADS, MLA_NOPE + MLA_V)
    k_r = jnp.broadcast_to(rope(k_rope[:, :, None, :], pos), (B, S, MLA_HEADS, MLA_ROPE))
    k = jnp.concatenate([kv[..., :MLA_NOPE], k_r], axis=-1)
    return causal_block_attention(q, k, kv[..., MLA_NOPE:])


def fox_attention(q, k, v, f_logit, b_f):
    B, S, _ = q.shape
    shp = (B, S, FOX_HEADS, DH)
    cum = jnp.cumsum(jax.nn.log_sigmoid((f_logit + b_f).astype(jnp.float32)), axis=1)
    return causal_block_attention(q.reshape(shp), k.reshape(shp), v.reshape(shp), cum_log_f=cum)


def hybrid_mixer(h, w_in, cmp_pe, cmp_w1, cmp_w2, t5_table, q_norm, w_uq, kv_norm, w_ukv,
                 b_f, w_gate, w_br_nsa, w_br_mla, w_br_fox, w_out):
    B, S, _ = h.shape
    split_points = np.cumsum(IN_SIZES)[:-1].tolist()
    (nq, nkc, nvc, nks, nvs, nkw, nvw, ngate,
     cq, ckv, kr, fq, fk, fv, ff) = jnp.split(h @ w_in, split_points, axis=-1)
    o_nsa = nsa_attention(nq, nkc, nvc, nks, nvs, nkw, nvw, ngate, cmp_pe, cmp_w1, cmp_w2, t5_table)
    o_mla = mla_attention(cq, ckv, kr, q_norm, w_uq, kv_norm, w_ukv)
    o_fox = fox_attention(fq, fk, fv, ff, b_f)
    gates = jax.nn.sigmoid(h @ w_gate).reshape(B, S, 3, D_MODEL)
    merged = (gates[:, :, 0] * (o_nsa @ w_br_nsa) + gates[:, :, 1] * (o_mla @ w_br_mla)
              + gates[:, :, 2] * (o_fox @ w_br_fox))
    return merged @ w_out


def memory_cross_attention(x, mem, w_q, w_kv, w_o):
    B, S, _ = x.shape
    M = mem.shape[1]
    q = (x @ w_q).reshape(B, S, XA_HEADS, DH)
    kv = (mem @ w_kv).reshape(B, M, 2, XA_HEADS, DH)
    k, v = kv[:, :, 0], kv[:, :, 1]
    s = jnp.einsum('bqhd,bmhd->bhqm', q, k).astype(jnp.float32) * (DH ** -0.5)
    p = jax.nn.softmax(s, axis=-1).astype(v.dtype)
    o = jnp.einsum('bhqm,bmhd->bqhd', p, v).reshape(B, S, XA_W)
    return o @ w_o


def setup_inputs(seed: int = 0) -> dict:
    key = jax.random.key(seed)
    ks = jax.random.split(key, 32)
    L = DEPTH

    def dense(k, shape, fan_in, scale=1.0):
        return jax.random.normal(k, shape, jnp.float32) * (scale * fan_in ** -0.5)

    def normal(k, shape, scale=1.0):
        return jax.random.normal(k, shape, jnp.float32) * scale

    return {
        'x': normal(ks[0], (BATCH, SEQ, D_MODEL)),
        'mem': normal(ks[1], (BATCH, MEM_LEN, D_MODEL)),
        'w_in': dense(ks[2], (L, D_MODEL, N_IN), D_MODEL),
        'cmp_pe': normal(ks[3], (L, 2, L_CMP, DH), 0.1),
        'cmp_w1': dense(ks[4], (L, 2, L_CMP * DH, CMP_HIDDEN), L_CMP * DH),
        'cmp_w2': dense(ks[5], (L, 2, CMP_HIDDEN, DH), CMP_HIDDEN),
        't5_table': normal(ks[6], (T5_BUCKETS, NSA_HEADS), 0.5),
        'mla_q_norm': 1.0 + normal(ks[7], (L, MLA_Q_LORA), 0.02),
        'mla_w_uq': dense(ks[8], (L, MLA_Q_LORA, MLA_HEADS * (MLA_NOPE + MLA_ROPE)), MLA_Q_LORA),
        'mla_kv_norm': 1.0 + normal(ks[9], (L, MLA_KV_LORA), 0.02),
        'mla_w_ukv': dense(ks[10], (L, MLA_KV_LORA, MLA_HEADS * (MLA_NOPE + MLA_V)), MLA_KV_LORA),
        'fox_b_f': jax.random.uniform(ks[11], (L, FOX_HEADS), jnp.float32, 1.0, 6.0),
        'w_gate': dense(ks[12], (L, D_MODEL, 3 * D_MODEL), D_MODEL),
        'w_br_nsa': dense(ks[13], (L, NSA_W, D_MODEL), NSA_W),
        'w_br_mla': dense(ks[14], (L, MLA_W, D_MODEL), MLA_W),
        'w_br_fox': dense(ks[15], (L, FOX_W, D_MODEL), FOX_W),
        'w_mix_out': dense(ks[16], (L, D_MODEL, D_MODEL), D_MODEL, DN_BETA),
        'xa_w_q': dense(ks[17], (L, D_MODEL, XA_W), D_MODEL),
        'xa_w_kv': dense(ks[18], (L, D_MODEL, 2 * XA_W), D_MODEL),
        'xa_w_o': dense(ks[19], (L, XA_W, D_MODEL), XA_W, DN_BETA),
        'mlp_w_up': dense(ks[20], (L, D_MODEL, D_FF), D_MODEL),
        'mlp_w_down': dense(ks[21], (L, D_FF, D_MODEL), D_FF, DN_BETA),
        'ln_g': 1.0 + normal(ks[22], (L, 3, D_MODEL), 0.02),
        'ln_b': normal(ks[23], (L, 3, D_MODEL), 0.02),
    }


def reference(x, mem, w_in, cmp_pe, cmp_w1, cmp_w2, t5_table, mla_q_norm, mla_w_uq, mla_kv_norm,
              mla_w_ukv, fox_b_f, w_gate, w_br_nsa, w_br_mla, w_br_fox, w_mix_out, xa_w_q, xa_w_kv,
              xa_w_o, mlp_w_up, mlp_w_down, ln_g, ln_b):
    for l in range(DEPTH):
        y = hybrid_mixer(x, w_in[l], cmp_pe[l], cmp_w1[l], cmp_w2[l], t5_table, mla_q_norm[l],
                         mla_w_uq[l], mla_kv_norm[l], mla_w_ukv[l], fox_b_f[l], w_gate[l],
                         w_br_nsa[l], w_br_mla[l], w_br_fox[l], w_mix_out[l])
        x = layer_norm(DN_ALPHA * x + y, ln_g[l, 0], ln_b[l, 0])
        y = memory_cross_attention(x, mem, xa_w_q[l], xa_w_kv[l], xa_w_o[l])
        x = layer_norm(DN_ALPHA * x + y, ln_g[l, 1], ln_b[l, 1])
        y = jnp.square(jax.nn.relu(x @ mlp_w_up[l])) @ mlp_w_down[l]
        x = layer_norm(DN_ALPHA * x + y, ln_g[l, 2], ln_b[l, 2])
    return x
```

```cpp
#include <hip/hip_runtime.h>
#include <hip/hip_cooperative_groups.h>
#include <cstdio>
#include <cstdint>
namespace cg = cooperative_groups;

typedef unsigned short bf16;
typedef __attribute__((ext_vector_type(8))) short bf16x8;
typedef __attribute__((ext_vector_type(4))) float f32x4;
typedef __attribute__((ext_vector_type(2))) __bf16 bf2_t;
typedef __attribute__((ext_vector_type(4))) unsigned u32x4;
typedef unsigned long long u64;
typedef __attribute__((ext_vector_type(2))) unsigned u32x2;

#ifndef EXTRA_SYNC
#define EXTRA_SYNC 0
#endif
#ifndef PROBE_NOSTORE
#define PROBE_NOSTORE 0
#endif
#ifndef USE_RING
#define USE_RING 0
#endif
#if USE_RING
#define GEMM_ML gemm_mainloop_r
#else
#define GEMM_ML gemm_mainloop_g
#endif
#ifndef SWZ_MODE
#define SWZ_MODE 0
#endif
#ifndef KROT
#define KROT 0
#endif
#ifndef DEEP_FRAG
#define DEEP_FRAG 1
#endif
#ifndef REP_ATTN
#define REP_ATTN 1
#endif
#ifndef REP_PROJ
#define REP_PROJ 1
#endif
#ifndef REP_UP
#define REP_UP 1
#endif
#ifndef REP_MERGE
#define REP_MERGE 1
#endif
#ifndef REP_DERIVED
#define REP_DERIVED 1
#endif
#ifndef REP_PREP
#define REP_PREP 1
#endif
#ifndef REP_XA
#define REP_XA 1
#endif
#define DEVI __device__ __forceinline__

DEVI int opaque_tid() { int t = __builtin_amdgcn_workitem_id_x(); asm volatile("" : "+v"(t)); return t; }
DEVI char* opaque_ptr(char* p) { asm volatile("" : "+s"(p)); return p; }
DEVI float opq(float x) { asm("" : "+v"(x)); return x; }
DEVI unsigned pack2(float a, float b) { bf2_t v; v[0] = (__bf16)a; v[1] = (__bf16)b; return __builtin_bit_cast(unsigned, v); }
DEVI bf16 f2bf(float a) { return __builtin_bit_cast(unsigned short, (__bf16)a); }
DEVI float bf2f(unsigned u) { return __uint_as_float(u << 16); }
DEVI float fexp2(float x) { return __builtin_amdgcn_exp2f(x); }
DEVI float sigmoidf(float x) { return 1.f / (1.f + __expf(-x)); }

constexpr int T_TOK = 32768;
constexpr int PROJ_LD = 2688;
constexpr float LOG2E = 1.4426950408889634f;
constexpr float DN_ALPHA = 1.681792830507429f;

constexpr size_t al256(size_t x) { return (x + 255) & ~(size_t)255; }
constexpr size_t OFF_BAR = 0;
constexpr size_t OFF_CNT = 14336;
constexpr size_t OFF_WIN = 16384;
constexpr size_t OFF_WG = OFF_WIN + (size_t)2688 * 1024 * 2;
constexpr size_t OFF_WBN = OFF_WG + (size_t)3072 * 1024 * 2;
constexpr size_t OFF_WBM = OFF_WBN + (size_t)1024 * 512 * 2;
constexpr size_t OFF_WBF = OFF_WBM + (size_t)1024 * 256 * 2;
constexpr size_t OFF_WOUT = OFF_WBF + (size_t)1024 * 256 * 2;
constexpr size_t OFF_WXQ = OFF_WOUT + (size_t)1024 * 1024 * 2;
constexpr size_t OFF_WXKV = OFF_WXQ + (size_t)256 * 1024 * 2;
constexpr size_t OFF_WXO = OFF_WXKV + (size_t)512 * 1024 * 2;
constexpr size_t OFF_WUP = OFF_WXO + (size_t)1024 * 256 * 2;
constexpr size_t OFF_WDN = OFF_WUP + (size_t)4096 * 1024 * 2;
constexpr size_t OFF_WUQ = OFF_WDN + (size_t)4096 * 1024 * 2;
constexpr size_t OFF_WUKV = OFF_WUQ + (size_t)384 * 384 * 2;
constexpr size_t OFF_WC1 = OFF_WUKV + (size_t)512 * 128 * 2;
constexpr size_t OFF_WC2 = OFF_WC1 + (size_t)2 * 128 * 2048 * 2;
constexpr size_t OFF_B1 = OFF_WC2 + (size_t)2 * 64 * 128 * 2;
constexpr size_t OFF_XB = al256(OFF_B1 + 2 * 32 * 128 * 4);
constexpr size_t OFF_MEMB = OFF_XB + (size_t)32768 * 1024 * 2;
constexpr size_t OFF_PROJ = OFF_MEMB + (size_t)2048 * 1024 * 2;
constexpr size_t OFF_OCAT = OFF_PROJ + (size_t)32768 * 2688 * 2;
constexpr size_t OFF_QMLA = OFF_OCAT + (size_t)32768 * 1024 * 2;
constexpr size_t OFF_KMLA = OFF_QMLA + (size_t)32768 * 384 * 2;
constexpr size_t OFF_VMT = OFF_KMLA + (size_t)32768 * 384 * 2;
constexpr size_t OFF_VST = OFF_VMT + (size_t)8 * 4 * 64 * 4096 * 2;
constexpr size_t OFF_VWT = OFF_VST + (size_t)8 * 2 * 64 * 4096 * 2;
constexpr size_t OFF_VFT = OFF_VWT + (size_t)8 * 2 * 64 * 4096 * 2;
constexpr size_t OFF_KC = OFF_VFT + (size_t)8 * 4 * 64 * 4096 * 2;
constexpr size_t OFF_VCT = OFF_KC + (size_t)16 * 256 * 64 * 2;
constexpr size_t OFF_GAUX = OFF_VCT + (size_t)16 * 256 * 64 * 2;
constexpr size_t OFF_FLOG = OFF_GAUX + (size_t)32768 * 32 * 4;
constexpr size_t OFF_CUM = OFF_FLOG + (size_t)32768 * 4 * 4;
constexpr size_t OFF_KXA = OFF_CUM + (size_t)32768 * 4 * 4;
constexpr size_t OFF_VXA = OFF_KXA + (size_t)2048 * 256 * 2;
constexpr size_t OFF_XQ = OFF_VXA + (size_t)2048 * 256 * 2;
constexpr size_t OFF_OXA = OFF_XQ + (size_t)32768 * 256 * 2;
constexpr size_t OFF_STATS = OFF_OXA + (size_t)32768 * 256 * 2;
constexpr size_t WS_TOTAL = OFF_STATS + (size_t)32768 * 2 * 4;
constexpr size_t OFF_HID = OFF_PROJ;
constexpr size_t OFF_MERGED = OFF_PROJ;

constexpr int LDS_ROW = 144;
constexpr int TILE_B = 128 * LDS_ROW;
constexpr int SM_ROWSS = 2 * TILE_B;
constexpr int ARING = 66560;
constexpr int XBST = 77216;
constexpr int SMEM_BYTES = XBST + 16;
constexpr int ALUT = ARING, AIMP = ALUT + 2176, ASEL = AIMP + 8192, AITEM = ASEL + 256;
template <int DK> struct RingGeo { static constexpr int AVO = DK == 64 ? 8192 : 12288, ACO = AVO + 8192, STRIDE = DK == 64 ? 16640 : 20992; };
static_assert(4 * 16640 <= ARING && 3 * 20992 <= ARING, "ring");
static_assert(AITEM + 16 <= XBST, "LDS map");


#define XB_TMO      128
#define XB_XCNT(j)  (256  + 64 * (j))
#define XB_XSUB(j)  (1280 + 64 * (j))
#define XB_XGEN(j)  (2304 + 64 * (j))
#define XB_TOP      3328
#define XB_TOPGEN   3392
#define XCD_BAR_WORDS 3456
#define XB_SPIN_CAP (1u << 18)
#define LAS __attribute__((address_space(3)))
DEVI unsigned xb_ld(unsigned* p) { return __hip_atomic_load(p, __ATOMIC_RELAXED, __HIP_MEMORY_SCOPE_AGENT); }
DEVI unsigned xb_add(unsigned* p, unsigned v) { return __hip_atomic_fetch_add(p, v, __ATOMIC_RELAXED, __HIP_MEMORY_SCOPE_AGENT); }
DEVI unsigned xb_xcc_id() { return (unsigned)__builtin_amdgcn_s_getreg((3 << 11) | 20) & 0xFu; }
#define XB_SPIN(cond, bar) do { unsigned _sp = 0; while (cond) { __builtin_amdgcn_s_sleep(1); \
    if ((++_sp & 255u) == 0u) { if (xb_ld(&(bar)[XB_TMO])) break; if (_sp > XB_SPIN_CAP) { atomicAdd(&(bar)[XB_TMO], 1u); break; } } } } while (0)
struct XcdBarrier { unsigned* bar; unsigned x; volatile LAS unsigned* st; };
DEVI XcdBarrier xcd_barrier_post(unsigned* bar, volatile LAS unsigned* st) {
  XcdBarrier b; b.bar = bar; b.x = xb_xcc_id(); b.st = st;
  if (opaque_tid() == 0) (void)xb_add(&bar[XB_XCNT(b.x)], 1u);
  return b;
}
DEVI void xcd_barrier_complete(unsigned* bar, unsigned x, unsigned& nloc, unsigned& nx) {
  const unsigned G = gridDim.x * gridDim.y * gridDim.z;
  unsigned sum, cnt, mine, sp = 0u;
  for (;;) {
    sum = 0u; cnt = 0u; mine = 0u;
#pragma unroll
    for (unsigned j = 0; j < 16; ++j) { const unsigned c = xb_ld(&bar[XB_XCNT(j)]); sum += c; cnt += (c > 0u) ? 1u : 0u; mine = (j == x) ? c : mine; }
    if (sum == G) break;
    __builtin_amdgcn_s_sleep(1);
    if ((++sp & 255u) == 0u) { if (xb_ld(&bar[XB_TMO])) break; if (sp > XB_SPIN_CAP) { atomicAdd(&bar[XB_TMO], 1u); break; } }
  }
  nloc = mine > 0u ? mine : 1u; nx = cnt > 0u ? cnt : 1u;
}
DEVI void xcd_barrier(const XcdBarrier& b) {
  asm volatile("s_waitcnt vmcnt(0)" ::: "memory");
  __syncthreads();
  if (opaque_tid() == 0) {
    unsigned* bar = b.bar;
    __builtin_amdgcn_s_waitcnt(0);
    unsigned nloc = b.st[0], nx = b.st[1];
    if (nloc == 0u) { xcd_barrier_complete(bar, b.x, nloc, nx); b.st[0] = nloc; b.st[1] = nx; }
    const unsigned old = xb_add(&bar[XB_XSUB(b.x)], 1u);
    const unsigned gen = old / nloc;
    if (old + 1u == (gen + 1u) * nloc) {
      __builtin_amdgcn_fence(__ATOMIC_RELEASE, "agent");
      asm volatile("s_waitcnt vmcnt(0)" ::: "memory");
      const unsigned og = xb_add(&bar[XB_TOP], 1u);
      const unsigned tg = og / nx;
      if (og + 1u == (tg + 1u) * nx) xb_add(&bar[XB_TOPGEN], 1u);
      else XB_SPIN(xb_ld(&bar[XB_TOPGEN]) == tg, bar);
      __builtin_amdgcn_fence(__ATOMIC_ACQUIRE, "agent");
      xb_add(&bar[XB_XGEN(b.x)], 1u);
      asm volatile("s_waitcnt vmcnt(0)" ::: "memory");
    } else {
      XB_SPIN(xb_ld(&bar[XB_XGEN(b.x)]) == gen, bar);
      __builtin_amdgcn_fence(__ATOMIC_ACQUIRE, "agent");
      asm volatile("s_waitcnt vmcnt(0)" ::: "memory");
    }
  }
  __syncthreads();
}

struct Params {
  const float* in[24];
  float* out;
  char* ws;
};

__device__ const unsigned char T5BUCKET[128] = {
  0, 1, 2, 3, 4, 5, 6, 7, 8, 9, 10, 11, 12, 13, 14, 15, 16, 16, 16, 17, 17, 18, 18, 18, 19, 19, 19, 20, 20, 20, 20, 21,
  21, 21, 21, 22, 22, 22, 22, 22, 23, 23, 23, 23, 23, 23, 24, 24, 24, 24, 24, 24, 25, 25, 25, 25, 25, 25, 25, 26, 26, 26, 26, 26,
  26, 26, 26, 27, 27, 27, 27, 27, 27, 27, 27, 27, 27, 28, 28, 28, 28, 28, 28, 28, 28, 28, 28, 29, 29, 29, 29, 29, 29, 29, 29, 29,
  29, 29, 29, 30, 30, 30, 30, 30, 30, 30, 30, 30, 30, 30, 30, 30, 30, 31, 31, 31, 31, 31, 31, 31, 31, 31, 31, 31, 31, 31, 31, 31};

struct RowLinear { long ld; DEVI long operator()(int r) const { return (long)r * ld; } };
struct RowCmp {
  int colbase;
  DEVI long operator()(int r) const {
    int bg = r >> 8, c = r & 255; if (c > 254) c = 254;
    int b = bg >> 1, g = bg & 1;
    return ((long)(b * 4096 + c * 16)) * PROJ_LD + colbase + g * 64;
  }
};

DEVI float sumsq8(u32x4 v) {
  float s = 0.f;
  unsigned w[4] = {v[0], v[1], v[2], v[3]};
#pragma unroll
  for (int i = 0; i < 4; ++i) { float a = bf2f(w[i] & 0xffffu), b = __uint_as_float(w[i] & 0xffff0000u); s += a * a + b * b; }
  return s;
}

template <bool ROWSS, int NF, class ARow>
DEVI void gemm_mainloop_t(f32x4 (&acc)[4][NF], const bf16* __restrict__ A, ARow arow, int kstrideA,
                          const bf16* __restrict__ Bt, int ldb, int K, int m0, int n0, char* smem) {
  constexpr int NBI = NF;
  char* As = smem; char* Bs = smem + TILE_B;
  const int tid = opaque_tid(), lane = tid & 63, wid = tid >> 6, wr = wid >> 1, wc = wid & 1, fr = lane & 15, fq = lane >> 4;
  const int lrow = tid >> 3, lkc = tid & 7;
  unsigned aoff[4], boff[NBI];
#pragma unroll
  for (int i = 0; i < 4; ++i) aoff[i] = (unsigned)(arow(m0 + lrow + 32 * i) + lkc * 8);
#pragma unroll
  for (int i = 0; i < NBI; ++i) boff[i] = (unsigned)((n0 + lrow + 32 * i) * ldb + lkc * 8);
  u32x4 ra[4], rb[NBI];
  float ss[4] = {0.f, 0.f, 0.f, 0.f};
  const int nk = K >> 6;
#pragma unroll
  for (int i = 0; i < 4; ++i) ra[i] = *(const u32x4*)(A + aoff[i]);
#pragma unroll
  for (int i = 0; i < NBI; ++i) rb[i] = *(const u32x4*)(Bt + boff[i]);
  for (int kt = 0; kt < nk; ++kt) {
    __syncthreads();
#pragma unroll
    for (int i = 0; i < 4; ++i) {
      *(u32x4*)(As + (lrow + 32 * i) * LDS_ROW + lkc * 16) = ra[i];
      if (ROWSS) ss[i] += sumsq8(ra[i]);
    }
#pragma unroll
    for (int i = 0; i < NBI; ++i) *(u32x4*)(Bs + (lrow + 32 * i) * LDS_ROW + lkc * 16) = rb[i];
    __syncthreads();
    if (kt + 1 < nk) {
      const unsigned ka = (unsigned)((kt + 1) * kstrideA), kb = (unsigned)((kt + 1) * 64);
#pragma unroll
      for (int i = 0; i < 4; ++i) ra[i] = *(const u32x4*)(A + (aoff[i] + ka));
#pragma unroll
      for (int i = 0; i < NBI; ++i) rb[i] = *(const u32x4*)(Bt + (boff[i] + kb));
    }
#pragma unroll
    for (int ks = 0; ks < 2; ++ks) {
      bf16x8 af[4], bfr[NF];
#pragma unroll
      for (int m = 0; m < 4; ++m) af[m] = *(const bf16x8*)(As + (wr * 64 + m * 16 + fr) * LDS_ROW + ks * 64 + fq * 16);
#pragma unroll
      for (int n = 0; n < NF; ++n) bfr[n] = *(const bf16x8*)(Bs + (wc * 16 * NF + n * 16 + fr) * LDS_ROW + ks * 64 + fq * 16);
#pragma unroll
      for (int m = 0; m < 4; ++m)
#pragma unroll
        for (int n = 0; n < NF; ++n) acc[m][n] = __builtin_amdgcn_mfma_f32_16x16x32_bf16(af[m], bfr[n], acc[m][n], 0, 0, 0);
    }
  }
  if (ROWSS) {
    float* rowss = (float*)(smem + SM_ROWSS);
#pragma unroll
    for (int i = 0; i < 4; ++i) {
      float s = ss[i];
      s += __shfl_xor(s, 1); s += __shfl_xor(s, 2); s += __shfl_xor(s, 4);
      if (lkc == 0) rowss[lrow + 32 * i] = s;
    }
    __syncthreads();
  }
}
template <bool ROWSS, class ARow>
DEVI void gemm_mainloop(f32x4 (&acc)[4][4], const bf16* __restrict__ A, ARow arow, int kstrideA,
                        const bf16* __restrict__ Bt, int ldb, int K, int m0, int n0, char* smem) {
  gemm_mainloop_t<ROWSS, 4>(acc, A, arow, kstrideA, Bt, ldb, K, m0, n0, smem);
}

DEVI int k_rot(int mt, int nt, int nk) { return (((mt & 7) + (nt & 7)) & 7) * nk >> 3; }

template <int NF, class ARow>
DEVI void gemm_prefetch0(const bf16* __restrict__ A, ARow arow, const bf16* __restrict__ Bt, int ldb, int m0, int n0, char* smem, int koff = 0) {
  const int tid = opaque_tid();
  const int lrow = tid >> 3, lpos = tid & 7;
  const int gch = (lpos ^ (lrow & 7)) * 8 + koff * 64;
  char* ab = smem + tid * 16;
#pragma unroll
  for (int i = 0; i < 4; ++i)
    __builtin_amdgcn_global_load_lds((const unsigned*)(A + (unsigned)(arow(m0 + lrow + 32 * i) + gch)), (unsigned*)(ab + i * 4096), 16, 0, 0);
#pragma unroll
  for (int i = 0; i < NF; ++i)
    __builtin_amdgcn_global_load_lds((const unsigned*)(Bt + (unsigned)((n0 + lrow + 32 * i) * ldb + gch)), (unsigned*)(ab + 16384 + i * 4096), 16, 0, 0);
}

template <int NF, bool SWAP, class ARow, bool PRE = false, bool DEEP = false>
DEVI void gemm_mainloop_g(f32x4 (&acc)[4][NF], const bf16* __restrict__ A, ARow arow, int kstrideA,
                          const bf16* __restrict__ Bt, int ldb, int K, int m0, int n0, char* smem, int koff = 0) {
  const int tid = opaque_tid(), lane = tid & 63, wid = tid >> 6, wr = wid >> 1, wc = wid & 1, fr = lane & 15, fq = lane >> 4;
  const int lrow = tid >> 3, lpos = tid & 7;
  const int gch = (lpos ^ (lrow & 7)) * 8;
  unsigned aoff[4], boff[NF];
#pragma unroll
  for (int i = 0; i < 4; ++i) aoff[i] = (unsigned)(arow(m0 + lrow + 32 * i) + gch);
#pragma unroll
  for (int i = 0; i < NF; ++i) boff[i] = (unsigned)((n0 + lrow + 32 * i) * ldb + gch);
  const int nk = K >> 6;
  if (!PRE) __syncthreads();
#define GL_ISSUE(KT, BUF)                                                                                  \
  {                                                                                                        \
    char* ab = smem + (BUF) * 32768 + tid * 16;                                                            \
    const int kr_ = ((KT) + koff) & (nk - 1);                                                              \
    const unsigned ka = (unsigned)(kr_ * kstrideA), kb = (unsigned)(kr_ * 64);                             \
    _Pragma("unroll") for (int i = 0; i < 4; ++i)                                                          \
      __builtin_amdgcn_global_load_lds((const unsigned*)(A + (aoff[i] + ka)), (unsigned*)(ab + i * 4096), 16, 0, 0); \
    _Pragma("unroll") for (int i = 0; i < NF; ++i)                                                         \
      __builtin_amdgcn_global_load_lds((const unsigned*)(Bt + (boff[i] + kb)), (unsigned*)(ab + 16384 + i * 4096), 16, 0, 0); \
  }
  if (!PRE) GL_ISSUE(0, 0)
  asm volatile("s_waitcnt vmcnt(0)" ::: "memory");
  __syncthreads();
  const int swz = fr & 7;
  for (int kt = 0; kt < nk; ++kt) {
    if (kt + 1 < nk) GL_ISSUE(kt + 1, (kt + 1) & 1)
    const char* As = smem + (kt & 1) * 32768;
    const char* Bs = As + 16384;
    if (DEEP) {
    bf16x8 af[2][4], bfr[2][NF];
#pragma unroll
    for (int ks = 0; ks < 2; ++ks) {
      const int co = ((ks * 4 + fq) ^ swz) * 16;
#pragma unroll
      for (int m = 0; m < 4; ++m) af[ks][m] = *(const bf16x8*)(As + (wr * 64 + m * 16 + fr) * 128 + co);
#pragma unroll
      for (int n = 0; n < NF; ++n) bfr[ks][n] = *(const bf16x8*)(Bs + (wc * 16 * NF + n * 16 + fr) * 128 + co);
    }
    __builtin_amdgcn_s_setprio(1);
#pragma unroll
    for (int ks = 0; ks < 2; ++ks)
#pragma unroll
      for (int m = 0; m < 4; ++m)
#pragma unroll
        for (int n = 0; n < NF; ++n) {
          if (SWAP) acc[m][n] = __builtin_amdgcn_mfma_f32_16x16x32_bf16(bfr[ks][n], af[ks][m], acc[m][n], 0, 0, 0);
          else acc[m][n] = __builtin_amdgcn_mfma_f32_16x16x32_bf16(af[ks][m], bfr[ks][n], acc[m][n], 0, 0, 0);
        }
    __builtin_amdgcn_s_setprio(0);
    __builtin_amdgcn_sched_group_barrier(0x100, 4 + NF, 0);
#pragma unroll
    for (int i = 0; i < 4 + NF; ++i) { __builtin_amdgcn_sched_group_barrier(0x008, 2, 0); __builtin_amdgcn_sched_group_barrier(0x100, 1, 0); }
    __builtin_amdgcn_sched_group_barrier(0x008, 8 * NF - 2 * (4 + NF), 0);
    } else {
#pragma unroll
    for (int ks = 0; ks < 2; ++ks) {
      const int co = ((ks * 4 + fq) ^ swz) * 16;
      bf16x8 af[4], bfr[NF];
#pragma unroll
      for (int m = 0; m < 4; ++m) af[m] = *(const bf16x8*)(As + (wr * 64 + m * 16 + fr) * 128 + co);
#pragma unroll
      for (int n = 0; n < NF; ++n) bfr[n] = *(const bf16x8*)(Bs + (wc * 16 * NF + n * 16 + fr) * 128 + co);
      __builtin_amdgcn_s_setprio(1);
#pragma unroll
      for (int m = 0; m < 4; ++m)
#pragma unroll
        for (int n = 0; n < NF; ++n) {
          if (SWAP) acc[m][n] = __builtin_amdgcn_mfma_f32_16x16x32_bf16(bfr[n], af[m], acc[m][n], 0, 0, 0);
          else acc[m][n] = __builtin_amdgcn_mfma_f32_16x16x32_bf16(af[m], bfr[n], acc[m][n], 0, 0, 0);
        }
      __builtin_amdgcn_s_setprio(0);
    }
    }
    asm volatile("s_waitcnt vmcnt(0)" ::: "memory");
    __syncthreads();
  }
#undef GL_ISSUE
}

template <int NF, bool SWAP, class ARow>
DEVI void gemm_mainloop_r(f32x4 (&acc)[4][NF], const bf16* __restrict__ A, ARow arow, int kstrideA,
                          const bf16* __restrict__ Bt, int ldb, int K, int m0, int n0, char* smem) {
  constexpr int NBI = NF / 2;
  const int tid = opaque_tid(), lane = tid & 63, wid = tid >> 6, wr = wid >> 1, wc = wid & 1, fr = lane & 15, fq = lane >> 4;
  const int lrow = tid >> 2, lpos = tid & 3;
  const int gch = (lpos ^ ((4 - ((lrow >> 2) & 3)) & 3)) * 8;
  unsigned aoff[2], boff[NBI];
#pragma unroll
  for (int i = 0; i < 2; ++i) aoff[i] = (unsigned)(arow(m0 + lrow + 64 * i) + gch);
#pragma unroll
  for (int i = 0; i < NBI; ++i) boff[i] = (unsigned)((n0 + lrow + 64 * i) * ldb + gch);
  const int nh = K >> 5;
  __syncthreads();
#define GR_ISSUE(H)                                                                                        \
  {                                                                                                        \
    char* ab = smem + ((H) & 3) * 16384 + tid * 16;                                                        \
    const unsigned ka = (unsigned)(((H) >> 1) * kstrideA + ((H) & 1) * 32), kb = (unsigned)((H) * 32);     \
    _Pragma("unroll") for (int i = 0; i < 2; ++i)                                                          \
      __builtin_amdgcn_global_load_lds((const unsigned*)(A + (aoff[i] + ka)), (unsigned*)(ab + i * 4096), 16, 0, 0); \
    _Pragma("unroll") for (int i = 0; i < NBI; ++i)                                                        \
      __builtin_amdgcn_global_load_lds((const unsigned*)(Bt + (boff[i] + kb)), (unsigned*)(ab + 8192 + i * 4096), 16, 0, 0); \
  }
  GR_ISSUE(0) GR_ISSUE(1) GR_ISSUE(2)
  const int co = (fq ^ ((4 - ((fr >> 2) & 3)) & 3)) * 16;
  for (int h = 0; h < nh; ++h) {
    if (h + 2 < nh) { if (NF == 4) asm volatile("s_waitcnt vmcnt(8)" ::: "memory"); else asm volatile("s_waitcnt vmcnt(6)" ::: "memory"); }
    else if (h + 1 < nh) { if (NF == 4) asm volatile("s_waitcnt vmcnt(4)" ::: "memory"); else asm volatile("s_waitcnt vmcnt(3)" ::: "memory"); }
    else asm volatile("s_waitcnt vmcnt(0)" ::: "memory");
    __builtin_amdgcn_s_barrier();
    if (h + 3 < nh) GR_ISSUE(h + 3)
    const char* As = smem + (h & 3) * 16384;
    const char* Bs = As + 8192;
    bf16x8 af[4], bfr[NF];
#pragma unroll
    for (int m = 0; m < 4; ++m) af[m] = *(const bf16x8*)(As + (wr * 64 + m * 16 + fr) * 64 + co);
#pragma unroll
    for (int n = 0; n < NF; ++n) bfr[n] = *(const bf16x8*)(Bs + (wc * 16 * NF + n * 16 + fr) * 64 + co);
#pragma unroll
    for (int m = 0; m < 4; ++m)
#pragma unroll
      for (int n = 0; n < NF; ++n) {
        if (SWAP) acc[m][n] = __builtin_amdgcn_mfma_f32_16x16x32_bf16(bfr[n], af[m], acc[m][n], 0, 0, 0);
        else acc[m][n] = __builtin_amdgcn_mfma_f32_16x16x32_bf16(af[m], bfr[n], acc[m][n], 0, 0, 0);
      }
  }
#undef GR_ISSUE
  __syncthreads();
}

DEVI void zero_acc(f32x4 (&acc)[4][4]) {
#pragma unroll
  for (int m = 0; m < 4; ++m)
#pragma unroll
    for (int n = 0; n < 4; ++n) acc[m][n] = f32x4{0.f, 0.f, 0.f, 0.f};
}

DEVI void tile_swz(int t, int MT, int NT, int& mt, int& nt) {
#if SWZ_MODE == 1
  mt = t / NT; nt = t - mt * NT; return;
#elif SWZ_MODE == 2
  nt = t / MT; mt = t - nt * MT; return;
#endif
  int per = (MT * NT) >> 3;
  int v = (t & 7) * per + (t >> 3);
  int band = v / (8 * NT);
  int w = v - band * 8 * NT;
  mt = band * 8 + (w & 7);
  nt = w >> 3;
}

DEVI void store_rm(const f32x4 (&acc)[4][4], bf16* dst, long ld, int m0, int n0) {
  const int tid = opaque_tid(), lane = tid & 63, wid = tid >> 6, wr = wid >> 1, wc = wid & 1, fr = lane & 15, fq = lane >> 4;
#pragma unroll
  for (int m = 0; m < 4; ++m)
#pragma unroll
    for (int j = 0; j < 4; ++j) {
      bf16* rp = dst + (long)(m0 + wr * 64 + m * 16 + fq * 4 + j) * ld + n0 + wc * 64 + fr;
#pragma unroll
      for (int n = 0; n < 4; ++n) rp[n * 16] = f2bf(acc[m][n][j]);
    }
}

DEVI void store_rm_sw(const f32x4 (&acc)[4][4], bf16* dst, long ld, int m0, int n0) {
  const int tid = opaque_tid(), lane = tid & 63, wid = tid >> 6, wr = wid >> 1, wc = wid & 1, fr = lane & 15, fq = lane >> 4;
  const int cofs = (fq & 1) * 16 + (fq & 2) * 4;
#pragma unroll
  for (int m = 0; m < 4; ++m) {
    bf16* rp = dst + (long)(m0 + wr * 64 + m * 16 + fr) * ld + n0 + wc * 64 + cofs;
#pragma unroll
    for (int n = 0; n < 4; n += 2) {
      const unsigned x0 = pack2(acc[m][n][0], acc[m][n][1]), x1 = pack2(acc[m][n][2], acc[m][n][3]);
      const unsigned y0 = pack2(acc[m][n + 1][0], acc[m][n + 1][1]), y1 = pack2(acc[m][n + 1][2], acc[m][n + 1][3]);
      const u32x2 s0 = __builtin_amdgcn_permlane16_swap(x0, y0, false, false);
      const u32x2 s1 = __builtin_amdgcn_permlane16_swap(x1, y1, false, false);
      *(u32x4*)(rp + n * 16) = u32x4{s0[0], s1[0], s0[1], s1[1]};
    }
  }
}

DEVI void store_tr_wave(const f32x4 (&acc)[4][4], bf16* dstplane, long rowlen, int pos0  ) {
  const int lane = opaque_tid() & 63, fr = lane & 15, fq = lane >> 4;
#pragma unroll
  for (int m = 0; m < 4; ++m)
#pragma unroll
    for (int n = 0; n < 4; n += 2) {
      const unsigned x0 = pack2(acc[m][n][0], acc[m][n][1]), x1 = pack2(acc[m][n][2], acc[m][n][3]);
      const unsigned y0 = pack2(acc[m][n + 1][0], acc[m][n + 1][1]), y1 = pack2(acc[m][n + 1][2], acc[m][n + 1][3]);
      const u32x2 s0 = __builtin_amdgcn_permlane16_swap(x0, y0, false, false);
      const u32x2 s1 = __builtin_amdgcn_permlane16_swap(x1, y1, false, false);
      *(u32x4*)(dstplane + (long)((n + (fq & 1)) * 16 + fr) * rowlen + pos0 + m * 16 + (fq & 2) * 4) = u32x4{s0[0], s1[0], s0[1], s1[1]};
    }
}

DEVI void rope_sincos(int t, int i, float& sn, float& cs) {
  float inv = __powf(10000.f, -(float)i * (1.f / 16.f));
  float ang = (float)t * inv;
  float k = rintf(ang * 0.15915494309189535f);
  float r = fmaf(-k, 6.28125f, ang);
  r = fmaf(-k, 1.9353071795864769e-3f, r);
  sn = __sinf(r); cs = __cosf(r);
}

DEVI int win_srccol(int n) {
  if (n < 1280) return n;
  if (n < 1664) return 1304 + (n - 1280);
  if (n < 1792) return 1688 + (n - 1664);
  if (n < 2560) return 1848 + (n - 1792);
  if (n < 2592) return 1816 + (n - 2560);
  if (n < 2616) return 1280 + (n - 2592);
  if (n < 2620) return n;
  return -1;
}

template <int MODE>
DEVI void prep_transpose(const float* __restrict__ src, int ldsrc, int K, int Ndst, bf16* __restrict__ dst,
                         const float* __restrict__ kscale, char* smem, int rot) {
  float(*tile)[65] = (float(*)[65])smem;
  const int tid = opaque_tid();
  const int KT = K >> 6, NTL = Ndst >> 6, ntiles = KT * NTL;
  const int c4 = (tid & 15) * 4, r16 = tid >> 4;
  int start = (int)blockIdx.x - rot; if (start < 0) start += gridDim.x;
  for (int t = start; t < ntiles; t += gridDim.x) {
    int kt = t % KT, nt = t / KT;
    int n = nt * 64 + c4;
    int sc = MODE == 1 ? win_srccol(n) : n;
    __syncthreads();
#pragma unroll
    for (int i = 0; i < 4; ++i) {
      int k = i * 16 + r16;
      f32x4 v = f32x4{0.f, 0.f, 0.f, 0.f};
      if (sc >= 0) v = *(const f32x4*)(src + (long)(kt * 64 + k) * ldsrc + sc);
      if (kscale) v *= kscale[kt * 64 + k];
      tile[k][c4] = v[0]; tile[k][c4 + 1] = v[1]; tile[k][c4 + 2] = v[2]; tile[k][c4 + 3] = v[3];
    }
    __syncthreads();
    int nn = tid >> 2, kq = tid & 3;
    unsigned w[8];
#pragma unroll
    for (int e = 0; e < 8; ++e) w[e] = pack2(tile[kq * 16 + 2 * e][nn], tile[kq * 16 + 2 * e + 1][nn]);
    u32x4* dp = (u32x4*)(dst + (long)(nt * 64 + nn) * K + kt * 64 + kq * 16);
    dp[0] = u32x4{w[0], w[1], w[2], w[3]};
    dp[1] = u32x4{w[4], w[5], w[6], w[7]};
  }
}

DEVI void phase_prep(const Params& p, int L, char* smem) {
  char* ws = opaque_ptr(p.ws);
  const int G = gridDim.x;
  int rot = 0;
#define PREP(MODE, SRC, LDS_, KK, ND, DST, SC) \
  { prep_transpose<MODE>(SRC, LDS_, KK, ND, (bf16*)(ws + DST), SC, smem, rot); rot = (rot + ((KK) >> 6) * ((ND) >> 6)) % G; }
  PREP(1, p.in[2] + (size_t)L * 1024 * 2620, 2620, 1024, 2688, OFF_WIN, nullptr)
  PREP(0, p.in[12] + (size_t)L * 1024 * 3072, 3072, 1024, 3072, OFF_WG, nullptr)
  PREP(0, p.in[13] + (size_t)L * 512 * 1024, 1024, 512, 1024, OFF_WBN, nullptr)
  PREP(0, p.in[14] + (size_t)L * 256 * 1024, 1024, 256, 1024, OFF_WBM, nullptr)
  PREP(0, p.in[15] + (size_t)L * 256 * 1024, 1024, 256, 1024, OFF_WBF, nullptr)
  PREP(0, p.in[16] + (size_t)L * 1024 * 1024, 1024, 1024, 1024, OFF_WOUT, nullptr)
  PREP(0, p.in[17] + (size_t)L * 1024 * 256, 256, 1024, 256, OFF_WXQ, nullptr)
  PREP(0, p.in[18] + (size_t)L * 1024 * 512, 512, 1024, 512, OFF_WXKV, nullptr)
  PREP(0, p.in[19] + (size_t)L * 256 * 1024, 1024, 256, 1024, OFF_WXO, nullptr)
  PREP(0, p.in[20] + (size_t)L * 1024 * 4096, 4096, 1024, 4096, OFF_WUP, nullptr)
  PREP(0, p.in[21] + (size_t)L * 4096 * 1024, 1024, 4096, 1024, OFF_WDN, nullptr)
  PREP(0, p.in[8] + (size_t)L * 384 * 384, 384, 384, 384, OFF_WUQ, p.in[7] + L * 384)
  PREP(0, p.in[10] + (size_t)L * 128 * 512, 512, 128, 512, OFF_WUKV, p.in[9] + L * 128)
  PREP(0, p.in[4] + (size_t)(L * 2 + 0) * 2048 * 128, 128, 2048, 128, OFF_WC1, nullptr)
  PREP(0, p.in[4] + (size_t)(L * 2 + 1) * 2048 * 128, 128, 2048, 128, OFF_WC1 + (size_t)128 * 2048 * 2, nullptr)
  PREP(0, p.in[5] + (size_t)(L * 2 + 0) * 128 * 64, 64, 128, 64, OFF_WC2, nullptr)
  PREP(0, p.in[5] + (size_t)(L * 2 + 1) * 128 * 64, 64, 128, 64, OFF_WC2 + (size_t)64 * 128 * 2, nullptr)
#undef PREP
  {
    int bsel = (int)blockIdx.x - (G - 64);
    if (bsel >= 0) {
      const int tid = opaque_tid();
      const int kv = bsel >> 5, chunk = bsel & 31;
      const float* pe = p.in[3] + (size_t)(L * 2 + kv) * 2048 + chunk * 64;
      const float* w1 = p.in[4] + (size_t)(L * 2 + kv) * 2048 * 128 + (size_t)chunk * 64 * 128;
      int n = tid & 127, half = tid >> 7;
      float s = 0.f;
#pragma unroll 8
      for (int k = half * 32; k < half * 32 + 32; ++k) s += pe[k] * w1[(long)k * 128 + n];
      float* red = (float*)smem;
      __syncthreads();
      red[tid] = s;
      __syncthreads();
      if (tid < 128) ((float*)(ws + OFF_B1))[(kv * 32 + chunk) * 128 + tid] = red[tid] + red[tid + 128];
      __syncthreads();
    }
  }
  if (L == 0) {
    const long gt = (long)blockIdx.x * 256 + opaque_tid(), gn = (long)G * 256;
    const f32x4* xs = (const f32x4*)p.in[0];
    f32x4* xo = (f32x4*)p.out;
    u32x2* xb = (u32x2*)(ws + OFF_XB);
    for (long i = gt; i < (long)T_TOK * 1024 / 4; i += gn) {
      f32x4 v = xs[i]; xo[i] = v;
      xb[i] = u32x2{pack2(v[0], v[1]), pack2(v[2], v[3])};
    }
    const f32x4* ms = (const f32x4*)p.in[1];
    u32x2* mb = (u32x2*)(ws + OFF_MEMB);
    for (long i = gt; i < (long)2048 * 1024 / 4; i += gn) {
      f32x4 v = ms[i];
      mb[i] = u32x2{pack2(v[0], v[1]), pack2(v[2], v[3])};
    }
  }
}

DEVI void epi_proj(const Params& p, int L, f32x4 (&acc)[4][4], int m0, int nt) {
  char* ws = opaque_ptr(p.ws);
  const int tid = opaque_tid(), lane = tid & 63, wid = tid >> 6, wr = wid >> 1, wc = wid & 1, fr = lane & 15, fq = lane >> 4;
  const int mbase = m0 + wr * 64;
  if (nt == 7 || nt == 9 || nt == 18 || nt == 19) {
    const int b = mbase >> 12, t0 = mbase & 4095;
    bf16* dstp;
    if (nt == 7) dstp = (bf16*)(ws + OFF_VST) + (long)(b * 2 + wc) * 64 * 4096;
    else if (nt == 9) dstp = (bf16*)(ws + OFF_VWT) + (long)(b * 2 + wc) * 64 * 4096;
    else dstp = (bf16*)(ws + OFF_VFT) + (long)(b * 4 + (nt - 18) * 2 + wc) * 64 * 4096;
    store_tr_wave(acc, dstp, 4096, t0);
  } else if (nt == 20) {
    if (wc == 0) {
      float* mb = (float*)(ws + OFF_XQ);
#pragma unroll
      for (int m = 0; m < 4; ++m)
#pragma unroll
        for (int j = 0; j < 4; ++j) {
          float* rp = mb + (long)(mbase + m * 16 + fq * 4 + j) * 64 + fr;
#pragma unroll
          for (int n = 0; n < 4; ++n) rp[n * 16] = acc[m][n][j];
        }
      if (fr >= 8 && fr < 12) {
        float* flog = (float*)(ws + OFF_FLOG);
        const float bfh = p.in[11][L * 4 + (fr - 8)];
#pragma unroll
        for (int m = 0; m < 4; ++m)
#pragma unroll
          for (int j = 0; j < 4; ++j) {
            const float x = acc[m][3][j] + bfh;
            flog[(long)(mbase + m * 16 + fq * 4 + j) * 4 + (fr - 8)] = fminf(x, 0.f) - log1pf(__expf(-fabsf(x)));
          }
      }
    }
  } else {
    store_rm(acc, (bf16*)(ws + OFF_PROJ), PROJ_LD, m0, nt * 128);
  }
}

DEVI void phase_proj(const Params& p, int L, char* smem) {
  char* ws = opaque_ptr(p.ws);
  const bf16* xb = (const bf16*)(ws + OFF_XB);
  constexpr int NTILE = 256 * 21;
  for (int t = blockIdx.x; t < NTILE + 64; t += gridDim.x) {
    f32x4 acc[4][4];
    zero_acc(acc);
    if (t < NTILE) {
      int mt, nt; tile_swz(t, 256, 21, mt, nt);
      if (nt == 7 || nt == 9 || nt >= 18) {
        gemm_mainloop_g<4, false, RowLinear, false, true>(acc, xb, RowLinear{1024}, 64, (const bf16*)(ws + OFF_WIN), 1024, 1024, mt * 128, nt * 128, smem);
        epi_proj(p, L, acc, mt * 128, nt);
      } else {
        gemm_mainloop_g<4, true, RowLinear, false, true>(acc, xb, RowLinear{1024}, 64, (const bf16*)(ws + OFF_WIN), 1024, 1024, mt * 128, nt * 128, smem);
        store_rm_sw(acc, (bf16*)(ws + OFF_PROJ), PROJ_LD, mt * 128, nt * 128);
      }
    } else {
      int u = t - NTILE; int mt = u >> 2, nt = u & 3;
      GEMM_ML<4, false>(acc, (const bf16*)(ws + OFF_MEMB), RowLinear{1024}, 64, (const bf16*)(ws + OFF_WXKV), 1024, 1024, mt * 128, nt * 128, smem);
      const int wid = opaque_tid() >> 6, wr = wid >> 1, wc = wid & 1;
      if (nt < 2) store_rm(acc, (bf16*)(ws + OFF_KXA), 256, mt * 128, nt * 128);
      else {
        int row0 = mt * 128 + wr * 64; int b = row0 >> 8, mm = row0 & 255;
        int h = (nt - 2) * 2 + wc;
        store_tr_wave(acc, (bf16*)(ws + OFF_VXA) + (long)(b * 4 + h) * 64 * 256, 256, mm);
      }
    }
  }
}

DEVI float gelu_tanh(float x) {
  float u = 0.7978845608028654f * (x + 0.044715f * x * x * x);
  return 0.5f * x * (1.f + tanhf(u));
}

DEVI void phase_derived(const Params& p, int L, char* smem) {
  char* ws = opaque_ptr(p.ws);
  const int tid = opaque_tid(), lane = tid & 63, wid = tid >> 6, wr = wid >> 1, wc = wid & 1, fr = lane & 15, fq = lane >> 4;
  const bf16* proj = (const bf16*)(ws + OFF_PROJ);
  constexpr int N_CMP = 64, N_CUM = 8, N_MISC = 512, N_QUP = 768, N_KVUP = 1024;
  for (int t0_ = blockIdx.x; t0_ < N_CMP + N_CUM + N_MISC + N_QUP + N_KVUP; t0_ += gridDim.x) {
    int t;
    if (t0_ < N_CMP) t = t0_;
    else if (t0_ < N_CMP + N_CUM) t = N_CMP + N_QUP + N_KVUP + (t0_ - N_CMP);
    else if (t0_ < N_CMP + N_CUM + N_MISC) t = N_CMP + N_QUP + N_KVUP + N_CUM + (t0_ - N_CMP - N_CUM);
    else t = N_CMP + (t0_ - N_CMP - N_CUM - N_MISC);
    if (t < N_CMP) {
      const int kv = t >> 5, mt = t & 31;
      f32x4 acc[4][4]; zero_acc(acc);
      GEMM_ML<4, false>(acc, proj, RowCmp{kv ? 640 : 512}, PROJ_LD, (const bf16*)(ws + OFF_WC1) + (long)kv * 128 * 2048, 2048, 2048, mt * 128, 0, smem);
      __syncthreads();
      bf16* Hs = (bf16*)smem;
      const float* b1 = (const float*)(ws + OFF_B1) + kv * 32 * 128;
#pragma unroll
      for (int n = 0; n < 4; ++n) {
        const int col = wc * 64 + n * 16 + fr;
        float bb = 0.f;
#pragma unroll 8
        for (int ch = 0; ch < 32; ++ch) bb += b1[ch * 128 + col];
#pragma unroll
        for (int m = 0; m < 4; ++m)
#pragma unroll
          for (int j = 0; j < 4; ++j) Hs[(wr * 64 + m * 16 + fq * 4 + j) * 136 + col] = f2bf(gelu_tanh(acc[m][n][j] + bb));
      }
      __syncthreads();
      f32x4 a2[4][2];
#pragma unroll
      for (int m = 0; m < 4; ++m) { a2[m][0] = f32x4{0.f, 0.f, 0.f, 0.f}; a2[m][1] = f32x4{0.f, 0.f, 0.f, 0.f}; }
      const bf16* w2 = (const bf16*)(ws + OFF_WC2) + (long)kv * 64 * 128;
#pragma unroll
      for (int ks = 0; ks < 4; ++ks) {
        bf16x8 af[4], bq[2];
#pragma unroll
        for (int m = 0; m < 4; ++m) af[m] = *(const bf16x8*)(Hs + (wr * 64 + m * 16 + fr) * 136 + ks * 32 + fq * 8);
#pragma unroll
        for (int n = 0; n < 2; ++n) bq[n] = *(const bf16x8*)(w2 + (wc * 32 + n * 16 + fr) * 128 + ks * 32 + fq * 8);
#pragma unroll
        for (int m = 0; m < 4; ++m)
#pragma unroll
          for (int n = 0; n < 2; ++n) a2[m][n] = __builtin_amdgcn_mfma_f32_16x16x32_bf16(af[m], bq[n], a2[m][n], 0, 0, 0);
      }
#pragma unroll
      for (int m = 0; m < 4; ++m)
#pragma unroll
        for (int n = 0; n < 2; ++n) {
          const int r0 = mt * 128 + wr * 64 + m * 16 + fq * 4;
          const int col = wc * 32 + n * 16 + fr;
          if (kv == 0) {
            bf16* kc = (bf16*)(ws + OFF_KC);
#pragma unroll
            for (int j = 0; j < 4; ++j) kc[(long)(r0 + j) * 64 + col] = f2bf(a2[m][n][j]);
          } else {
            bf16* vct = (bf16*)(ws + OFF_VCT);
            u32x2 v; v[0] = pack2(a2[m][n][0], a2[m][n][1]); v[1] = pack2(a2[m][n][2], a2[m][n][3]);
            *(u32x2*)(vct + ((long)(r0 >> 8) * 64 + col) * 256 + (r0 & 255)) = v;
          }
        }
    } else if (t < N_CMP + N_QUP) {
      const int u = t - N_CMP; const int mt = u / 3, nt = u - mt * 3;
      f32x4 acc[4][4]; zero_acc(acc);
      gemm_mainloop<true>(acc, proj + 1280, RowLinear{PROJ_LD}, 64, (const bf16*)(ws + OFF_WUQ), 384, 384, mt * 128, nt * 128, smem);
      const float* rowss = (const float*)(smem + SM_ROWSS);
      bf16* qmla = (bf16*)(ws + OFF_QMLA);
      const int nbase = nt * 128 + wc * 64;
#pragma unroll
      for (int m = 0; m < 4; ++m)
#pragma unroll
        for (int j = 0; j < 4; ++j) {
          const int lr = wr * 64 + m * 16 + fq * 4 + j;
          const int row = mt * 128 + lr;
          const float rinv = rsqrtf(rowss[lr] * (1.f / 384.f) + 1e-6f);
          float v[4];
#pragma unroll
          for (int n = 0; n < 4; ++n) v[n] = acc[m][n][j] * rinv;
#pragma unroll
          for (int n = 0; n < 3; ++n) {
            if (((nbase + n * 16) % 96) == 64) {
              float sn, cs; rope_sincos(row & 4095, fr, sn, cs);
              float x1 = v[n], x2 = v[n + 1];
              v[n] = x1 * cs - x2 * sn; v[n + 1] = x1 * sn + x2 * cs;
            }
          }
#pragma unroll
          for (int n = 0; n < 4; ++n) qmla[(long)row * 384 + nbase + n * 16 + fr] = f2bf(v[n]);
        }
    } else if (t < N_CMP + N_QUP + N_KVUP) {
      const int u = t - N_CMP - N_QUP; const int mt = u >> 2, nt = u & 3;
      f32x4 acc[4][4]; zero_acc(acc);
      gemm_mainloop<true>(acc, proj + 1664, RowLinear{PROJ_LD}, 64, (const bf16*)(ws + OFF_WUKV), 128, 128, mt * 128, nt * 128, smem);
      const float* rowss = (const float*)(smem + SM_ROWSS);
#pragma unroll
      for (int m = 0; m < 4; ++m)
#pragma unroll
        for (int j = 0; j < 4; ++j) {
          const float rinv = rsqrtf(rowss[wr * 64 + m * 16 + fq * 4 + j] * (1.f / 128.f) + 1e-6f);
#pragma unroll
          for (int n = 0; n < 4; ++n) acc[m][n][j] *= rinv;
        }
      const int mbase = mt * 128 + wr * 64;
      if (wc == 0) {
        bf16* kmla = (bf16*)(ws + OFF_KMLA);
#pragma unroll
        for (int m = 0; m < 4; ++m)
#pragma unroll
          for (int j = 0; j < 4; ++j) {
            bf16* rp = kmla + (long)(mbase + m * 16 + fq * 4 + j) * 384 + nt * 96 + fr;
#pragma unroll
            for (int n = 0; n < 4; ++n) rp[n * 16] = f2bf(acc[m][n][j]);
          }
      } else {
        const int b = mbase >> 12, t0 = mbase & 4095;
        store_tr_wave(acc, (bf16*)(ws + OFF_VMT) + (long)(b * 4 + nt) * 64 * 4096, 4096, t0);
      }
    } else if (t < N_CMP + N_QUP + N_KVUP + N_CUM) {
      const int u = t - N_CMP - N_QUP - N_KVUP;
      const int seq = u * 4 + wid;
      const int b = seq >> 2, h = seq & 3;
      const float* flog = (const float*)(ws + OFF_FLOG) + (long)b * 4096 * 4 + h;
      float* cum = (float*)(ws + OFF_CUM) + (long)seq * 4096;
      float s = 0.f;
      for (int i = 0; i < 64; ++i) s += flog[(long)(lane * 64 + i) * 4];
      float incl = s;
#pragma unroll
      for (int off = 1; off < 64; off <<= 1) { float o = __shfl_up(incl, off); if (lane >= off) incl += o; }
      float run = incl - s;
      for (int i = 0; i < 64; ++i) { run += flog[(long)(lane * 64 + i) * 4]; cum[lane * 64 + i] = run * LOG2E; }
    } else {
      const int u = t - N_CMP - N_QUP - N_KVUP - N_CUM;
      const int row = u * 64 + (tid >> 2), sub = tid & 3;
      const float* mb = (const float*)(ws + OFF_XQ) + (long)row * 64;
      bf16* kmla = (bf16*)(ws + OFF_KMLA) + (long)row * 384;
      float* gaux = (float*)(ws + OFF_GAUX) + (long)row * 32;
      const int tpos = row & 4095;
#pragma unroll
      for (int q = 0; q < 4; ++q) {
        const int i = sub * 4 + q;
        float sn, cs; rope_sincos(tpos, i, sn, cs);
        const float x1 = mb[i], x2 = mb[16 + i];
        const bf16 y1 = f2bf(x1 * cs - x2 * sn), y2 = f2bf(x1 * sn + x2 * cs);
#pragma unroll
        for (int hh = 0; hh < 4; ++hh) { kmla[hh * 96 + 64 + i] = y1; kmla[hh * 96 + 80 + i] = y2; }
      }
#pragma unroll
      for (int q = 0; q < 6; ++q) { const int gi = sub * 6 + q; gaux[gi] = sigmoidf(mb[32 + gi]); }
    }
  }
}

DEVI float xmax16(float x) {
  u32x2 r = __builtin_amdgcn_permlane16_swap(__float_as_uint(x), __float_as_uint(x), false, false);
  return fmaxf(__uint_as_float(r[0]), __uint_as_float(r[1]));
}
DEVI float xmax32(float x) {
  u32x2 r = __builtin_amdgcn_permlane32_swap(__float_as_uint(x), __float_as_uint(x), false, false);
  return fmaxf(__uint_as_float(r[0]), __uint_as_float(r[1]));
}
template <int CTRL> DEVI float dppf(float v) { return __int_as_float(__builtin_amdgcn_update_dpp(0, __float_as_int(v), CTRL, 0xF, 0xF, true)); }
template <int CTRL> DEVI unsigned dppu(unsigned v) { return (unsigned)__builtin_amdgcn_update_dpp(0, (int)v, CTRL, 0xF, 0xF, true); }
constexpr int DPP_X1 = 0xB1, DPP_X2 = 0x4E, DPP_HM = 0x141, DPP_M = 0x140;
DEVI float quad_sum(float v) { v += dppf<DPP_X1>(v); v += dppf<DPP_X2>(v); return v; }
DEVI float row16_sum(float v) { v = quad_sum(v); v += dppf<DPP_HM>(v); v += dppf<DPP_M>(v); return v; }
DEVI float wave_sum(float v) {
  v = row16_sum(v);
  u32x2 r = __builtin_amdgcn_permlane16_swap(__float_as_uint(v), __float_as_uint(v), false, false);
  v = __uint_as_float(r[0]) + __uint_as_float(r[1]);
  r = __builtin_amdgcn_permlane32_swap(__float_as_uint(v), __float_as_uint(v), false, false);
  return __uint_as_float(r[0]) + __uint_as_float(r[1]);
}
DEVI float max3f(float a, float b, float c) { return fmaxf(fmaxf(a, b), c); }
DEVI float max16(const f32x4& a, const f32x4& b, const f32x4& c, const f32x4& d) {
  const float t0 = max3f(a[0], a[1], a[2]), t1 = max3f(a[3], b[0], b[1]), t2 = max3f(b[2], b[3], c[0]);
  const float t3 = max3f(c[1], c[2], c[3]), t4 = max3f(d[0], d[1], d[2]);
  return fmaxf(max3f(t0, t1, t2), max3f(t3, t4, d[3]));
}
constexpr float DEFER_THR = 8.f;

template <int DK, int MODE, int RBM, class SF, class FF, class POST>
DEVI void attn_tile_body(const bf16x8 (&qf)[2][DK / 32], const char* Ks, const char* Vs, SF& sf, FF& ff, POST& post,
                         int cur, int c0, int c1, float (&m)[2], float (&l)[2], f32x4 (&o)[5][2], int fr, int fq) {
  constexpr int NKC = DK / 32;
  f32x4 s[4][2];
#pragma unroll
  for (int kb = 0; kb < 4; ++kb) { s[kb][0] = f32x4{0.f, 0.f, 0.f, 0.f}; s[kb][1] = f32x4{0.f, 0.f, 0.f, 0.f}; }
#pragma unroll
  for (int ks = 0; ks < NKC; ++ks)
#pragma unroll
    for (int kb = 0; kb < 4; ++kb) {
      const int koff = DK == 64 ? (kb * 16 + fr) * 128 + (((ks * 4 + fq) ^ (fr & 7)) * 16)
                                : (kb * 16 + fr) * 192 + ((ks * 4 + (fq ^ ((fr >> 2) & 3))) * 16);
      bf16x8 kf = *(const bf16x8*)(Ks + koff);
      if (RBM & 1) s[kb][0] = __builtin_amdgcn_mfma_f32_16x16x32_bf16(kf, qf[0][ks], s[kb][0], 0, 0, 0);
      if (RBM & 2) s[kb][1] = __builtin_amdgcn_mfma_f32_16x16x32_bf16(kf, qf[1][ks], s[kb][1], 0, 0, 0);
    }
#pragma unroll
  for (int rb = 0; rb < 2; ++rb) {
    if (!(RBM & (1 << rb))) continue;
    const int cm = rb == 0 ? c0 : c1;
    if (cm == 2) {
      const float cl = ff.cl(rb, cur);
      const float fsc = ff.sc;
      if (FF::HASVEC) {
#pragma unroll
        for (int kb = 0; kb < 4; ++kb) {
          const f32x4 av = ff.vec(kb);
#pragma unroll
          for (int j = 0; j < 4; ++j) s[kb][rb][j] = opq(fmaf(s[kb][rb][j], fsc, av[j]));
        }
      }
      if (MODE == 2) {
        const float c = cl - m[rb];
#pragma unroll
        for (int kb = 0; kb < 4; ++kb)
#pragma unroll
          for (int j = 0; j < 4; ++j) {
            const float e = FF::HASVEC ? opq(s[kb][rb][j] + c) : opq(fmaf(s[kb][rb][j], fsc, c));
            s[kb][rb][j] = opq(fexp2(e) * l[rb]);
          }
      } else if (MODE == 0) {
        float mx = max16(s[0][rb], s[1][rb], s[2][rb], s[3][rb]);
        mx = xmax16(mx); mx = xmax32(mx);
        const float cand = FF::HASVEC ? (mx + cl) : fmaf(mx, fsc, cl);
        if (__builtin_amdgcn_ballot_w64(cand > m[rb] + DEFER_THR) != 0) {
          const float mn = fmaxf(m[rb], cand);
          const float alpha = fexp2(m[rb] - mn);
          m[rb] = mn;
#pragma unroll
          for (int db = 0; db < 5; ++db)
#pragma unroll
            for (int j = 0; j < 4; ++j) o[db][rb][j] = opq(o[db][rb][j] * alpha);
        }
        const float c = cl - m[rb];
#pragma unroll
        for (int kb = 0; kb < 4; ++kb)
#pragma unroll
          for (int j = 0; j < 4; ++j) {
            const float e = FF::HASVEC ? opq(s[kb][rb][j] + c) : opq(fmaf(s[kb][rb][j], fsc, c));
            s[kb][rb][j] = fexp2(e);
          }
      } else {
        float mx = max16(s[0][rb], s[1][rb], s[2][rb], s[3][rb]);
        mx = xmax16(mx); mx = xmax32(mx);
        const float cand = FF::HASVEC ? (mx + cl) : fmaf(mx, fsc, cl);
        const float mn = fmaxf(m[rb], cand);
        const float alpha = fexp2(m[rb] - mn);
        m[rb] = mn;
        const float c = cl - mn;
        float rs0 = 0.f, rs1 = 0.f;
#pragma unroll
        for (int kb = 0; kb < 4; ++kb)
#pragma unroll
          for (int j = 0; j < 4; ++j) {
            const float e = FF::HASVEC ? opq(s[kb][rb][j] + c) : opq(fmaf(s[kb][rb][j], fsc, c));
            const float pv = fexp2(e);
            s[kb][rb][j] = pv;
            if (j & 1) rs1 = opq(rs1 + pv); else rs0 = opq(rs0 + pv);
          }
        l[rb] = fmaf(l[rb], alpha, rs0 + rs1);
      }
      continue;
    }
#pragma unroll
    for (int kb = 0; kb < 4; ++kb)
#pragma unroll
      for (int j = 0; j < 4; ++j) s[kb][rb][j] = sf(rb, kb, j, cur, s[kb][rb][j]);
    if (MODE == 2) {
#pragma unroll
      for (int kb = 0; kb < 4; ++kb)
#pragma unroll
        for (int j = 0; j < 4; ++j) s[kb][rb][j] = fexp2(s[kb][rb][j] - m[rb]) * l[rb];
    } else if (MODE == 0) {
      float mx = max16(s[0][rb], s[1][rb], s[2][rb], s[3][rb]);
      mx = xmax16(mx); mx = xmax32(mx);
      if (__builtin_amdgcn_ballot_w64(mx > m[rb] + DEFER_THR) != 0) {
        const float mn = fmaxf(m[rb], mx);
        const float alpha = fexp2(m[rb] - mn);
        m[rb] = mn;
#pragma unroll
        for (int db = 0; db < 5; ++db)
#pragma unroll
          for (int j = 0; j < 4; ++j) o[db][rb][j] = opq(o[db][rb][j] * alpha);
      }
      const float mm = m[rb];
#pragma unroll
      for (int kb = 0; kb < 4; ++kb)
#pragma unroll
        for (int j = 0; j < 4; ++j) s[kb][rb][j] = fexp2(s[kb][rb][j] - mm);
    } else {
      float mx = -INFINITY;
#pragma unroll
      for (int kb = 0; kb < 4; ++kb)
#pragma unroll
        for (int j = 0; j < 4; ++j) mx = fmaxf(mx, s[kb][rb][j]);
      mx = xmax16(mx); mx = xmax32(mx);
      const float mn = fmaxf(m[rb], mx);
      const float alpha = fexp2(m[rb] - mn);
      m[rb] = mn;
      float rs = 0.f;
#pragma unroll
      for (int kb = 0; kb < 4; ++kb)
#pragma unroll
        for (int j = 0; j < 4; ++j) { float pv = fexp2(s[kb][rb][j] - mn); s[kb][rb][j] = pv; rs += pv; }
      l[rb] = l[rb] * alpha + rs;
    }
  }
  if (MODE == 2) post(cur, s);
  if (MODE != 1) {
    bf16x8 pf[2][2];
#pragma unroll
    for (int rb = 0; rb < 2; ++rb) {
      if (!(RBM & (1 << rb))) continue;
#pragma unroll
      for (int kp2 = 0; kp2 < 2; ++kp2) {
        u32x4 w;
        w[0] = pack2(s[2 * kp2][rb][0], s[2 * kp2][rb][1]); w[1] = pack2(s[2 * kp2][rb][2], s[2 * kp2][rb][3]);
        w[2] = pack2(s[2 * kp2 + 1][rb][0], s[2 * kp2 + 1][rb][1]); w[3] = pack2(s[2 * kp2 + 1][rb][2], s[2 * kp2 + 1][rb][3]);
        pf[rb][kp2] = __builtin_bit_cast(bf16x8, w);
      }
    }
#pragma unroll
    for (int kp2 = 0; kp2 < 2; ++kp2)
#pragma unroll
      for (int db = 0; db < 4; ++db) {
        const char* base = Vs + (db * 16 + fr) * 128 + (fq & 1) * 8;
        const int c = kp2 * 4 + (fq >> 1);
        u32x2 lo = *(const u32x2*)(base + ((c ^ (fr & 7)) * 16));
        u32x2 hi = *(const u32x2*)(base + (((c + 2) ^ (fr & 7)) * 16));
        u32x4 w; w[0] = lo[0]; w[1] = lo[1]; w[2] = hi[0]; w[3] = hi[1];
        bf16x8 vf = __builtin_bit_cast(bf16x8, w);
        if (RBM & 1) o[db][0] = __builtin_amdgcn_mfma_f32_16x16x32_bf16(vf, pf[0][kp2], o[db][0], 0, 0, 0);
        if (RBM & 2) o[db][1] = __builtin_amdgcn_mfma_f32_16x16x32_bf16(vf, pf[1][kp2], o[db][1], 0, 0, 0);
      }
    if (MODE == 0) {
      u32x4 w1; w1[0] = w1[1] = w1[2] = w1[3] = 0x3F803F80u;
      const bf16x8 ones = __builtin_bit_cast(bf16x8, w1);
#pragma unroll
      for (int kp2 = 0; kp2 < 2; ++kp2) {
        if (RBM & 1) o[4][0] = __builtin_amdgcn_mfma_f32_16x16x32_bf16(ones, pf[0][kp2], o[4][0], 0, 0, 0);
        if (RBM & 2) o[4][1] = __builtin_amdgcn_mfma_f32_16x16x32_bf16(ones, pf[1][kp2], o[4][1], 0, 0, 0);
      }
    }
  }
}

template <int DK, int MODE, bool RBSKIP, bool HASCUM, class KP, class VP, class CP, class SF, class FF, class CLS, class POST>
DEVI void attn_run(u64 tiles, u64 wtiles, const bf16x8 (&qf)[2][DK / 32], KP kp, VP vp, CP cp, SF sf, FF ff, CLS cls, POST post,
                   float (&m)[2], float (&l)[2], f32x4 (&o)[5][2], char* smem, const char*& curslot) {
  constexpr int NKC = DK / 32;
  constexpr int CPR = DK / 8;
  const int tid = opaque_tid(), lane = tid & 63, fr = lane & 15, fq = lane >> 4;
  if (tiles == 0) return;
#define ATT_ISSUE(TILE, SLOT)                                                                             \
  {                                                                                                       \
    char* sb = smem + (SLOT) * GEO::STRIDE;                                                               \
    _Pragma("unroll") for (int i = 0; i < NKC; ++i) {                                                     \
      const int q = tid + 256 * i; const int row = q / CPR, pos = q - row * CPR;                          \
      const int gc = DK == 64 ? (pos ^ (row & 7)) : ((pos & ~3) | ((pos & 3) ^ ((row >> 2) & 3)));        \
      __builtin_amdgcn_global_load_lds((const unsigned*)(kp(TILE, row) + gc * 8), (unsigned*)(sb + q * 16), 16, 0, 0); \
    }                                                                                                     \
    if (MODE != 1) {                                                                                      \
      _Pragma("unroll") for (int i = 0; i < 2; ++i) {                                                     \
        const int q = tid + 256 * i; const int d = q >> 3, pos = q & 7;                                   \
        __builtin_amdgcn_global_load_lds((const unsigned*)(vp(TILE, d) + ((pos ^ (d & 7)) * 8)), (unsigned*)(sb + GEO::AVO + q * 16), 16, 0, 0); \
      }                                                                                                   \
    }                                                                                                     \
    if (HASCUM) {                                                                                         \
      if (lane < 16) __builtin_amdgcn_global_load_lds((const unsigned*)(cp(TILE) + lane * 4), (unsigned*)(sb + GEO::ACO + lane * 16), 16, 0, 0); \
    }                                                                                                     \
  }
#define ATT_POP(VAR) { VAR = -1; if (tiles) { VAR = __builtin_ctzll(tiles); tiles &= tiles - 1; } }
#define ATT_COMPUTE(TILE, SLOT)                                                                           \
  if ((wtiles >> (TILE)) & 1) {                                                                           \
    const char* sb = smem + (SLOT) * GEO::STRIDE;                                                         \
    curslot = sb;                                                                                         \
    const int c0 = cls(0, (TILE)), c1 = cls(1, (TILE));                                                   \
    if (RBSKIP) {                                                                                         \
      if (c0) attn_tile_body<DK, MODE, 1>(qf, sb, sb + GEO::AVO, sf, ff, post, (TILE), c0, c1, m, l, o, fr, fq); \
      if (c1) attn_tile_body<DK, MODE, 2>(qf, sb, sb + GEO::AVO, sf, ff, post, (TILE), c0, c1, m, l, o, fr, fq); \
    } else {                                                                                              \
      attn_tile_body<DK, MODE, 3>(qf, sb, sb + GEO::AVO, sf, ff, post, (TILE), c0, c1, m, l, o, fr, fq);  \
    }                                                                                                     \
  }
  using GEO = RingGeo<DK>;
  __syncthreads();
  if (DK == 64) {
    int ta, tb;
    ATT_POP(ta) ATT_ISSUE(ta, 0)
    ATT_POP(tb) if (tb >= 0) ATT_ISSUE(tb, 1)
    int sp = 0;
    for (;;) {
      asm volatile("s_waitcnt vmcnt(0)" ::: "memory");
      __builtin_amdgcn_s_barrier();
      int tc, td = -1;
      ATT_POP(tc)
      if (tc >= 0) { ATT_ISSUE(tc, sp ^ 2) ATT_POP(td) if (td >= 0) ATT_ISSUE(td, (sp ^ 2) + 1) }
      ATT_COMPUTE(ta, sp)
      if (tb >= 0) ATT_COMPUTE(tb, sp + 1)
      if (tc < 0) break;
      ta = tc; tb = td; sp ^= 2;
    }
  } else {
    int cur, n1;
    ATT_POP(cur) ATT_ISSUE(cur, 0)
    ATT_POP(n1) if (n1 >= 0) ATT_ISSUE(n1, 1)
    int si = 0;
    for (;;) {
      if (n1 >= 0) {
        constexpr int G = NKC + (MODE != 1 ? 2 : 0) + (HASCUM ? 1 : 0);
        if (G == 2) asm volatile("s_waitcnt vmcnt(2)" ::: "memory");
        else if (G == 4) asm volatile("s_waitcnt vmcnt(4)" ::: "memory");
        else if (G == 5) asm volatile("s_waitcnt vmcnt(5)" ::: "memory");
        else asm volatile("s_waitcnt vmcnt(0)" ::: "memory");
      } else {
        asm volatile("s_waitcnt vmcnt(0)" ::: "memory");
      }
      __builtin_amdgcn_s_barrier();
      int n2;
      ATT_POP(n2)
      if (n2 >= 0) { const int s2 = si >= 1 ? si - 1 : 2; ATT_ISSUE(n2, s2) }
      ATT_COMPUTE(cur, si)
      if (n1 < 0) break;
      cur = n1; n1 = n2; si = si == 2 ? 0 : si + 1;
    }
  }
#undef ATT_COMPUTE
#undef ATT_POP
#undef ATT_ISSUE
  __syncthreads();
}

template <class CL>
struct FastConst { static constexpr bool HASVEC = false; float sc; CL clf; DEVI float cl(int rb, int tile) const { return clf(rb, tile); } DEVI f32x4 vec(int) const { return f32x4{0.f, 0.f, 0.f, 0.f}; } };
template <class CL, class VF>
struct FastVec { static constexpr bool HASVEC = true; float sc; CL clf; VF vf; DEVI float cl(int rb, int tile) const { return clf(rb, tile); } DEVI f32x4 vec(int kb) const { return vf(kb); } };
template <class CL> DEVI FastConst<CL> make_fast(float sc, CL cl) { return FastConst<CL>{sc, cl}; }
template <class CL, class VF> DEVI FastVec<CL, VF> make_fast_vec(float sc, CL cl, VF vf) { return FastVec<CL, VF>{sc, cl, vf}; }

DEVI float row_lsum(float l) { l += __shfl_xor(l, 16); l += __shfl_xor(l, 32); return l; }

struct NoCum { DEVI const float* operator()(int) const { return nullptr; } };
struct NoPost { DEVI void operator()(int, f32x4 (&)[4][2]) const {} };

DEVI void nsa_item(const Params& p, int b, int g, int t0, char* smem) {
  char* ws = opaque_ptr(p.ws);
  const int tid = opaque_tid(), lane = tid & 63, wid = tid >> 6, fr = lane & 15, fq = lane >> 4;
  const bf16* proj = (const bf16*)(ws + OFF_PROJ);
  float* lut = (float*)(smem + ALUT);
  float* imp = (float*)(smem + AIMP);
  u64* selm = (u64*)(smem + ASEL);
  __syncthreads();
  const float* t5 = p.in[6];
  for (int e = tid; e < 512; e += 256) { int r = e >> 7, d = e & 127; lut[e] = t5[T5BUCKET[d] * 8 + g * 4 + r] * LOG2E; }
  for (int e = tid; e < 2048; e += 256) imp[e] = 0.f;
  const int hl = fr & 3, h = g * 4 + hl;
  int tl[2], t[2];
  tl[0] = wid * 8 + (fr >> 2); tl[1] = tl[0] + 4;
#pragma unroll
  for (int rb = 0; rb < 2; ++rb) t[rb] = t0 + tl[rb];
  bf16x8 qf[2][2];
#pragma unroll
  for (int rb = 0; rb < 2; ++rb)
#pragma unroll
    for (int ks = 0; ks < 2; ++ks) qf[rb][ks] = *(const bf16x8*)(proj + ((long)b * 4096 + t[rb]) * PROJ_LD + h * 64 + ks * 32 + fq * 8);
  const float* gaux = (const float*)(ws + OFF_GAUX);
  f32x4* totl = (f32x4*)(ws + OFF_OXA) + (size_t)blockIdx.x * 8 * 256 + tid;
  const char* curslot = smem;
  const float* lutr = lut + hl * 128;
  const float sc = 0.125f * LOG2E;
  const int uw = __builtin_amdgcn_readfirstlane(wid);
  const int tmin0 = t0 + uw * 8, tmin1 = tmin0 + 4;
  __syncthreads();

  float m[2], l[2]; f32x4 o[5][2];
#define RESET_STATE                                                                                   \
  {                                                                                                   \
    m[0] = m[1] = -1e30f; l[0] = l[1] = 0.f;                                                          \
    _Pragma("unroll") for (int db = 0; db < 5; ++db) { o[db][0] = f32x4{0.f, 0.f, 0.f, 0.f}; o[db][1] = f32x4{0.f, 0.f, 0.f, 0.f}; } \
  }
#define ACCUM_BRANCH(GI, NORMALIZED)                                                                  \
  {                                                                                                   \
    _Pragma("unroll") for (int rb = 0; rb < 2; ++rb) {                                                \
      float f = gaux[((long)b * 4096 + t[rb]) * 32 + h * 3 + GI];                                     \
      if (!(NORMALIZED)) { float ls = o[4][rb][0]; f = ls > 0.f ? f / ls : 0.f; }                     \
      _Pragma("unroll") for (int db = 0; db < 4; ++db) {                                              \
        f32x4* tp = totl + (rb * 4 + db) * 256;                                                       \
        if (GI == 0) *tp = o[db][rb] * f; else *tp = *tp + o[db][rb] * f;                             \
      }                                                                                               \
    }                                                                                                 \
  }

  {
    const bf16* kc = (const bf16*)(ws + OFF_KC) + (long)(b * 2 + g) * 256 * 64;
    const bf16* vct = (const bf16*)(ws + OFF_VCT) + (long)(b * 2 + g) * 64 * 256;
    const int nct = (t0 >> 10) + 1;
    const u64 ctiles = (1ull << nct) - 1;
    auto kpc = [&](int tile, int row) { return kc + (long)(tile * 64 + row) * 64; };
    auto vpc = [&](int tile, int d) { return vct + (long)d * 256 + tile * 64; };
    auto sfc = [&](int rb, int kb, int j, int tile, float s) {
      int cend = (tile * 64 + kb * 16 + fq * 4 + j) * 16 + 31;
      int dist = t[rb] - cend;
      int di = min(max(dist, 0), 127);
      return dist >= 0 ? fmaf(s, sc, lutr[di]) : -INFINITY;
    };
    const float cbf = lutr[127];
    auto ffc = make_fast(sc, [=](int rb, int tile) { return cbf; });
    auto clc = [&](int rb, int tile) { return ((rb ? tmin1 : tmin0) - ((tile * 64 + 63) * 16 + 31) >= 113) ? 2 : 1; };
    RESET_STATE
    attn_run<64, 1, false, false>(ctiles, ctiles, qf, kpc, vpc, NoCum{}, sfc, ffc, clc, NoPost{}, m, l, o, smem, curslot);
#pragma unroll
    for (int rb = 0; rb < 2; ++rb) { float ls = row_lsum(l[rb]); l[rb] = ls > 0.f ? 1.f / ls : 0.f; }
    auto postc = [&](int tile, f32x4 (&s)[4][2]) {
#pragma unroll
      for (int rb = 0; rb < 2; ++rb)
#pragma unroll
        for (int kb = 0; kb < 4; ++kb) {
          float P[4];
#pragma unroll
          for (int j = 0; j < 4; ++j) P[j] = quad_sum(s[kb][rb][j]);
          if (hl == 0) {
            int n = tile * 16 + kb * 4 + fq;
            atomicAdd(&imp[tl[rb] * 64 + n], 2.f * (P[0] + P[1] + P[2]) + P[3]);
            if (n + 1 < 64) atomicAdd(&imp[tl[rb] * 64 + n + 1], P[3]);
          }
        }
    };
    attn_run<64, 2, false, false>(ctiles, ctiles, qf, kpc, vpc, NoCum{}, sfc, ffc, clc, postc, m, l, o, smem, curslot);
    ACCUM_BRANCH(0, true)
  }
  __syncthreads();
  {
    const int tli = wid * 8 + (lane >> 3), sub = lane & 7;
    const int curb = (t0 + tli) >> 6;
    float v[8];
#pragma unroll
    for (int i = 0; i < 8; ++i) {
      int n = sub * 8 + i;
      float x = imp[tli * 64 + n];
      bool cand = (n <= curb) && (n != 0) && (n != curb) && (n != curb - 1);
      v[i] = cand ? x : -1.f;
    }
    u64 mask = 1ull | (1ull << curb) | (1ull << (curb > 0 ? curb - 1 : 0));
#pragma unroll 1
    for (int round = 0; round < 5; ++round) {
      float bv = v[0]; int bi = 0;
#pragma unroll
      for (int i = 1; i < 8; ++i) if (v[i] > bv) { bv = v[i]; bi = i; }
      int bn = sub * 8 + bi;
#pragma unroll
      for (int off = 1; off < 8; off <<= 1) {
        float ov = __shfl_xor(bv, off); int on = __shfl_xor(bn, off);
        if (ov > bv || (ov == bv && on < bn)) { bv = ov; bn = on; }
      }
      if (bv >= 0.f) mask |= 1ull << bn;
      const bool owner = (bn >> 3) == sub;
#pragma unroll
      for (int i = 0; i < 8; ++i) v[i] = (owner && i == (bn & 7)) ? -2.f : v[i];
    }
    if (curb < 8) mask = (2ull << curb) - 1;
    if (sub == 0) selm[tli] = mask;
  }
  __syncthreads();
  {
    u64 msk[2] = {selm[tl[0]], selm[tl[1]]};
    u64 U = 0;
    for (int i = 0; i < 32; ++i) U |= selm[i];
    const bf16* kb_ = proj + (long)b * 4096 * PROJ_LD + 768 + g * 64;
    const bf16* vst = (const bf16*)(ws + OFF_VST) + (long)(b * 2 + g) * 64 * 4096;
    auto kps = [&](int tile, int row) { return kb_ + (long)(tile * 64 + row) * PROJ_LD; };
    auto vps = [&](int tile, int d) { return vst + (long)d * 4096 + tile * 64; };
    auto sfs = [&](int rb, int kb, int j, int tile, float s) {
      int dist = t[rb] - (tile * 64 + kb * 16 + fq * 4 + j);
      int di = min(max(dist, 0), 127);
      bool ok = dist >= 0 && ((msk[rb] >> tile) & 1);
      return ok ? fmaf(s, sc, lutr[di]) : -INFINITY;
    };
    u64 orm[2], andm[2];
#pragma unroll
    for (int rb = 0; rb < 2; ++rb) {
      unsigned olo = (unsigned)msk[rb], ohi = (unsigned)(msk[rb] >> 32), alo = olo, ahi = ohi;
      olo |= dppu<DPP_X1>(olo); ohi |= dppu<DPP_X1>(ohi); alo &= dppu<DPP_X1>(alo); ahi &= dppu<DPP_X1>(ahi);
      olo |= dppu<DPP_X2>(olo); ohi |= dppu<DPP_X2>(ohi); alo &= dppu<DPP_X2>(alo); ahi &= dppu<DPP_X2>(ahi);
      olo |= dppu<DPP_HM>(olo); ohi |= dppu<DPP_HM>(ohi); alo &= dppu<DPP_HM>(alo); ahi &= dppu<DPP_HM>(ahi);
      olo |= dppu<DPP_M>(olo); ohi |= dppu<DPP_M>(ohi); alo &= dppu<DPP_M>(alo); ahi &= dppu<DPP_M>(ahi);
      orm[rb] = ((u64)(unsigned)__builtin_amdgcn_readfirstlane((int)ohi) << 32) | (unsigned)__builtin_amdgcn_readfirstlane((int)olo);
      andm[rb] = ((u64)(unsigned)__builtin_amdgcn_readfirstlane((int)ahi) << 32) | (unsigned)__builtin_amdgcn_readfirstlane((int)alo);
    }
    const float cbf = lutr[127];
    const u64 msk0 = msk[0], msk1 = msk[1];
    auto ffs = make_fast(sc, [=](int rb, int tile) { return (((rb ? msk1 : msk0) >> tile) & 1) ? cbf : -INFINITY; });
    auto cls = [&](int rb, int tile) {
      const u64 om = rb ? orm[1] : orm[0], am = rb ? andm[1] : andm[0];
      if (!((om >> tile) & 1)) return 0;
      return ((rb ? tmin1 : tmin0) - (tile * 64 + 63) >= 113) ? 2 : 1;
    };
    RESET_STATE
    attn_run<64, 0, true, false>(U, orm[0] | orm[1], qf, kps, vps, NoCum{}, sfs, ffs, cls, NoPost{}, m, l, o, smem, curslot);
    ACCUM_BRANCH(1, false)
  }
  {
    const int lo = (t0 >= 511 ? t0 - 511 : 0) >> 6, hi = (t0 + 31) >> 6;
    const u64 wt = ((hi == 63) ? ~0ull : ((1ull << (hi + 1)) - 1)) & ~((1ull << lo) - 1);
    const bf16* kb_ = proj + (long)b * 4096 * PROJ_LD + 1024 + g * 64;
    const bf16* vwt = (const bf16*)(ws + OFF_VWT) + (long)(b * 2 + g) * 64 * 4096;
    auto kpw = [&](int tile, int row) { return kb_ + (long)(tile * 64 + row) * PROJ_LD; };
    auto vpw = [&](int tile, int d) { return vwt + (long)d * 4096 + tile * 64; };
    auto sfw = [&](int rb, int kb, int j, int tile, float s) {
      int dist = t[rb] - (tile * 64 + kb * 16 + fq * 4 + j);
      int di = min(max(dist, 0), 127);
      bool ok = dist >= 0 && dist < 512;
      return ok ? fmaf(s, sc, lutr[di]) : -INFINITY;
    };
    const float cbf = lutr[127];
    auto ffw = make_fast(sc, [=](int rb, int tile) { return cbf; });
    auto clw = [&](int rb, int tile) {
      const int tm = rb ? tmin1 : tmin0;
      return (tm - (tile * 64 + 63) >= 113 && tm + 3 - tile * 64 < 512) ? 2 : 1;
    };
    RESET_STATE
    attn_run<64, 0, false, false>(wt, wt, qf, kpw, vpw, NoCum{}, sfw, ffw, clw, NoPost{}, m, l, o, smem, curslot);
    ACCUM_BRANCH(2, false)
  }
#undef RESET_STATE
#undef ACCUM_BRANCH
  bf16* ocat = (bf16*)(ws + OFF_OCAT);
#pragma unroll
  for (int rb = 0; rb < 2; ++rb)
#pragma unroll
    for (int db = 0; db < 4; ++db) {
      const f32x4 tv = totl[(rb * 4 + db) * 256];
      u32x2 v; v[0] = pack2(tv[0], tv[1]); v[1] = pack2(tv[2], tv[3]);
      *(u32x2*)(ocat + ((long)b * 4096 + t[rb]) * 1024 + h * 64 + db * 16 + fq * 4) = v;
    }
}

template <int KIND>
DEVI void mha_item(const Params& p, int b, int h, int t0, char* smem) {
  constexpr int DK = KIND == 0 ? 96 : 64;
  char* ws = opaque_ptr(p.ws);
  const int tid = opaque_tid(), lane = tid & 63, wid = tid >> 6, fr = lane & 15, fq = lane >> 4;
  int t[2]; long tok[2];
#pragma unroll
  for (int rb = 0; rb < 2; ++rb) { t[rb] = t0 + wid * 32 + rb * 16 + fr; tok[rb] = (long)b * 4096 + t[rb]; }
  const bf16* qb; long qld; const bf16* kbase; long kld; const bf16* vbase; long vld;
  if (KIND == 0) {
    qb = (const bf16*)(ws + OFF_QMLA) + h * 96; qld = 384;
    kbase = (const bf16*)(ws + OFF_KMLA) + (long)b * 4096 * 384 + h * 96; kld = 384;
    vbase = (const bf16*)(ws + OFF_VMT) + (long)(b * 4 + h) * 64 * 4096; vld = 4096;
  } else if (KIND == 1) {
    qb = (const bf16*)(ws + OFF_PROJ) + 1792 + h * 64; qld = PROJ_LD;
    kbase = (const bf16*)(ws + OFF_PROJ) + (long)b * 4096 * PROJ_LD + 2048 + h * 64; kld = PROJ_LD;
    vbase = (const bf16*)(ws + OFF_VFT) + (long)(b * 4 + h) * 64 * 4096; vld = 4096;
  } else {
    qb = (const bf16*)(ws + OFF_XQ) + h * 64; qld = 256;
    kbase = (const bf16*)(ws + OFF_KXA) + (long)b * 256 * 256 + h * 64; kld = 256;
    vbase = (const bf16*)(ws + OFF_VXA) + (long)(b * 4 + h) * 64 * 256; vld = 256;
  }
  bf16x8 qf[2][DK / 32];
#pragma unroll
  for (int rb = 0; rb < 2; ++rb)
#pragma unroll
    for (int ks = 0; ks < DK / 32; ++ks) qf[rb][ks] = *(const bf16x8*)(qb + tok[rb] * qld + ks * 32 + fq * 8);
  u64 tiles, wtiles;
  if (KIND == 2) { tiles = 0xF; wtiles = 0xF; }
  else {
    int nt = (t0 >> 6) + 2; tiles = nt >= 64 ? ~0ull : ((1ull << nt) - 1);
    int nw = ((t0 + wid * 32 + 31) >> 6) + 1; wtiles = nw >= 64 ? ~0ull : ((1ull << nw) - 1);
  }
  const float sc = (KIND == 0 ? 0.10206207261596575f : 0.125f) * LOG2E;
  const float* cum = (const float*)(ws + OFF_CUM) + (long)(b * 4 + h) * 4096;
  float cq[2] = {0.f, 0.f};
  const char* curslot = smem;
  if (KIND == 1) { cq[0] = cum[t[0]]; cq[1] = cum[t[1]]; }
  auto kpf = [&](int tile, int row) { return kbase + (long)(tile * 64 + row) * kld; };
  auto vpf = [&](int tile, int d) { return vbase + (long)d * vld + tile * 64; };
  auto cpf = [&](int tile) { return cum + tile * 64; };
  auto sf = [&](int rb, int kb, int j, int tile, float s) {
    if (KIND == 2) return s * sc;
    int kpos = tile * 64 + kb * 16 + fq * 4 + j;
    float v = s * sc;
    if (KIND == 1) v += cq[rb] - *(const float*)(curslot + RingGeo<64>::ACO + (kb * 16 + fq * 4 + j) * 4);
    return kpos <= t[rb] ? v : -INFINITY;
  };
  float m[2] = {-1e30f, -1e30f}, l[2] = {0.f, 0.f};
  f32x4 o[5][2];
#pragma unroll
  for (int db = 0; db < 5; ++db) { o[db][0] = f32x4{0.f, 0.f, 0.f, 0.f}; o[db][1] = f32x4{0.f, 0.f, 0.f, 0.f}; }
  __syncthreads();
  const int uw = __builtin_amdgcn_readfirstlane(wid);
  const float cq0 = cq[0], cq1 = cq[1];
  const char* const* cslot = &curslot;
  auto ffm = make_fast_vec(sc, [=](int rb, int tile) { return KIND == 1 ? (rb ? cq1 : cq0) : 0.f; },
                           [=](int kb) { f32x4 z = f32x4{0.f, 0.f, 0.f, 0.f}; return KIND == 1 ? (z - *(const f32x4*)(*cslot + RingGeo<64>::ACO + (kb * 16 + fq * 4) * 4)) : z; });
  auto ffx = make_fast(sc, [=](int rb, int tile) { return 0.f; });
  auto clm = [&](int rb, int tile) { return (KIND == 2 || tile * 64 + 63 <= t0 + uw * 32 + rb * 16) ? 2 : 1; };
  if (KIND == 1) attn_run<DK, 0, false, true>(tiles, wtiles, qf, kpf, vpf, cpf, sf, ffm, clm, NoPost{}, m, l, o, smem, curslot);
  else attn_run<DK, 0, false, false>(tiles, wtiles, qf, kpf, vpf, cpf, sf, ffx, clm, NoPost{}, m, l, o, smem, curslot);
  bf16* dst; long dld;
  if (KIND == 0) { dst = (bf16*)(ws + OFF_OCAT) + 512 + h * 64; dld = 1024; }
  else if (KIND == 1) { dst = (bf16*)(ws + OFF_OCAT) + 768 + h * 64; dld = 1024; }
  else { dst = (bf16*)(ws + OFF_OXA) + h * 64; dld = 256; }
#pragma unroll
  for (int rb = 0; rb < 2; ++rb) {
    float ls = o[4][rb][0];
    float f = ls > 0.f ? 1.f / ls : 0.f;
#pragma unroll
    for (int db = 0; db < 4; ++db) {
      u32x2 v; v[0] = pack2(o[db][rb][0] * f, o[db][rb][1] * f); v[1] = pack2(o[db][rb][2] * f, o[db][rb][3] * f);
      *(u32x2*)(dst + tok[rb] * dld + db * 16 + fq * 4) = v;
    }
  }
}

DEVI int next_item(unsigned* ctr, char* smem) {
  __syncthreads();
  if (opaque_tid() == 0) *(int*)(smem + AITEM) = (int)atomicAdd(ctr, 1u);
  __syncthreads();
  return *(volatile int*)(smem + AITEM);
}

DEVI void phase_attn(const Params& p, int L, char* smem, int rep) {
  unsigned* ctr = (unsigned*)(p.ws + OFF_CNT) + L + 8 * rep;
  for (;;) {
    int it = next_item(ctr, smem);
    if (it >= 4096) break;
    int level = it >> 7, w = it & 127; int q128 = 31 - level;
    if (w < 64) { int sub = w & 3, bg = w >> 2; nsa_item(p, bg >> 1, bg & 1, q128 * 128 + sub * 32, smem); }
    else if (w < 96) { int bh = w - 64; mha_item<0>(p, bh >> 2, bh & 3, q128 * 128, smem); }
    else { int bh = w - 96; mha_item<1>(p, bh >> 2, bh & 3, q128 * 128, smem); }
  }
}

DEVI void phase_xattn(const Params& p, char* smem) {
  for (int it = blockIdx.x; it < 1024; it += gridDim.x) {
    int bh = it & 31, q = it >> 5;
    mha_item<2>(p, bh >> 2, bh & 3, q * 128, smem);
  }
}

DEVI void phase_merge(const Params& p, char* smem) {
  char* ws = opaque_ptr(p.ws);
  const bf16* xb = (const bf16*)(ws + OFF_XB);
  const bf16* ocat = (const bf16*)(ws + OFF_OCAT);
  const bf16* wg = (const bf16*)(ws + OFF_WG);
  u32x4* brg = (u32x4*)(ws + OFF_QMLA) + (size_t)blockIdx.x * 8 * 256 + opaque_tid();
  int t = blockIdx.x;
  if (t < 256 * 8) {
    int mt, nt; tile_swz(t, 256, 8, mt, nt);
    __syncthreads();
    gemm_prefetch0<4>(ocat, RowLinear{1024}, (const bf16*)(ws + OFF_WBN), 512, mt * 128, nt * 128, smem);
  }
  for (; t < 256 * 8; t += gridDim.x) {
    int mt, nt; tile_swz(t, 256, 8, mt, nt);
    f32x4 res[4][4]; zero_acc(res);
#pragma unroll 1
    for (int i = 0; i < 3; ++i) {
      const bf16* wb = (const bf16*)(ws + (i == 0 ? OFF_WBN : (i == 1 ? OFF_WBM : OFF_WBF)));
      const int kk = i == 0 ? 512 : 256;
      const int ko = i == 0 ? 0 : (i == 1 ? 512 : 768);
      f32x4 acc[4][4]; zero_acc(acc);
      gemm_mainloop_g<4, true, RowLinear, true>(acc, ocat + ko, RowLinear{1024}, 64, wb, kk, kk, mt * 128, nt * 128, smem);
      gemm_prefetch0<4>(xb, RowLinear{1024}, wg + (long)i * 1024 * 1024, 1024, mt * 128, nt * 128, smem);
#pragma unroll
      for (int m = 0; m < 4; ++m)
#pragma unroll
        for (int n = 0; n < 4; n += 2)
          brg[(m * 2 + (n >> 1)) * 256] = u32x4{pack2(acc[m][n][0], acc[m][n][1]), pack2(acc[m][n][2], acc[m][n][3]),
                                                pack2(acc[m][n + 1][0], acc[m][n + 1][1]), pack2(acc[m][n + 1][2], acc[m][n + 1][3])};
      zero_acc(acc);
      gemm_mainloop_g<4, true, RowLinear, true, true>(acc, xb, RowLinear{1024}, 64, wg + (long)i * 1024 * 1024, 1024, 1024, mt * 128, nt * 128, smem);
      if (i < 2) {
        const bf16* wb2 = (const bf16*)(ws + (i == 0 ? OFF_WBM : OFF_WBF));
        gemm_prefetch0<4>(ocat + (i == 0 ? 512 : 768), RowLinear{1024}, wb2, 256, mt * 128, nt * 128, smem);
      } else if (t + (int)gridDim.x < 256 * 8) {
        int mt2, nt2; tile_swz(t + gridDim.x, 256, 8, mt2, nt2);
        gemm_prefetch0<4>(ocat, RowLinear{1024}, (const bf16*)(ws + OFF_WBN), 512, mt2 * 128, nt2 * 128, smem);
      }
#pragma unroll
      for (int m = 0; m < 4; ++m)
#pragma unroll
        for (int n = 0; n < 4; ++n) {
          const u32x4 bq = brg[(m * 2 + (n >> 1)) * 256];
          const unsigned b0 = bq[(n & 1) * 2], b1 = bq[(n & 1) * 2 + 1];
          res[m][n][0] += sigmoidf(acc[m][n][0]) * bf2f(b0 & 0xffffu);
          res[m][n][1] += sigmoidf(acc[m][n][1]) * __uint_as_float(b0 & 0xffff0000u);
          res[m][n][2] += sigmoidf(acc[m][n][2]) * bf2f(b1 & 0xffffu);
          res[m][n][3] += sigmoidf(acc[m][n][3]) * __uint_as_float(b1 & 0xffff0000u);
        }
    }
    store_rm_sw(res, (bf16*)(ws + OFF_MERGED), 1024, mt * 128, nt * 128);
  }
}

enum { EPI_RESID = 0, EPI_RM = 1, EPI_RELU2 = 2 };
template <int EPI>
DEVI void phase_gemm(const Params& p, const bf16* A, int lda, const bf16* Bt, int K, int NT, bf16* dst, int ldd, char* smem, bool nostore = false,
                     const float* lng = nullptr, const float* lnb = nullptr) {
  int t = blockIdx.x;
  if (t < 256 * NT) {
    int mt, nt; tile_swz(t, 256, NT, mt, nt);
    __syncthreads();
    gemm_prefetch0<4>(A, RowLinear{lda}, Bt, K, mt * 128, nt * 128, smem, KROT ? k_rot(mt, nt, K >> 6) : 0);
  }
  for (; t < 256 * NT; t += gridDim.x) {
    int mt, nt; tile_swz(t, 256, NT, mt, nt);
    f32x4 acc[4][4]; zero_acc(acc);
    gemm_mainloop_g<4, true, RowLinear, true, DEEP_FRAG != 0>(acc, A, RowLinear{lda}, 64, Bt, K, K, mt * 128, nt * 128, smem, KROT ? k_rot(mt, nt, K >> 6) : 0);
    if (t + (int)gridDim.x < 256 * NT) {
      int mt2, nt2; tile_swz(t + gridDim.x, 256, NT, mt2, nt2);
      gemm_prefetch0<4>(A, RowLinear{lda}, Bt, K, mt2 * 128, nt2 * 128, smem, KROT ? k_rot(mt2, nt2, K >> 6) : 0);
    }
    if (EPI == EPI_RESID) {
      const int tid = opaque_tid(), lane = tid & 63, wid = tid >> 6, wr = wid >> 1, wc = wid & 1, fr = lane & 15, fq = lane >> 4;
      float* x = p.out;
      const float* stats = (const float*)(p.ws + OFF_STATS);
      const int cb0 = nt * 128 + wc * 64 + fq * 4;
      f32x4 gv[4], bv[4];
      if (lng) {
#pragma unroll
        for (int n = 0; n < 4; ++n) { gv[n] = *(const f32x4*)(lng + cb0 + n * 16); bv[n] = *(const f32x4*)(lnb + cb0 + n * 16); }
      }
#pragma unroll
      for (int m = 0; m < 4; ++m) {
        const int row = mt * 128 + wr * 64 + m * 16 + fr;
        float* rp = x + (long)row * 1024 + cb0;
        float mu = 0.f, rstd = 1.f;
        if (lng) { mu = stats[row * 2]; rstd = stats[row * 2 + 1]; }
        f32x4 v[4];
#pragma unroll
        for (int n = 0; n < 4; ++n) v[n] = *(const f32x4*)(rp + n * 16);
#pragma unroll
        for (int n = 0; n < 4; ++n) {
          f32x4 xv = v[n];
          if (lng) xv = (xv - mu) * rstd * gv[n] + bv[n];
          *(f32x4*)(rp + n * 16) = xv * DN_ALPHA + acc[m][n];
        }
      }
    } else if (EPI == EPI_RELU2) {
#pragma unroll
      for (int m = 0; m < 4; ++m)
#pragma unroll
        for (int n = 0; n < 4; ++n)
#pragma unroll
          for (int j = 0; j < 4; ++j) { float v = fmaxf(acc[m][n][j], 0.f); acc[m][n][j] = v * v; }
      if (!nostore || acc[0][0][0] == 123.456f) store_rm_sw(acc, dst, ldd, mt * 128, nt * 128);
    } else {
      store_rm_sw(acc, dst, ldd, mt * 128, nt * 128);
    }
  }
}

DEVI void phase_ln(const Params& p, int L, int which) {
  const int lane = opaque_tid() & 63, wid = opaque_tid() >> 6;
  const int gw = blockIdx.x * 4 + wid, nw = gridDim.x * 4;
  const float* g = p.in[22] + (L * 3 + which) * 1024;
  const float* bb = p.in[23] + (L * 3 + which) * 1024;
  char* ws = opaque_ptr(p.ws);
  bf16* xb = (bf16*)(ws + OFF_XB);
  float* stats = (float*)(ws + OFF_STATS);
  const bool final_out = (L == 3 && which == 2);
  const f32x4 g0 = *(const f32x4*)(g + lane * 4), g1 = *(const f32x4*)(g + 256 + lane * 4), g2 = *(const f32x4*)(g + 512 + lane * 4), g3 = *(const f32x4*)(g + 768 + lane * 4);
  const f32x4 b0 = *(const f32x4*)(bb + lane * 4), b1 = *(const f32x4*)(bb + 256 + lane * 4), b2 = *(const f32x4*)(bb + 512 + lane * 4), b3 = *(const f32x4*)(bb + 768 + lane * 4);
  for (int row = gw; row < T_TOK; row += nw) {
    float* xr = p.out + (long)row * 1024;
    f32x4 v0 = *(const f32x4*)(xr + lane * 4), v1 = *(const f32x4*)(xr + 256 + lane * 4);
    f32x4 v2 = *(const f32x4*)(xr + 512 + lane * 4), v3 = *(const f32x4*)(xr + 768 + lane * 4);
    f32x4 sv = v0 + v1 + v2 + v3;
    float s = sv[0] + sv[1] + sv[2] + sv[3];
    s = wave_sum(s);
    const float mu = s * (1.f / 1024.f);
    v0 -= mu; v1 -= mu; v2 -= mu; v3 -= mu;
    f32x4 qv = v0 * v0 + v1 * v1 + v2 * v2 + v3 * v3;
    float q = qv[0] + qv[1] + qv[2] + qv[3];
    q = wave_sum(q);
    const float rstd = rsqrtf(q * (1.f / 1024.f) + 1e-5f);
    if (lane == 0) { stats[row * 2] = mu; stats[row * 2 + 1] = rstd; }
#define LN_OUT(V, GG, BB, I)                                                                           \
    {                                                                                                  \
      f32x4 o = V * rstd * GG + BB;                                                                    \
      if (final_out) *(f32x4*)(xr + I * 256 + lane * 4) = o;                                           \
      *(u32x2*)(xb + (long)row * 1024 + I * 256 + lane * 4) = u32x2{pack2(o[0], o[1]), pack2(o[2], o[3])}; \
    }
    LN_OUT(v0, g0, b0, 0) LN_OUT(v1, g1, b1, 1) LN_OUT(v2, g2, b2, 2) LN_OUT(v3, g3, b3, 3)
#undef LN_OUT
  }
}

__global__ void __launch_bounds__(256, 2) mega(Params p) {
  __shared__ __attribute__((aligned(16))) char smem[SMEM_BYTES];
  cg::grid_group grid = cg::this_grid();
  char* ws = opaque_ptr(p.ws);
  volatile LAS unsigned* xst = (volatile LAS unsigned*)(smem + XBST);
  if (opaque_tid() < 4) xst[opaque_tid()] = 0u;
  __syncthreads();
  XcdBarrier xb = xcd_barrier_post((unsigned*)(ws + OFF_BAR), xst);
  grid.sync();
#pragma unroll 1
  for (int L = 0; L < 4; ++L) {
    char* ws = opaque_ptr(p.ws);
    for (int r = 0; r < REP_PREP; ++r) { phase_prep(p, L, smem);
    xcd_barrier(xb); }
    for (int r = 0; r < REP_PROJ; ++r) { phase_proj(p, L, smem);
    xcd_barrier(xb); }
    for (int r = 0; r < REP_DERIVED; ++r) { phase_derived(p, L, smem);
    xcd_barrier(xb); }
    for (int r = 0; r < REP_ATTN; ++r) { phase_attn(p, L, smem, r);
    xcd_barrier(xb); }
    for (int r = 0; r < REP_MERGE; ++r) { phase_merge(p, smem);
    xcd_barrier(xb); }
    phase_gemm<EPI_RESID>(p, (const bf16*)(ws + OFF_MERGED), 1024, (const bf16*)(ws + OFF_WOUT), 1024, 8, nullptr, 0, smem, false,
                          L ? p.in[22] + ((L - 1) * 3 + 2) * 1024 : nullptr, L ? p.in[23] + ((L - 1) * 3 + 2) * 1024 : nullptr);
    xcd_barrier(xb);
    phase_ln(p, L, 0);
    xcd_barrier(xb);
    phase_gemm<EPI_RM>(p, (const bf16*)(ws + OFF_XB), 1024, (const bf16*)(ws + OFF_WXQ), 1024, 2, (bf16*)(ws + OFF_XQ), 256, smem);
    xcd_barrier(xb);
    for (int r = 0; r < REP_XA; ++r) { phase_xattn(p, smem);
    xcd_barrier(xb); }
    phase_gemm<EPI_RESID>(p, (const bf16*)(ws + OFF_OXA), 256, (const bf16*)(ws + OFF_WXO), 256, 8, nullptr, 0, smem, false,
                          p.in[22] + (L * 3 + 0) * 1024, p.in[23] + (L * 3 + 0) * 1024);
    xcd_barrier(xb);
    phase_ln(p, L, 1);
    xcd_barrier(xb);
    for (int r = 0; r < REP_UP; ++r) { phase_gemm<EPI_RELU2>(p, (const bf16*)(ws + OFF_XB), 1024, (const bf16*)(ws + OFF_WUP), 1024, 32, (bf16*)(ws + OFF_HID), 4096, smem, (PROBE_NOSTORE && r > 0));
    xcd_barrier(xb); }
    phase_gemm<EPI_RESID>(p, (const bf16*)(ws + OFF_HID), 4096, (const bf16*)(ws + OFF_WDN), 4096, 8, nullptr, 0, smem, false,
                          p.in[22] + (L * 3 + 1) * 1024, p.in[23] + (L * 3 + 1) * 1024);
    xcd_barrier(xb);
    phase_ln(p, L, 2);
    xcd_barrier(xb);
    for (int r = 0; r < EXTRA_SYNC; ++r) xcd_barrier(xb);
  }
}

extern "C" void kernel_launch(void* const* d_in, const int* in_sizes, int n_in, void* d_out, int out_size,
                              void* d_ws, size_t ws_size, hipStream_t stream) {
  static int grid_blocks = 0;
  if (!grid_blocks) {
    int dev = 0, cus = 0, per_cu = 0;
    (void)hipGetDevice(&dev);
    (void)hipDeviceGetAttribute(&cus, hipDeviceAttributeMultiprocessorCount, dev);
    (void)hipOccupancyMaxActiveBlocksPerMultiprocessor(&per_cu, mega, 256, 0);
    if (per_cu > 2) per_cu = 2;
    if (per_cu < 1) per_cu = 1;
    grid_blocks = cus * per_cu;
    grid_blocks &= ~7;
    if (grid_blocks > 512) grid_blocks = 512;
  }
  if (ws_size < WS_TOTAL) fprintf(stderr, "workspace too small: %zu < %zu\n", ws_size, (size_t)WS_TOTAL);
  Params p{};
  for (int i = 0; i < 24; ++i) p.in[i] = (const float*)d_in[i];
  p.out = (float*)d_out;
  p.ws = (char*)d_ws;
  (void)hipMemsetAsync((char*)d_ws + OFF_BAR, 0, 16384, stream);
  void* args[] = {&p};
  hipError_t e = hipLaunchCooperativeKernel((void*)mega, dim3(grid_blocks), dim3(256), args, 0, stream);
  if (e != hipSuccess) fprintf(stderr, "cooperative launch failed: %s (grid %d)\n", hipGetErrorString(e), grid_blocks);
}
```

```cpp
#include <hip/hip_runtime.h>
#include <hip/hip_cooperative_groups.h>
#include <cstdio>
#include <cstdint>
namespace cg = cooperative_groups;

typedef unsigned short bf16;
typedef __attribute__((ext_vector_type(8))) short bf16x8;
typedef __attribute__((ext_vector_type(4))) float f32x4;
typedef __attribute__((ext_vector_type(2))) __bf16 bf2_t;
typedef __attribute__((ext_vector_type(4))) unsigned u32x4;
typedef unsigned long long u64;
typedef __attribute__((ext_vector_type(2))) unsigned u32x2;

#ifndef EXTRA_SYNC
#define EXTRA_SYNC 0
#endif
#ifndef PROBE_NOSTORE
#define PROBE_NOSTORE 0
#endif
#ifndef USE_RING
#define USE_RING 0
#endif
#if USE_RING
#define GEMM_ML gemm_mainloop_r
#else
#define GEMM_ML gemm_mainloop_g
#endif
#ifndef SWZ_MODE
#define SWZ_MODE 0
#endif
#ifndef KROT
#define KROT 0
#endif
#ifndef DEEP_FRAG
#define DEEP_FRAG 1
#endif
#ifndef REP_ATTN
#define REP_ATTN 1
#endif
#ifndef REP_PROJ
#define REP_PROJ 1
#endif
#ifndef REP_UP
#define REP_UP 1
#endif
#ifndef REP_MERGE
#define REP_MERGE 1
#endif
#ifndef REP_DERIVED
#define REP_DERIVED 1
#endif
#ifndef REP_PREP
#define REP_PREP 1
#endif
#ifndef REP_XA
#define REP_XA 1
#endif
#define DEVI __device__ __forceinline__

DEVI int opaque_tid() { int t = __builtin_amdgcn_workitem_id_x(); asm volatile("" : "+v"(t)); return t; }
DEVI char* opaque_ptr(char* p) { asm volatile("" : "+s"(p)); return p; }
DEVI float opq(float x) { asm("" : "+v"(x)); return x; }
DEVI unsigned pack2(float a, float b) { bf2_t v; v[0] = (__bf16)a; v[1] = (__bf16)b; return __builtin_bit_cast(unsigned, v); }
DEVI bf16 f2bf(float a) { return __builtin_bit_cast(unsigned short, (__bf16)a); }
DEVI float bf2f(unsigned u) { return __uint_as_float(u << 16); }
DEVI float fexp2(float x) { return __builtin_amdgcn_exp2f(x); }
DEVI float sigmoidf(float x) { return 1.f / (1.f + __expf(-x)); }

constexpr int T_TOK = 32768;
constexpr int PROJ_LD = 2688;
constexpr float LOG2E = 1.4426950408889634f;
constexpr float DN_ALPHA = 1.681792830507429f;

constexpr size_t al256(size_t x) { return (x + 255) & ~(size_t)255; }
constexpr size_t OFF_BAR = 0;
constexpr size_t OFF_CNT = 14336;
constexpr size_t OFF_WIN = 16384;
constexpr size_t OFF_WG = OFF_WIN + (size_t)2688 * 1024 * 2;
constexpr size_t OFF_WBN = OFF_WG + (size_t)3072 * 1024 * 2;
constexpr size_t OFF_WBM = OFF_WBN + (size_t)1024 * 512 * 2;
constexpr size_t OFF_WBF = OFF_WBM + (size_t)1024 * 256 * 2;
constexpr size_t OFF_WOUT = OFF_WBF + (size_t)1024 * 256 * 2;
constexpr size_t OFF_WXQ = OFF_WOUT + (size_t)1024 * 1024 * 2;
constexpr size_t OFF_WXKV = OFF_WXQ + (size_t)256 * 1024 * 2;
constexpr size_t OFF_WXO = OFF_WXKV + (size_t)512 * 1024 * 2;
constexpr size_t OFF_WUP = OFF_WXO + (size_t)1024 * 256 * 2;
constexpr size_t OFF_WDN = OFF_WUP + (size_t)4096 * 1024 * 2;
constexpr size_t OFF_WUQ = OFF_WDN + (size_t)4096 * 1024 * 2;
constexpr size_t OFF_WUKV = OFF_WUQ + (size_t)384 * 384 * 2;
constexpr size_t OFF_WC1 = OFF_WUKV + (size_t)512 * 128 * 2;
constexpr size_t OFF_WC2 = OFF_WC1 + (size_t)2 * 128 * 2048 * 2;
constexpr size_t OFF_B1 = OFF_WC2 + (size_t)2 * 64 * 128 * 2;
constexpr size_t OFF_XB = al256(OFF_B1 + 2 * 32 * 128 * 4);
constexpr size_t OFF_MEMB = OFF_XB + (size_t)32768 * 1024 * 2;
constexpr size_t OFF_PROJ = OFF_MEMB + (size_t)2048 * 1024 * 2;
constexpr size_t OFF_OCAT = OFF_PROJ + (size_t)32768 * 2688 * 2;
constexpr size_t OFF_QMLA = OFF_OCAT + (size_t)32768 * 1024 * 2;
constexpr size_t OFF_KMLA = OFF_QMLA + (size_t)32768 * 384 * 2;
constexpr size_t OFF_VMT = OFF_KMLA + (size_t)32768 * 384 * 2;
constexpr size_t OFF_VST = OFF_VMT + (size_t)8 * 4 * 64 * 4096 * 2;
constexpr size_t OFF_VWT = OFF_VST + (size_t)8 * 2 * 64 * 4096 * 2;
constexpr size_t OFF_VFT = OFF_VWT + (size_t)8 * 2 * 64 * 4096 * 2;
constexpr size_t OFF_KC = OFF_VFT + (size_t)8 * 4 * 64 * 4096 * 2;
constexpr size_t OFF_VCT = OFF_KC + (size_t)16 * 256 * 64 * 2;
constexpr size_t OFF_GAUX = OFF_VCT + (size_t)16 * 256 * 64 * 2;
constexpr size_t OFF_FLOG = OFF_GAUX + (size_t)32768 * 32 * 4;
constexpr size_t OFF_CUM = OFF_FLOG + (size_t)32768 * 4 * 4;
constexpr size_t OFF_KXA = OFF_CUM + (size_t)32768 * 4 * 4;
constexpr size_t OFF_VXA = OFF_KXA + (size_t)2048 * 256 * 2;
constexpr size_t OFF_XQ = OFF_VXA + (size_t)2048 * 256 * 2;
constexpr size_t OFF_OXA = OFF_XQ + (size_t)32768 * 256 * 2;
constexpr size_t OFF_STATS = OFF_OXA + (size_t)32768 * 256 * 2;
constexpr size_t WS_TOTAL = OFF_STATS + (size_t)32768 * 2 * 4;
constexpr size_t OFF_HID = OFF_PROJ;
constexpr size_t OFF_MERGED = OFF_PROJ;

constexpr int LDS_ROW = 144;
constexpr int TILE_B = 128 * LDS_ROW;
constexpr int SM_ROWSS = 2 * TILE_B;
constexpr int ARING = 66560;
constexpr int XBST = 77216;
constexpr int SMEM_BYTES = XBST + 16;
constexpr int ALUT = ARING, AIMP = ALUT + 2176, ASEL = AIMP + 8192, AITEM = ASEL + 256;
template <int DK> struct RingGeo { static constexpr int AVO = DK == 64 ? 8192 : 12288, ACO = AVO + 8192, STRIDE = DK == 64 ? 16640 : 20992; };
static_assert(4 * 16640 <= ARING && 3 * 20992 <= ARING, "ring");
static_assert(AITEM + 16 <= XBST, "LDS map");


#define XB_TMO      128
#define XB_XCNT(j)  (256  + 64 * (j))
#define XB_XSUB(j)  (1280 + 64 * (j))
#define XB_XGEN(j)  (2304 + 64 * (j))
#define XB_TOP      3328
#define XB_TOPGEN   3392
#define XCD_BAR_WORDS 3456
#define XB_SPIN_CAP (1u << 18)
#define LAS __attribute__((address_space(3)))
DEVI unsigned xb_ld(unsigned* p) { return __hip_atomic_load(p, __ATOMIC_RELAXED, __HIP_MEMORY_SCOPE_AGENT); }
DEVI unsigned xb_add(unsigned* p, unsigned v) { return __hip_atomic_fetch_add(p, v, __ATOMIC_RELAXED, __HIP_MEMORY_SCOPE_AGENT); }
DEVI unsigned xb_xcc_id() { return (unsigned)__builtin_amdgcn_s_getreg((3 << 11) | 20) & 0xFu; }
#define XB_SPIN(cond, bar) do { unsigned _sp = 0; while (cond) { __builtin_amdgcn_s_sleep(1); \
    if ((++_sp & 255u) == 0u) { if (xb_ld(&(bar)[XB_TMO])) break; if (_sp > XB_SPIN_CAP) { atomicAdd(&(bar)[XB_TMO], 1u); break; } } } } while (0)
struct XcdBarrier { unsigned* bar; unsigned x; volatile LAS unsigned* st; };
DEVI XcdBarrier xcd_barrier_post(unsigned* bar, volatile LAS unsigned* st) {
  XcdBarrier b; b.bar = bar; b.x = xb_xcc_id(); b.st = st;
  if (opaque_tid() == 0) (void)xb_add(&bar[XB_XCNT(b.x)], 1u);
  return b;
}
DEVI void xcd_barrier_complete(unsigned* bar, unsigned x, unsigned& nloc, unsigned& nx) {
  const unsigned G = gridDim.x * gridDim.y * gridDim.z;
  unsigned sum, cnt, mine, sp = 0u;
  for (;;) {
    sum = 0u; cnt = 0u; mine = 0u;
#pragma unroll
    for (unsigned j = 0; j < 16; ++j) { const unsigned c = xb_ld(&bar[XB_XCNT(j)]); sum += c; cnt += (c > 0u) ? 1u : 0u; mine = (j == x) ? c : mine; }
    if (sum == G) break;
    __builtin_amdgcn_s_sleep(1);
    if ((++sp & 255u) == 0u) { if (xb_ld(&bar[XB_TMO])) break; if (sp > XB_SPIN_CAP) { atomicAdd(&bar[XB_TMO], 1u); break; } }
  }
  nloc = mine > 0u ? mine : 1u; nx = cnt > 0u ? cnt : 1u;
}
DEVI void xcd_barrier(const XcdBarrier& b) {
  asm volatile("s_waitcnt vmcnt(0)" ::: "memory");
  __syncthreads();
  if (opaque_tid() == 0) {
    unsigned* bar = b.bar;
    __builtin_amdgcn_s_waitcnt(0);
    unsigned nloc = b.st[0], nx = b.st[1];
    if (nloc == 0u) { xcd_barrier_complete(bar, b.x, nloc, nx); b.st[0] = nloc; b.st[1] = nx; }
    const unsigned old = xb_add(&bar[XB_XSUB(b.x)], 1u);
    const unsigned gen = old / nloc;
    if (old + 1u == (gen + 1u) * nloc) {
      __builtin_amdgcn_fence(__ATOMIC_RELEASE, "agent");
      asm volatile("s_waitcnt vmcnt(0)" ::: "memory");
      const unsigned og = xb_add(&bar[XB_TOP], 1u);
      const unsigned tg = og / nx;
      if (og + 1u == (tg + 1u) * nx) xb_add(&bar[XB_TOPGEN], 1u);
      else XB_SPIN(xb_ld(&bar[XB_TOPGEN]) == tg, bar);
      __builtin_amdgcn_fence(__ATOMIC_ACQUIRE, "agent");
      xb_add(&bar[XB_XGEN(b.x)], 1u);
      asm volatile("s_waitcnt vmcnt(0)" ::: "memory");
    } else {
      XB_SPIN(xb_ld(&bar[XB_XGEN(b.x)]) == gen, bar);
      __builtin_amdgcn_fence(__ATOMIC_ACQUIRE, "agent");
      asm volatile("s_waitcnt vmcnt(0)" ::: "memory");
    }
  }
  __syncthreads();
}

struct Params {
  const float* in[24];
  float* out;
  char* ws;
};

__device__ const unsigned char T5BUCKET[128] = {
  0, 1, 2, 3, 4, 5, 6, 7, 8, 9, 10, 11, 12, 13, 14, 15, 16, 16, 16, 17, 17, 18, 18, 18, 19, 19, 19, 20, 20, 20, 20, 21,
  21, 21, 21, 22, 22, 22, 22, 22, 23, 23, 23, 23, 23, 23, 24, 24, 24, 24, 24, 24, 25, 25, 25, 25, 25, 25, 25, 26, 26, 26, 26, 26,
  26, 26, 26, 27, 27, 27, 27, 27, 27, 27, 27, 27, 27, 28, 28, 28, 28, 28, 28, 28, 28, 28, 28, 29, 29, 29, 29, 29, 29, 29, 29, 29,
  29, 29, 29, 30, 30, 30, 30, 30, 30, 30, 30, 30, 30, 30, 30, 30, 30, 31, 31, 31, 31, 31, 31, 31, 31, 31, 31, 31, 31, 31, 31, 31};

struct RowLinear { long ld; DEVI long operator()(int r) const { return (long)r * ld; } };
struct RowCmp {
  int colbase;
  DEVI long operator()(int r) const {
    int bg = r >> 8, c = r & 255; if (c > 254) c = 254;
    int b = bg >> 1, g = bg & 1;
    return ((long)(b * 4096 + c * 16)) * PROJ_LD + colbase + g * 64;
  }
};

DEVI float sumsq8(u32x4 v) {
  float s = 0.f;
  unsigned w[4] = {v[0], v[1], v[2], v[3]};
#pragma unroll
  for (int i = 0; i < 4; ++i) { float a = bf2f(w[i] & 0xffffu), b = __uint_as_float(w[i] & 0xffff0000u); s += a * a + b * b; }
  return s;
}

template <bool ROWSS, int NF, class ARow>
DEVI void gemm_mainloop_t(f32x4 (&acc)[4][NF], const bf16* __restrict__ A, ARow arow, int kstrideA,
                          const bf16* __restrict__ Bt, int ldb, int K, int m0, int n0, char* smem) {
  constexpr int NBI = NF;
  char* As = smem; char* Bs = smem + TILE_B;
  const int tid = opaque_tid(), lane = tid & 63, wid = tid >> 6, wr = wid >> 1, wc = wid & 1, fr = lane & 15, fq = lane >> 4;
  const int lrow = tid >> 3, lkc = tid & 7;
  unsigned aoff[4], boff[NBI];
#pragma unroll
  for (int i = 0; i < 4; ++i) aoff[i] = (unsigned)(arow(m0 + lrow + 32 * i) + lkc * 8);
#pragma unroll
  for (int i = 0; i < NBI; ++i) boff[i] = (unsigned)((n0 + lrow + 32 * i) * ldb + lkc * 8);
  u32x4 ra[4], rb[NBI];
  float ss[4] = {0.f, 0.f, 0.f, 0.f};
  const int nk = K >> 6;
#pragma unroll
  for (int i = 0; i < 4; ++i) ra[i] = *(const u32x4*)(A + aoff[i]);
#pragma unroll
  for (int i = 0; i < NBI; ++i) rb[i] = *(const u32x4*)(Bt + boff[i]);
  for (int kt = 0; kt < nk; ++kt) {
    __syncthreads();
#pragma unroll
    for (int i = 0; i < 4; ++i) {
      *(u32x4*)(As + (lrow + 32 * i) * LDS_ROW + lkc * 16) = ra[i];
      if (ROWSS) ss[i] += sumsq8(ra[i]);
    }
#pragma unroll
    for (int i = 0; i < NBI; ++i) *(u32x4*)(Bs + (lrow + 32 * i) * LDS_ROW + lkc * 16) = rb[i];
    __syncthreads();
    if (kt + 1 < nk) {
      const unsigned ka = (unsigned)((kt + 1) * kstrideA), kb = (unsigned)((kt + 1) * 64);
#pragma unroll
      for (int i = 0; i < 4; ++i) ra[i] = *(const u32x4*)(A + (aoff[i] + ka));
#pragma unroll
      for (int i = 0; i < NBI; ++i) rb[i] = *(const u32x4*)(Bt + (boff[i] + kb));
    }
#pragma unroll
    for (int ks = 0; ks < 2; ++ks) {
      bf16x8 af[4], bfr[NF];
#pragma unroll
      for (int m = 0; m < 4; ++m) af[m] = *(const bf16x8*)(As + (wr * 64 + m * 16 + fr) * LDS_ROW + ks * 64 + fq * 16);
#pragma unroll
      for (int n = 0; n < NF; ++n) bfr[n] = *(const bf16x8*)(Bs + (wc * 16 * NF + n * 16 + fr) * LDS_ROW + ks * 64 + fq * 16);
#pragma unroll
      for (int m = 0; m < 4; ++m)
#pragma unroll
        for (int n = 0; n < NF; ++n) acc[m][n] = __builtin_amdgcn_mfma_f32_16x16x32_bf16(af[m], bfr[n], acc[m][n], 0, 0, 0);
    }
  }
  if (ROWSS) {
    float* rowss = (float*)(smem + SM_ROWSS);
#pragma unroll
    for (int i = 0; i < 4; ++i) {
      float s = ss[i];
      s += __shfl_xor(s, 1); s += __shfl_xor(s, 2); s += __shfl_xor(s, 4);
      if (lkc == 0) rowss[lrow + 32 * i] = s;
    }
    __syncthreads();
  }
}
template <bool ROWSS, class ARow>
DEVI void gemm_mainloop(f32x4 (&acc)[4][4], const bf16* __restrict__ A, ARow arow, int kstrideA,
                        const bf16* __restrict__ Bt, int ldb, int K, int m0, int n0, char* smem) {
  gemm_mainloop_t<ROWSS, 4>(acc, A, arow, kstrideA, Bt, ldb, K, m0, n0, smem);
}

DEVI int k_rot(int mt, int nt, int nk) { return (((mt & 7) + (nt & 7)) & 7) * nk >> 3; }

template <int NF, class ARow>
DEVI void gemm_prefetch0(const bf16* __restrict__ A, ARow arow, const bf16* __restrict__ Bt, int ldb, int m0, int n0, char* smem, int koff = 0) {
  const int tid = opaque_tid();
  const int lrow = tid >> 3, lpos = tid & 7;
  const int gch = (lpos ^ (lrow & 7)) * 8 + koff * 64;
  char* ab = smem + tid * 16;
#pragma unroll
  for (int i = 0; i < 4; ++i)
    __builtin_amdgcn_global_load_lds((const unsigned*)(A + (unsigned)(arow(m0 + lrow + 32 * i) + gch)), (unsigned*)(ab + i * 4096), 16, 0, 0);
#pragma unroll
  for (int i = 0; i < NF; ++i)
    __builtin_amdgcn_global_load_lds((const unsigned*)(Bt + (unsigned)((n0 + lrow + 32 * i) * ldb + gch)), (unsigned*)(ab + 16384 + i * 4096), 16, 0, 0);
}

template <int NF, bool SWAP, class ARow, bool PRE = false, bool DEEP = false>
DEVI void gemm_mainloop_g(f32x4 (&acc)[4][NF], const bf16* __restrict__ A, ARow arow, int kstrideA,
                          const bf16* __restrict__ Bt, int ldb, int K, int m0, int n0, char* smem, int koff = 0) {
  const int tid = opaque_tid(), lane = tid & 63, wid = tid >> 6, wr = wid >> 1, wc = wid & 1, fr = lane & 15, fq = lane >> 4;
  const int lrow = tid >> 3, lpos = tid & 7;
  const int gch = (lpos ^ (lrow & 7)) * 8;
  unsigned aoff[4], boff[NF];
#pragma unroll
  for (int i = 0; i < 4; ++i) aoff[i] = (unsigned)(arow(m0 + lrow + 32 * i) + gch);
#pragma unroll
  for (int i = 0; i < NF; ++i) boff[i] = (unsigned)((n0 + lrow + 32 * i) * ldb + gch);
  const int nk = K >> 6;
  if (!PRE) __syncthreads();
#define GL_ISSUE(KT, BUF)                                                                                  \
  {                                                                                                        \
    char* ab = smem + (BUF) * 32768 + tid * 16;                                                            \
    const int kr_ = ((KT) + koff) & (nk - 1);                                                              \
    const unsigned ka = (unsigned)(kr_ * kstrideA), kb = (unsigned)(kr_ * 64);                             \
    _Pragma("unroll") for (int i = 0; i < 4; ++i)                                                          \
      __builtin_amdgcn_global_load_lds((const unsigned*)(A + (aoff[i] + ka)), (unsigned*)(ab + i * 4096), 16, 0, 0); \
    _Pragma("unroll") for (int i = 0; i < NF; ++i)                                                         \
      __builtin_amdgcn_global_load_lds((const unsigned*)(Bt + (boff[i] + kb)), (unsigned*)(ab + 16384 + i * 4096), 16, 0, 0); \
  }
  if (!PRE) GL_ISSUE(0, 0)
  asm volatile("s_waitcnt vmcnt(0)" ::: "memory");
  __syncthreads();
  const int swz = fr & 7;
  for (int kt = 0; kt < nk; ++kt) {
    if (kt + 1 < nk) GL_ISSUE(kt + 1, (kt + 1) & 1)
    const char* As = smem + (kt & 1) * 32768;
    const char* Bs = As + 16384;
    if (DEEP) {
    bf16x8 af[2][4], bfr[2][NF];
#pragma unroll
    for (int ks = 0; ks < 2; ++ks) {
      const int co = ((ks * 4 + fq) ^ swz) * 16;
#pragma unroll
      for (int m = 0; m < 4; ++m) af[ks][m] = *(const bf16x8*)(As + (wr * 64 + m * 16 + fr) * 128 + co);
#pragma unroll
      for (int n = 0; n < NF; ++n) bfr[ks][n] = *(const bf16x8*)(Bs + (wc * 16 * NF + n * 16 + fr) * 128 + co);
    }
    __builtin_amdgcn_s_setprio(1);
#pragma unroll
    for (int ks = 0; ks < 2; ++ks)
#pragma unroll
      for (int m = 0; m < 4; ++m)
#pragma unroll
        for (int n = 0; n < NF; ++n) {
          if (SWAP) acc[m][n] = __builtin_amdgcn_mfma_f32_16x16x32_bf16(bfr[ks][n], af[ks][m], acc[m][n], 0, 0, 0);
          else acc[m][n] = __builtin_amdgcn_mfma_f32_16x16x32_bf16(af[ks][m], bfr[ks][n], acc[m][n], 0, 0, 0);
        }
    __builtin_amdgcn_s_setprio(0);
    __builtin_amdgcn_sched_group_barrier(0x100, 4 + NF, 0);
#pragma unroll
    for (int i = 0; i < 4 + NF; ++i) { __builtin_amdgcn_sched_group_barrier(0x008, 2, 0); __builtin_amdgcn_sched_group_barrier(0x100, 1, 0); }
    __builtin_amdgcn_sched_group_barrier(0x008, 8 * NF - 2 * (4 + NF), 0);
    } else {
#pragma unroll
    for (int ks = 0; ks < 2; ++ks) {
      const int co = ((ks * 4 + fq) ^ swz) * 16;
      bf16x8 af[4], bfr[NF];
#pragma unroll
      for (int m = 0; m < 4; ++m) af[m] = *(const bf16x8*)(As + (wr * 64 + m * 16 + fr) * 128 + co);
#pragma unroll
      for (int n = 0; n < NF; ++n) bfr[n] = *(const bf16x8*)(Bs + (wc * 16 * NF + n * 16 + fr) * 128 + co);
      __builtin_amdgcn_s_setprio(1);
#pragma unroll
      for (int m = 0; m < 4; ++m)
#pragma unroll
        for (int n = 0; n < NF; ++n) {
          if (SWAP) acc[m][n] = __builtin_amdgcn_mfma_f32_16x16x32_bf16(bfr[n], af[m], acc[m][n], 0, 0, 0);
          else acc[m][n] = __builtin_amdgcn_mfma_f32_16x16x32_bf16(af[m], bfr[n], acc[m][n], 0, 0, 0);
        }
      __builtin_amdgcn_s_setprio(0);
    }
    }
    asm volatile("s_waitcnt vmcnt(0)" ::: "memory");
    __syncthreads();
  }
#undef GL_ISSUE
}

template <int NF, bool SWAP, class ARow>
DEVI void gemm_mainloop_r(f32x4 (&acc)[4][NF], const bf16* __restrict__ A, ARow arow, int kstrideA,
                          const bf16* __restrict__ Bt, int ldb, int K, int m0, int n0, char* smem) {
  constexpr int NBI = NF / 2;
  const int tid = opaque_tid(), lane = tid & 63, wid = tid >> 6, wr = wid >> 1, wc = wid & 1, fr = lane & 15, fq = lane >> 4;
  const int lrow = tid >> 2, lpos = tid & 3;
  const int gch = (lpos ^ ((4 - ((lrow >> 2) & 3)) & 3)) * 8;
  unsigned aoff[2], boff[NBI];
#pragma unroll
  for (int i = 0; i < 2; ++i) aoff[i] = (unsigned)(arow(m0 + lrow + 64 * i) + gch);
#pragma unroll
  for (int i = 0; i < NBI; ++i) boff[i] = (unsigned)((n0 + lrow + 64 * i) * ldb + gch);
  const int nh = K >> 5;
  __syncthreads();
#define GR_ISSUE(H)                                                                                        \
  {                                                                                                        \
    char* ab = smem + ((H) & 3) * 16384 + tid * 16;                                                        \
    const unsigned ka = (unsigned)(((H) >> 1) * kstrideA + ((H) & 1) * 32), kb = (unsigned)((H) * 32);     \
    _Pragma("unroll") for (int i = 0; i < 2; ++i)                                                          \
      __builtin_amdgcn_global_load_lds((const unsigned*)(A + (aoff[i] + ka)), (unsigned*)(ab + i * 4096), 16, 0, 0); \
    _Pragma("unroll") for (int i = 0; i < NBI; ++i)                                                        \
      __builtin_amdgcn_global_load_lds((const unsigned*)(Bt + (boff[i] + kb)), (unsigned*)(ab + 8192 + i * 4096), 16, 0, 0); \
  }
  GR_ISSUE(0) GR_ISSUE(1) GR_ISSUE(2)
  const int co = (fq ^ ((4 - ((fr >> 2) & 3)) & 3)) * 16;
  for (int h = 0; h < nh; ++h) {
    if (h + 2 < nh) { if (NF == 4) asm volatile("s_waitcnt vmcnt(8)" ::: "memory"); else asm volatile("s_waitcnt vmcnt(6)" ::: "memory"); }
    else if (h + 1 < nh) { if (NF == 4) asm volatile("s_waitcnt vmcnt(4)" ::: "memory"); else asm volatile("s_waitcnt vmcnt(3)" ::: "memory"); }
    else asm volatile("s_waitcnt vmcnt(0)" ::: "memory");
    __builtin_amdgcn_s_barrier();
    if (h + 3 < nh) GR_ISSUE(h + 3)
    const char* As = smem + (h & 3) * 16384;
    const char* Bs = As + 8192;
    bf16x8 af[4], bfr[NF];
#pragma unroll
    for (int m = 0; m < 4; ++m) af[m] = *(const bf16x8*)(As + (wr * 64 + m * 16 + fr) * 64 + co);
#pragma unroll
    for (int n = 0; n < NF; ++n) bfr[n] = *(const bf16x8*)(Bs + (wc * 16 * NF + n * 16 + fr) * 64 + co);
#pragma unroll
    for (int m = 0; m < 4; ++m)
#pragma unroll
      for (int n = 0; n < NF; ++n) {
        if (SWAP) acc[m][n] = __builtin_amdgcn_mfma_f32_16x16x32_bf16(bfr[n], af[m], acc[m][n], 0, 0, 0);
        else acc[m][n] = __builtin_amdgcn_mfma_f32_16x16x32_bf16(af[m], bfr[n], acc[m][n], 0, 0, 0);
      }
  }
#undef GR_ISSUE
  __syncthreads();
}

DEVI void zero_acc(f32x4 (&acc)[4][4]) {
#pragma unroll
  for (int m = 0; m < 4; ++m)
#pragma unroll
    for (int n = 0; n < 4; ++n) acc[m][n] = f32x4{0.f, 0.f, 0.f, 0.f};
}

DEVI void tile_swz(int t, int MT, int NT, int& mt, int& nt) {
#if SWZ_MODE == 1
  mt = t / NT; nt = t - mt * NT; return;
#elif SWZ_MODE == 2
  nt = t / MT; mt = t - nt * MT; return;
#endif
  int per = (MT * NT) >> 3;
  int v = (t & 7) * per + (t >> 3);
  int band = v / (8 * NT);
  int w = v - band * 8 * NT;
  mt = band * 8 + (w & 7);
  nt = w >> 3;
}

DEVI void store_rm(const f32x4 (&acc)[4][4], bf16* dst, long ld, int m0, int n0) {
  const int tid = opaque_tid(), lane = tid & 63, wid = tid >> 6, wr = wid >> 1, wc = wid & 1, fr = lane & 15, fq = lane >> 4;
#pragma unroll
  for (int m = 0; m < 4; ++m)
#pragma unroll
    for (int j = 0; j < 4; ++j) {
      bf16* rp = dst + (long)(m0 + wr * 64 + m * 16 + fq * 4 + j) * ld + n0 + wc * 64 + fr;
#pragma unroll
      for (int n = 0; n < 4; ++n) rp[n * 16] = f2bf(acc[m][n][j]);
    }
}

DEVI void store_rm_sw(const f32x4 (&acc)[4][4], bf16* dst, long ld, int m0, int n0) {
  const int tid = opaque_tid(), lane = tid & 63, wid = tid >> 6, wr = wid >> 1, wc = wid & 1, fr = lane & 15, fq = lane >> 4;
  const int cofs = (fq & 1) * 16 + (fq & 2) * 4;
#pragma unroll
  for (int m = 0; m < 4; ++m) {
    bf16* rp = dst + (long)(m0 + wr * 64 + m * 16 + fr) * ld + n0 + wc * 64 + cofs;
#pragma unroll
    for (int n = 0; n < 4; n += 2) {
      const unsigned x0 = pack2(acc[m][n][0], acc[m][n][1]), x1 = pack2(acc[m][n][2], acc[m][n][3]);
      const unsigned y0 = pack2(acc[m][n + 1][0], acc[m][n + 1][1]), y1 = pack2(acc[m][n + 1][2], acc[m][n + 1][3]);
      const u32x2 s0 = __builtin_amdgcn_permlane16_swap(x0, y0, false, false);
      const u32x2 s1 = __builtin_amdgcn_permlane16_swap(x1, y1, false, false);
      *(u32x4*)(rp + n * 16) = u32x4{s0[0], s1[0], s0[1], s1[1]};
    }
  }
}

DEVI void store_tr_wave(const f32x4 (&acc)[4][4], bf16* dstplane, long rowlen, int pos0  ) {
  const int lane = opaque_tid() & 63, fr = lane & 15, fq = lane >> 4;
#pragma unroll
  for (int m = 0; m < 4; ++m)
#pragma unroll
    for (int n = 0; n < 4; n += 2) {
      const unsigned x0 = pack2(acc[m][n][0], acc[m][n][1]), x1 = pack2(acc[m][n][2], acc[m][n][3]);
      const unsigned y0 = pack2(acc[m][n + 1][0], acc[m][n + 1][1]), y1 = pack2(acc[m][n + 1][2], acc[m][n + 1][3]);
      const u32x2 s0 = __builtin_amdgcn_permlane16_swap(x0, y0, false, false);
      const u32x2 s1 = __builtin_amdgcn_permlane16_swap(x1, y1, false, false);
      *(u32x4*)(dstplane + (long)((n + (fq & 1)) * 16 + fr) * rowlen + pos0 + m * 16 + (fq & 2) * 4) = u32x4{s0[0], s1[0], s0[1], s1[1]};
    }
}

DEVI void rope_sincos(int t, int i, float& sn, float& cs) {
  float inv = __powf(10000.f, -(float)i * (1.f / 16.f));
  float ang = (float)t * inv;
  float k = rintf(ang * 0.15915494309189535f);
  float r = fmaf(-k, 6.28125f, ang);
  r = fmaf(-k, 1.9353071795864769e-3f, r);
  sn = __sinf(r); cs = __cosf(r);
}

DEVI int win_srccol(int n) {
  if (n < 1280) return n;
  if (n < 1664) return 1304 + (n - 1280);
  if (n < 1792) return 1688 + (n - 1664);
  if (n < 2560) return 1848 + (n - 1792);
  if (n < 2592) return 1816 + (n - 2560);
  if (n < 2616) return 1280 + (n - 2592);
  if (n < 2620) return n;
  return -1;
}

template <int MODE>
DEVI void prep_transpose(const float* __restrict__ src, int ldsrc, int K, int Ndst, bf16* __restrict__ dst,
                         const float* __restrict__ kscale, char* smem, int rot) {
  float(*tile)[65] = (float(*)[65])smem;
  const int tid = opaque_tid();
  const int KT = K >> 6, NTL = Ndst >> 6, ntiles = KT * NTL;
  const int c4 = (tid & 15) * 4, r16 = tid >> 4;
  int start = (int)blockIdx.x - rot; if (start < 0) start += gridDim.x;
  for (int t = start; t < ntiles; t += gridDim.x) {
    int kt = t % KT, nt = t / KT;
    int n = nt * 64 + c4;
    int sc = MODE == 1 ? win_srccol(n) : n;
    __syncthreads();
#pragma unroll
    for (int i = 0; i < 4; ++i) {
      int k = i * 16 + r16;
      f32x4 v = f32x4{0.f, 0.f, 0.f, 0.f};
      if (sc >= 0) v = *(const f32x4*)(src + (long)(kt * 64 + k) * ldsrc + sc);
      if (kscale) v *= kscale[kt * 64 + k];
      tile[k][c4] = v[0]; tile[k][c4 + 1] = v[1]; tile[k][c4 + 2] = v[2]; tile[k][c4 + 3] = v[3];
    }
    __syncthreads();
    int nn = tid >> 2, kq = tid & 3;
    unsigned w[8];
#pragma unroll
    for (int e = 0; e < 8; ++e) w[e] = pack2(tile[kq * 16 + 2 * e][nn], tile[kq * 16 + 2 * e + 1][nn]);
    u32x4* dp = (u32x4*)(dst + (long)(nt * 64 + nn) * K + kt * 64 + kq * 16);
    dp[0] = u32x4{w[0], w[1], w[2], w[3]};
    dp[1] = u32x4{w[4], w[5], w[6], w[7]};
  }
}

DEVI void phase_prep(const Params& p, int L, char* smem) {
  char* ws = opaque_ptr(p.ws);
  const int G = gridDim.x;
  int rot = 0;
#define PREP(MODE, SRC, LDS_, KK, ND, DST, SC) \
  { prep_transpose<MODE>(SRC, LDS_, KK, ND, (bf16*)(ws + DST), SC, smem, rot); rot = (rot + ((KK) >> 6) * ((ND) >> 6)) % G; }
  PREP(1, p.in[2] + (size_t)L * 1024 * 2620, 2620, 1024, 2688, OFF_WIN, nullptr)
  PREP(0, p.in[12] + (size_t)L * 1024 * 3072, 3072, 1024, 3072, OFF_WG, nullptr)
  PREP(0, p.in[13] + (size_t)L * 512 * 1024, 1024, 512, 1024, OFF_WBN, nullptr)
  PREP(0, p.in[14] + (size_t)L * 256 * 1024, 1024, 256, 1024, OFF_WBM, nullptr)
  PREP(0, p.in[15] + (size_t)L * 256 * 1024, 1024, 256, 1024, OFF_WBF, nullptr)
  PREP(0, p.in[16] + (size_t)L * 1024 * 1024, 1024, 1024, 1024, OFF_WOUT, nullptr)
  PREP(0, p.in[17] + (size_t)L * 1024 * 256, 256, 1024, 256, OFF_WXQ, nullptr)
  PREP(0, p.in[18] + (size_t)L * 1024 * 512, 512, 1024, 512, OFF_WXKV, nullptr)
  PREP(0, p.in[19] + (size_t)L * 256 * 1024, 1024, 256, 1024, OFF_WXO, nullptr)
  PREP(0, p.in[20] + (size_t)L * 1024 * 4096, 4096, 1024, 4096, OFF_WUP, nullptr)
  PREP(0, p.in[21] + (size_t)L * 4096 * 1024, 1024, 4096, 1024, OFF_WDN, nullptr)
  PREP(0, p.in[8] + (size_t)L * 384 * 384, 384, 384, 384, OFF_WUQ, p.in[7] + L * 384)
  PREP(0, p.in[10] + (size_t)L * 128 * 512, 512, 128, 512, OFF_WUKV, p.in[9] + L * 128)
  PREP(0, p.in[4] + (size_t)(L * 2 + 0) * 2048 * 128, 128, 2048, 128, OFF_WC1, nullptr)
  PREP(0, p.in[4] + (size_t)(L * 2 + 1) * 2048 * 128, 128, 2048, 128, OFF_WC1 + (size_t)128 * 2048 * 2, nullptr)
  PREP(0, p.in[5] + (size_t)(L * 2 + 0) * 128 * 64, 64, 128, 64, OFF_WC2, nullptr)
  PREP(0, p.in[5] + (size_t)(L * 2 + 1) * 128 * 64, 64, 128, 64, OFF_WC2 + (size_t)64 * 128 * 2, nullptr)
#undef PREP
  {
    int bsel = (int)blockIdx.x - (G - 64);
    if (bsel >= 0) {
      const int tid = opaque_tid();
      const int kv = bsel >> 5, chunk = bsel & 31;
      const float* pe = p.in[3] + (size_t)(L * 2 + kv) * 2048 + chunk * 64;
      const float* w1 = p.in[4] + (size_t)(L * 2 + kv) * 2048 * 128 + (size_t)chunk * 64 * 128;
      int n = tid & 127, half = tid >> 7;
      float s = 0.f;
#pragma unroll 8
      for (int k = half * 32; k < half * 32 + 32; ++k) s += pe[k] * w1[(long)k * 128 + n];
      float* red = (float*)smem;
      __syncthreads();
      red[tid] = s;
      __syncthreads();
      if (tid < 128) ((float*)(ws + OFF_B1))[(kv * 32 + chunk) * 128 + tid] = red[tid] + red[tid + 128];
      __syncthreads();
    }
  }
  if (L == 0) {
    const long gt = (long)blockIdx.x * 256 + opaque_tid(), gn = (long)G * 256;
    const f32x4* xs = (const f32x4*)p.in[0];
    f32x4* xo = (f32x4*)p.out;
    u32x2* xb = (u32x2*)(ws + OFF_XB);
    for (long i = gt; i < (long)T_TOK * 1024 / 4; i += gn) {
      f32x4 v = xs[i]; xo[i] = v;
      xb[i] = u32x2{pack2(v[0], v[1]), pack2(v[2], v[3])};
    }
    const f32x4* ms = (const f32x4*)p.in[1];
    u32x2* mb = (u32x2*)(ws + OFF_MEMB);
    for (long i = gt; i < (long)2048 * 1024 / 4; i += gn) {
      f32x4 v = ms[i];
      mb[i] = u32x2{pack2(v[0], v[1]), pack2(v[2], v[3])};
    }
  }
}

DEVI void epi_proj(const Params& p, int L, f32x4 (&acc)[4][4], int m0, int nt) {
  char* ws = opaque_ptr(p.ws);
  const int tid = opaque_tid(), lane = tid & 63, wid = tid >> 6, wr = wid >> 1, wc = wid & 1, fr = lane & 15, fq = lane >> 4;
  const int mbase = m0 + wr * 64;
  if (nt == 7 || nt == 9 || nt == 18 || nt == 19) {
    const int b = mbase >> 12, t0 = mbase & 4095;
    bf16* dstp;
    if (nt == 7) dstp = (bf16*)(ws + OFF_VST) + (long)(b * 2 + wc) * 64 * 4096;
    else if (nt == 9) dstp = (bf16*)(ws + OFF_VWT) + (long)(b * 2 + wc) * 64 * 4096;
    else dstp = (bf16*)(ws + OFF_VFT) + (long)(b * 4 + (nt - 18) * 2 + wc) * 64 * 4096;
    store_tr_wave(acc, dstp, 4096, t0);
  } else if (nt == 20) {
    if (wc == 0) {
      float* mb = (float*)(ws + OFF_XQ);
#pragma unroll
      for (int m = 0; m < 4; ++m)
#pragma unroll
        for (int j = 0; j < 4; ++j) {
          float* rp = mb + (long)(mbase + m * 16 + fq * 4 + j) * 64 + fr;
#pragma unroll
          for (int n = 0; n < 4; ++n) rp[n * 16] = acc[m][n][j];
        }
      if (fr >= 8 && fr < 12) {
        float* flog = (float*)(ws + OFF_FLOG);
        const float bfh = p.in[11][L * 4 + (fr - 8)];
#pragma unroll
        for (int m = 0; m < 4; ++m)
#pragma unroll
          for (int j = 0; j < 4; ++j) {
            const float x = acc[m][3][j] + bfh;
            flog[(long)(mbase + m * 16 + fq * 4 + j) * 4 + (fr - 8)] = fminf(x, 0.f) - log1pf(__expf(-fabsf(x)));
          }
      }
    }
  } else {
    store_rm(acc, (bf16*)(ws + OFF_PROJ), PROJ_LD, m0, nt * 128);
  }
}

DEVI void phase_proj(const Params& p, int L, char* smem) {
  char* ws = opaque_ptr(p.ws);
  const bf16* xb = (const bf16*)(ws + OFF_XB);
  constexpr int NTILE = 256 * 21;
  for (int t = blockIdx.x; t < NTILE + 64; t += gridDim.x) {
    f32x4 acc[4][4];
    zero_acc(acc);
    if (t < NTILE) {
      int mt, nt; tile_swz(t, 256, 21, mt, nt);
      if (nt == 7 || nt == 9 || nt >= 18) {
        gemm_mainloop_g<4, false, RowLinear, false, true>(acc, xb, RowLinear{1024}, 64, (const bf16*)(ws + OFF_WIN), 1024, 1024, mt * 128, nt * 128, smem);
        epi_proj(p, L, acc, mt * 128, nt);
      } else {
        gemm_mainloop_g<4, true, RowLinear, false, true>(acc, xb, RowLinear{1024}, 64, (const bf16*)(ws + OFF_WIN), 1024, 1024, mt * 128, nt * 128, smem);
        store_rm_sw(acc, (bf16*)(ws + OFF_PROJ), PROJ_LD, mt * 128, nt * 128);
      }
    } else {
      int u = t - NTILE; int mt = u >> 2, nt = u & 3;
      GEMM_ML<4, false>(acc, (const bf16*)(ws + OFF_MEMB), RowLinear{1024}, 64, (const bf16*)(ws + OFF_WXKV), 1024, 1024, mt * 128, nt * 128, smem);
      const int wid = opaque_tid() >> 6, wr = wid >> 1, wc = wid & 1;
      if (nt < 2) store_rm(acc, (bf16*)(ws + OFF_KXA), 256, mt * 128, nt * 128);
      else {
        int row0 = mt * 128 + wr * 64; int b = row0 >> 8, mm = row0 & 255;
        int h = (nt - 2) * 2 + wc;
        store_tr_wave(acc, (bf16*)(ws + OFF_VXA) + (long)(b * 4 + h) * 64 * 256, 256, mm);
      }
    }
  }
}

DEVI float gelu_tanh(float x) {
  float u = 0.7978845608028654f * (x + 0.044715f * x * x * x);
  return 0.5f * x * (1.f + tanhf(u));
}

DEVI void phase_derived(const Params& p, int L, char* smem) {
  char* ws = opaque_ptr(p.ws);
  const int tid = opaque_tid(), lane = tid & 63, wid = tid >> 6, wr = wid >> 1, wc = wid & 1, fr = lane & 15, fq = lane >> 4;
  const bf16* proj = (const bf16*)(ws + OFF_PROJ);
  constexpr int N_CMP = 64, N_CUM = 8, N_MISC = 512, N_QUP = 768, N_KVUP = 1024;
  for (int t0_ = blockIdx.x; t0_ < N_CMP + N_CUM + N_MISC + N_QUP + N_KVUP; t0_ += gridDim.x) {
    int t;
    if (t0_ < N_CMP) t = t0_;
    else if (t0_ < N_CMP + N_CUM) t = N_CMP + N_QUP + N_KVUP + (t0_ - N_CMP);
    else if (t0_ < N_CMP + N_CUM + N_MISC) t = N_CMP + N_QUP + N_KVUP + N_CUM + (t0_ - N_CMP - N_CUM);
    else t = N_CMP + (t0_ - N_CMP - N_CUM - N_MISC);
    if (t < N_CMP) {
      const int kv = t >> 5, mt = t & 31;
      f32x4 acc[4][4]; zero_acc(acc);
      GEMM_ML<4, false>(acc, proj, RowCmp{kv ? 640 : 512}, PROJ_LD, (const bf16*)(ws + OFF_WC1) + (long)kv * 128 * 2048, 2048, 2048, mt * 128, 0, smem);
      __syncthreads();
      bf16* Hs = (bf16*)smem;
      const float* b1 = (const float*)(ws + OFF_B1) + kv * 32 * 128;
#pragma unroll
      for (int n = 0; n < 4; ++n) {
        const int col = wc * 64 + n * 16 + fr;
        float bb = 0.f;
#pragma unroll 8
        for (int ch = 0; ch < 32; ++ch) bb += b1[ch * 128 + col];
#pragma unroll
        for (int m = 0; m < 4; ++m)
#pragma unroll
          for (int j = 0; j < 4; ++j) Hs[(wr * 64 + m * 16 + fq * 4 + j) * 136 + col] = f2bf(gelu_tanh(acc[m][n][j] + bb));
      }
      __syncthreads();
      f32x4 a2[4][2];
#pragma unroll
      for (int m = 0; m < 4; ++m) { a2[m][0] = f32x4{0.f, 0.f, 0.f, 0.f}; a2[m][1] = f32x4{0.f, 0.f, 0.f, 0.f}; }
      const bf16* w2 = (const bf16*)(ws + OFF_WC2) + (long)kv * 64 * 128;
#pragma unroll
      for (int ks = 0; ks < 4; ++ks) {
        bf16x8 af[4], bq[2];
#pragma unroll
        for (int m = 0; m < 4; ++m) af[m] = *(const bf16x8*)(Hs + (wr * 64 + m * 16 + fr) * 136 + ks * 32 + fq * 8);
#pragma unroll
        for (int n = 0; n < 2; ++n) bq[n] = *(const bf16x8*)(w2 + (wc * 32 + n * 16 + fr) * 128 + ks * 32 + fq * 8);
#pragma unroll
        for (int m = 0; m < 4; ++m)
#pragma unroll
          for (int n = 0; n < 2; ++n) a2[m][n] = __builtin_amdgcn_mfma_f32_16x16x32_bf16(af[m], bq[n], a2[m][n], 0, 0, 0);
      }
#pragma unroll
      for (int m = 0; m < 4; ++m)
#pragma unroll
        for (int n = 0; n < 2; ++n) {
          const int r0 = mt * 128 + wr * 64 + m * 16 + fq * 4;
          const int col = wc * 32 + n * 16 + fr;
          if (kv == 0) {
            bf16* kc = (bf16*)(ws + OFF_KC);
#pragma unroll
            for (int j = 0; j < 4; ++j) kc[(long)(r0 + j) * 64 + col] = f2bf(a2[m][n][j]);
          } else {
            bf16* vct = (bf16*)(ws + OFF_VCT);
            u32x2 v; v[0] = pack2(a2[m][n][0], a2[m][n][1]); v[1] = pack2(a2[m][n][2], a2[m][n][3]);
            *(u32x2*)(vct + ((long)(r0 >> 8) * 64 + col) * 256 + (r0 & 255)) = v;
          }
        }
    } else if (t < N_CMP + N_QUP) {
      const int u = t - N_CMP; const int mt = u / 3, nt = u - mt * 3;
      f32x4 acc[4][4]; zero_acc(acc);
      gemm_mainloop<true>(acc, proj + 1280, RowLinear{PROJ_LD}, 64, (const bf16*)(ws + OFF_WUQ), 384, 384, mt * 128, nt * 128, smem);
      const float* rowss = (const float*)(smem + SM_ROWSS);
      bf16* qmla = (bf16*)(ws + OFF_QMLA);
      const int nbase = nt * 128 + wc * 64;
#pragma unroll
      for (int m = 0; m < 4; ++m)
#pragma unroll
        for (int j = 0; j < 4; ++j) {
          const int lr = wr * 64 + m * 16 + fq * 4 + j;
          const int row = mt * 128 + lr;
          const float rinv = rsqrtf(rowss[lr] * (1.f / 384.f) + 1e-6f);
          float v[4];
#pragma unroll
          for (int n = 0; n < 4; ++n) v[n] = acc[m][n][j] * rinv;
#pragma unroll
          for (int n = 0; n < 3; ++n) {
            if (((nbase + n * 16) % 96) == 64) {
              float sn, cs; rope_sincos(row & 4095, fr, sn, cs);
              float x1 = v[n], x2 = v[n + 1];
              v[n] = x1 * cs - x2 * sn; v[n + 1] = x1 * sn + x2 * cs;
            }
          }
#pragma unroll
          for (int n = 0; n < 4; ++n) qmla[(long)row * 384 + nbase + n * 16 + fr] = f2bf(v[n]);
        }
    } else if (t < N_CMP + N_QUP + N_KVUP) {
      const int u = t - N_CMP - N_QUP; const int mt = u >> 2, nt = u & 3;
      f32x4 acc[4][4]; zero_acc(acc);
      gemm_mainloop<true>(acc, proj + 1664, RowLinear{PROJ_LD}, 64, (const bf16*)(ws + OFF_WUKV), 128, 128, mt * 128, nt * 128, smem);
      const float* rowss = (const float*)(smem + SM_ROWSS);
#pragma unroll
      for (int m = 0; m < 4; ++m)
#pragma unroll
        for (int j = 0; j < 4; ++j) {
          const float rinv = rsqrtf(rowss[wr * 64 + m * 16 + fq * 4 + j] * (1.f / 128.f) + 1e-6f);
#pragma unroll
          for (int n = 0; n < 4; ++n) acc[m][n][j] *= rinv;
        }
      const int mbase = mt * 128 + wr * 64;
      if (wc == 0) {
        bf16* kmla = (bf16*)(ws + OFF_KMLA);
#pragma unroll
        for (int m = 0; m < 4; ++m)
#pragma unroll
          for (int j = 0; j < 4; ++j) {
            bf16* rp = kmla + (long)(mbase + m * 16 + fq * 4 + j) * 384 + nt * 96 + fr;
#pragma unroll
            for (int n = 0; n < 4; ++n) rp[n * 16] = f2bf(acc[m][n][j]);
          }
      } else {
        const int b = mbase >> 12, t0 = mbase & 4095;
        store_tr_wave(acc, (bf16*)(ws + OFF_VMT) + (long)(b * 4 + nt) * 64 * 4096, 4096, t0);
      }
    } else if (t < N_CMP + N_QUP + N_KVUP + N_CUM) {
      const int u = t - N_CMP - N_QUP - N_KVUP;
      const int seq = u * 4 + wid;
      const int b = seq >> 2, h = seq & 3;
      const float* flog = (const float*)(ws + OFF_FLOG) + (long)b * 4096 * 4 + h;
      float* cum = (float*)(ws + OFF_CUM) + (long)seq * 4096;
      float s = 0.f;
      for (int i = 0; i < 64; ++i) s += flog[(long)(lane * 64 + i) * 4];
      float incl = s;
#pragma unroll
      for (int off = 1; off < 64; off <<= 1) { float o = __shfl_up(incl, off); if (lane >= off) incl += o; }
      float run = incl - s;
      for (int i = 0; i < 64; ++i) { run += flog[(long)(lane * 64 + i) * 4]; cum[lane * 64 + i] = run * LOG2E; }
    } else {
      const int u = t - N_CMP - N_QUP - N_KVUP - N_CUM;
      const int row = u * 64 + (tid >> 2), sub = tid & 3;
      const float* mb = (const float*)(ws + OFF_XQ) + (long)row * 64;
      bf16* kmla = (bf16*)(ws + OFF_KMLA) + (long)row * 384;
      float* gaux = (float*)(ws + OFF_GAUX) + (long)row * 32;
      const int tpos = row & 4095;
#pragma unroll
      for (int q = 0; q < 4; ++q) {
        const int i = sub * 4 + q;
        float sn, cs; rope_sincos(tpos, i, sn, cs);
        const float x1 = mb[i], x2 = mb[16 + i];
        const bf16 y1 = f2bf(x1 * cs - x2 * sn), y2 = f2bf(x1 * sn + x2 * cs);
#pragma unroll
        for (int hh = 0; hh < 4; ++hh) { kmla[hh * 96 + 64 + i] = y1; kmla[hh * 96 + 80 + i] = y2; }
      }
#pragma unroll
      for (int q = 0; q < 6; ++q) { const int gi = sub * 6 + q; gaux[gi] = sigmoidf(mb[32 + gi]); }
    }
  }
}

DEVI float xmax16(float x) {
  u32x2 r = __builtin_amdgcn_permlane16_swap(__float_as_uint(x), __float_as_uint(x), false, false);
  return fmaxf(__uint_as_float(r[0]), __uint_as_float(r[1]));
}
DEVI float xmax32(float x) {
  u32x2 r = __builtin_amdgcn_permlane32_swap(__float_as_uint(x), __float_as_uint(x), false, false);
  return fmaxf(__uint_as_float(r[0]), __uint_as_float(r[1]));
}
template <int CTRL> DEVI float dppf(float v) { return __int_as_float(__builtin_amdgcn_update_dpp(0, __float_as_int(v), CTRL, 0xF, 0xF, true)); }
template <int CTRL> DEVI unsigned dppu(unsigned v) { return (unsigned)__builtin_amdgcn_update_dpp(0, (int)v, CTRL, 0xF, 0xF, true); }
constexpr int DPP_X1 = 0xB1, DPP_X2 = 0x4E, DPP_HM = 0x141, DPP_M = 0x140;
DEVI float quad_sum(float v) { v += dppf<DPP_X1>(v); v += dppf<DPP_X2>(v); return v; }
DEVI float row16_sum(float v) { v = quad_sum(v); v += dppf<DPP_HM>(v); v += dppf<DPP_M>(v); return v; }
DEVI float wave_sum(float v) {
  v = row16_sum(v);
  u32x2 r = __builtin_amdgcn_permlane16_swap(__float_as_uint(v), __float_as_uint(v), false, false);
  v = __uint_as_float(r[0]) + __uint_as_float(r[1]);
  r = __builtin_amdgcn_permlane32_swap(__float_as_uint(v), __float_as_uint(v), false, false);
  return __uint_as_float(r[0]) + __uint_as_float(r[1]);
}
DEVI float max3f(float a, float b, float c) { return fmaxf(fmaxf(a, b), c); }
DEVI float max16(const f32x4& a, const f32x4& b, const f32x4& c, const f32x4& d) {
  const float t0 = max3f(a[0], a[1], a[2]), t1 = max3f(a[3], b[0], b[1]), t2 = max3f(b[2], b[3], c[0]);
  const float t3 = max3f(c[1], c[2], c[3]), t4 = max3f(d[0], d[1], d[2]);
  return fmaxf(max3f(t0, t1, t2), max3f(t3, t4, d[3]));
}
constexpr float DEFER_THR = 8.f;

template <int DK, int MODE, int RBM, class SF, class FF, class POST>
DEVI void attn_tile_body(const bf16x8 (&qf)[2][DK / 32], const char* Ks, const char* Vs, SF& sf, FF& ff, POST& post,
                         int cur, int c0, int c1, float (&m)[2], float (&l)[2], f32x4 (&o)[5][2], int fr, int fq) {
  constexpr int NKC = DK / 32;
  f32x4 s[4][2];
#pragma unroll
  for (int kb = 0; kb < 4; ++kb) { s[kb][0] = f32x4{0.f, 0.f, 0.f, 0.f}; s[kb][1] = f32x4{0.f, 0.f, 0.f, 0.f}; }
#pragma unroll
  for (int ks = 0; ks < NKC; ++ks)
#pragma unroll
    for (int kb = 0; kb < 4; ++kb) {
      const int koff = DK == 64 ? (kb * 16 + fr) * 128 + (((ks * 4 + fq) ^ (fr & 7)) * 16)
                                : (kb * 16 + fr) * 192 + ((ks * 4 + (fq ^ ((fr >> 2) & 3))) * 16);
      bf16x8 kf = *(const bf16x8*)(Ks + koff);
      if (RBM & 1) s[kb][0] = __builtin_amdgcn_mfma_f32_16x16x32_bf16(kf, qf[0][ks], s[kb][0], 0, 0, 0);
      if (RBM & 2) s[kb][1] = __builtin_amdgcn_mfma_f32_16x16x32_bf16(kf, qf[1][ks], s[kb][1], 0, 0, 0);
    }
#pragma unroll
  for (int rb = 0; rb < 2; ++rb) {
    if (!(RBM & (1 << rb))) continue;
    const int cm = rb == 0 ? c0 : c1;
    if (cm == 2) {
      const float cl = ff.cl(rb, cur);
      const float fsc = ff.sc;
      if (FF::HASVEC) {
#pragma unroll
        for (int kb = 0; kb < 4; ++kb) {
          const f32x4 av = ff.vec(kb);
#pragma unroll
          for (int j = 0; j < 4; ++j) s[kb][rb][j] = opq(fmaf(s[kb][rb][j], fsc, av[j]));
        }
      }
      if (MODE == 2) {
        const float c = cl - m[rb];
#pragma unroll
        for (int kb = 0; kb < 4; ++kb)
#pragma unroll
          for (int j = 0; j < 4; ++j) {
            const float e = FF::HASVEC ? opq(s[kb][rb][j] + c) : opq(fmaf(s[kb][rb][j], fsc, c));
            s[kb][rb][j] = opq(fexp2(e) * l[rb]);
          }
      } else if (MODE == 0) {
        float mx = max16(s[0][rb], s[1][rb], s[2][rb], s[3][rb]);
        mx = xmax16(mx); mx = xmax32(mx);
        const float cand = FF::HASVEC ? (mx + cl) : fmaf(mx, fsc, cl);
        if (__builtin_amdgcn_ballot_w64(cand > m[rb] + DEFER_THR) != 0) {
          const float mn = fmaxf(m[rb], cand);
          const float alpha = fexp2(m[rb] - mn);
          m[rb] = mn;
#pragma unroll
          for (int db = 0; db < 5; ++db)
#pragma unroll
            for (int j = 0; j < 4; ++j) o[db][rb][j] = opq(o[db][rb][j] * alpha);
        }
        const float c = cl - m[rb];
#pragma unroll
        for (int kb = 0; kb < 4; ++kb)
#pragma unroll
          for (int j = 0; j < 4; ++j) {
            const float e = FF::HASVEC ? opq(s[kb][rb][j] + c) : opq(fmaf(s[kb][rb][j], fsc, c));
            s[kb][rb][j] = fexp2(e);
          }
      } else {
        float mx = max16(s[0][rb], s[1][rb], s[2][rb], s[3][rb]);
        mx = xmax16(mx); mx = xmax32(mx);
        const float cand = FF::HASVEC ? (mx + cl) : fmaf(mx, fsc, cl);
        const float mn = fmaxf(m[rb], cand);
        const float alpha = fexp2(m[rb] - mn);
        m[rb] = mn;
        const float c = cl - mn;
        float rs0 = 0.f, rs1 = 0.f;
#pragma unroll
        for (int kb = 0; kb < 4; ++kb)
#pragma unroll
          for (int j = 0; j < 4; ++j) {
            const float e = FF::HASVEC ? opq(s[kb][rb][j] + c) : opq(fmaf(s[kb][rb][j], fsc, c));
            const float pv = fexp2(e);
            s[kb][rb][j] = pv;
            if (j & 1) rs1 = opq(rs1 + pv); else rs0 = opq(rs0 + pv);
          }
        l[rb] = fmaf(l[rb], alpha, rs0 + rs1);
      }
      continue;
    }
#pragma unroll
    for (int kb = 0; kb < 4; ++kb)
#pragma unroll
      for (int j = 0; j < 4; ++j) s[kb][rb][j] = sf(rb, kb, j, cur, s[kb][rb][j]);
    if (MODE == 2) {
#pragma unroll
      for (int kb = 0; kb < 4; ++kb)
#pragma unroll
        for (int j = 0; j < 4; ++j) s[kb][rb][j] = fexp2(s[kb][rb][j] - m[rb]) * l[rb];
    } else if (MODE == 0) {
      float mx = max16(s[0][rb], s[1][rb], s[2][rb], s[3][rb]);
      mx = xmax16(mx); mx = xmax32(mx);
      if (__builtin_amdgcn_ballot_w64(mx > m[rb] + DEFER_THR) != 0) {
        const float mn = fmaxf(m[rb], mx);
        const float alpha = fexp2(m[rb] - mn);
        m[rb] = mn;
#pragma unroll
        for (int db = 0; db < 5; ++db)
#pragma unroll
          for (int j = 0; j < 4; ++j) o[db][rb][j] = opq(o[db][rb][j] * alpha);
      }
      const float mm = m[rb];
#pragma unroll
      for (int kb = 0; kb < 4; ++kb)
#pragma unroll
        for (int j = 0; j < 4; ++j) s[kb][rb][j] = fexp2(s[kb][rb][j] - mm);
    } else {
      float mx = -INFINITY;
#pragma unroll
      for (int kb = 0; kb < 4; ++kb)
#pragma unroll
        for (int j = 0; j < 4; ++j) mx = fmaxf(mx, s[kb][rb][j]);
      mx = xmax16(mx); mx = xmax32(mx);
      const float mn = fmaxf(m[rb], mx);
      const float alpha = fexp2(m[rb] - mn);
      m[rb] = mn;
      float rs = 0.f;
#pragma unroll
      for (int kb = 0; kb < 4; ++kb)
#pragma unroll
        for (int j = 0; j < 4; ++j) { float pv = fexp2(s[kb][rb][j] - mn); s[kb][rb][j] = pv; rs += pv; }
      l[rb] = l[rb] * alpha + rs;
    }
  }
  if (MODE == 2) post(cur, s);
  if (MODE != 1) {
    bf16x8 pf[2][2];
#pragma unroll
    for (int rb = 0; rb < 2; ++rb) {
      if (!(RBM & (1 << rb))) continue;
#pragma unroll
      for (int kp2 = 0; kp2 < 2; ++kp2) {
        u32x4 w;
        w[0] = pack2(s[2 * kp2][rb][0], s[2 * kp2][rb][1]); w[1] = pack2(s[2 * kp2][rb][2], s[2 * kp2][rb][3]);
        w[2] = pack2(s[2 * kp2 + 1][rb][0], s[2 * kp2 + 1][rb][1]); w[3] = pack2(s[2 * kp2 + 1][rb][2], s[2 * kp2 + 1][rb][3]);
        pf[rb][kp2] = __builtin_bit_cast(bf16x8, w);
      }
    }
#pragma unroll
    for (int kp2 = 0; kp2 < 2; ++kp2)
#pragma unroll
      for (int db = 0; db < 4; ++db) {
        const char* base = Vs + (db * 16 + fr) * 128 + (fq & 1) * 8;
        const int c = kp2 * 4 + (fq >> 1);
        u32x2 lo = *(const u32x2*)(base + ((c ^ (fr & 7)) * 16));
        u32x2 hi = *(const u32x2*)(base + (((c + 2) ^ (fr & 7)) * 16));
        u32x4 w; w[0] = lo[0]; w[1] = lo[1]; w[2] = hi[0]; w[3] = hi[1];
        bf16x8 vf = __builtin_bit_cast(bf16x8, w);
        if (RBM & 1) o[db][0] = __builtin_amdgcn_mfma_f32_16x16x32_bf16(vf, pf[0][kp2], o[db][0], 0, 0, 0);
        if (RBM & 2) o[db][1] = __builtin_amdgcn_mfma_f32_16x16x32_bf16(vf, pf[1][kp2], o[db][1], 0, 0, 0);
      }
    if (MODE == 0) {
      u32x4 w1; w1[0] = w1[1] = w1[2] = w1[3] = 0x3F803F80u;
      const bf16x8 ones = __builtin_bit_cast(bf16x8, w1);
#pragma unroll
      for (int kp2 = 0; kp2 < 2; ++kp2) {
        if (RBM & 1) o[4][0] = __builtin_amdgcn_mfma_f32_16x16x32_bf16(ones, pf[0][kp2], o[4][0], 0, 0, 0);
        if (RBM & 2) o[4][1] = __builtin_amdgcn_mfma_f32_16x16x32_bf16(ones, pf[1][kp2], o[4][1], 0, 0, 0);
      }
    }
  }
}

template <int DK, int MODE, bool RBSKIP, bool HASCUM, class KP, class VP, class CP, class SF, class FF, class CLS, class POST>
DEVI void attn_run(u64 tiles, u64 wtiles, const bf16x8 (&qf)[2][DK / 32], KP kp, VP vp, CP cp, SF sf, FF ff, CLS cls, POST post,
                   float (&m)[2], float (&l)[2], f32x4 (&o)[5][2], char* smem, const char*& curslot) {
  constexpr int NKC = DK / 32;
  constexpr int CPR = DK / 8;
  const int tid = opaque_tid(), lane = tid & 63, fr = lane & 15, fq = lane >> 4;
  if (tiles == 0) return;
#define ATT_ISSUE(TILE, SLOT)                                                                             \
  {                                                                                                       \
    char* sb = smem + (SLOT) * GEO::STRIDE;                                                               \
    _Pragma("unroll") for (int i = 0; i < NKC; ++i) {                                                     \
      const int q = tid + 256 * i; const int row = q / CPR, pos = q - row * CPR;                          \
      const int gc = DK == 64 ? (pos ^ (row & 7)) : ((pos & ~3) | ((pos & 3) ^ ((row >> 2) & 3)));        \
      __builtin_amdgcn_global_load_lds((const unsigned*)(kp(TILE, row) + gc * 8), (unsigned*)(sb + q * 16), 16, 0, 0); \
    }                                                                                                     \
    if (MODE != 1) {                                                                                      \
      _Pragma("unroll") for (int i = 0; i < 2; ++i) {                                                     \
        const int q = tid + 256 * i; const int d = q >> 3, pos = q & 7;                                   \
        __builtin_amdgcn_global_load_lds((const unsigned*)(vp(TILE, d) + ((pos ^ (d & 7)) * 8)), (unsigned*)(sb + GEO::AVO + q * 16), 16, 0, 0); \
      }                                                                                                   \
    }                                                                                                     \
    if (HASCUM) {                                                                                         \
      if (lane < 16) __builtin_amdgcn_global_load_lds((const unsigned*)(cp(TILE) + lane * 4), (unsigned*)(sb + GEO::ACO + lane * 16), 16, 0, 0); \
    }                                                                                                     \
  }
#define ATT_POP(VAR) { VAR = -1; if (tiles) { VAR = __builtin_ctzll(tiles); tiles &= tiles - 1; } }
#define ATT_COMPUTE(TILE, SLOT)                                                                           \
  if ((wtiles >> (TILE)) & 1) {                                                                           \
    const char* sb = smem + (SLOT) * GEO::STRIDE;                                                         \
    curslot = sb;                                                                                         \
    const int c0 = cls(0, (TILE)), c1 = cls(1, (TILE));                                                   \
    if (RBSKIP) {                                                                                         \
      if (c0) attn_tile_body<DK, MODE, 1>(qf, sb, sb + GEO::AVO, sf, ff, post, (TILE), c0, c1, m, l, o, fr, fq); \
      if (c1) attn_tile_body<DK, MODE, 2>(qf, sb, sb + GEO::AVO, sf, ff, post, (TILE), c0, c1, m, l, o, fr, fq); \
    } else {                                                                                              \
      attn_tile_body<DK, MODE, 3>(qf, sb, sb + GEO::AVO, sf, ff, post, (TILE), c0, c1, m, l, o, fr, fq);  \
    }                                                                                                     \
  }
  using GEO = RingGeo<DK>;
  __syncthreads();
  if (DK == 64) {
    int ta, tb;
    ATT_POP(ta) ATT_ISSUE(ta, 0)
    ATT_POP(tb) if (tb >= 0) ATT_ISSUE(tb, 1)
    int sp = 0;
    for (;;) {
      asm volatile("s_waitcnt vmcnt(0)" ::: "memory");
      __builtin_amdgcn_s_barrier();
      int tc, td = -1;
      ATT_POP(tc)
      if (tc >= 0) { ATT_ISSUE(tc, sp ^ 2) ATT_POP(td) if (td >= 0) ATT_ISSUE(td, (sp ^ 2) + 1) }
      ATT_COMPUTE(ta, sp)
      if (tb >= 0) ATT_COMPUTE(tb, sp + 1)
      if (tc < 0) break;
      ta = tc; tb = td; sp ^= 2;
    }
  } else {
    int cur, n1;
    ATT_POP(cur) ATT_ISSUE(cur, 0)
    ATT_POP(n1) if (n1 >= 0) ATT_ISSUE(n1, 1)
    int si = 0;
    for (;;) {
      if (n1 >= 0) {
        constexpr int G = NKC + (MODE != 1 ? 2 : 0) + (HASCUM ? 1 : 0);
        if (G == 2) asm volatile("s_waitcnt vmcnt(2)" ::: "memory");
        else if (G == 4) asm volatile("s_waitcnt vmcnt(4)" ::: "memory");
        else if (G == 5) asm volatile("s_waitcnt vmcnt(5)" ::: "memory");
        else asm volatile("s_waitcnt vmcnt(0)" ::: "memory");
      } else {
        asm volatile("s_waitcnt vmcnt(0)" ::: "memory");
      }
      __builtin_amdgcn_s_barrier();
      int n2;
      ATT_POP(n2)
      if (n2 >= 0) { const int s2 = si >= 1 ? si - 1 : 2; ATT_ISSUE(n2, s2) }
      ATT_COMPUTE(cur, si)
      if (n1 < 0) break;
      cur = n1; n1 = n2; si = si == 2 ? 0 : si + 1;
    }
  }
#undef ATT_COMPUTE
#undef ATT_POP
#undef ATT_ISSUE
  __syncthreads();
}

template <class CL>
struct FastConst { static constexpr bool HASVEC = false; float sc; CL clf; DEVI float cl(int rb, int tile) const { return clf(rb, tile); } DEVI f32x4 vec(int) const { return f32x4{0.f, 0.f, 0.f, 0.f}; } };
template <class CL, class VF>
struct FastVec { static constexpr bool HASVEC = true; float sc; CL clf; VF vf; DEVI float cl(int rb, int tile) const { return clf(rb, tile); } DEVI f32x4 vec(int kb) const { return vf(kb); } };
template <class CL> DEVI FastConst<CL> make_fast(float sc, CL cl) { return FastConst<CL>{sc, cl}; }
template <class CL, class VF> DEVI FastVec<CL, VF> make_fast_vec(float sc, CL cl, VF vf) { return FastVec<CL, VF>{sc, cl, vf}; }

DEVI float row_lsum(float l) { l += __shfl_xor(l, 16); l += __shfl_xor(l, 32); return l; }

struct NoCum { DEVI const float* operator()(int) const { return nullptr; } };
struct NoPost { DEVI void operator()(int, f32x4 (&)[4][2]) const {} };

DEVI void nsa_item(const Params& p, int b, int g, int t0, char* smem) {
  char* ws = opaque_ptr(p.ws);
  const int tid = opaque_tid(), lane = tid & 63, wid = tid >> 6, fr = lane & 15, fq = lane >> 4;
  const bf16* proj = (const bf16*)(ws + OFF_PROJ);
  float* lut = (float*)(smem + ALUT);
  float* imp = (float*)(smem + AIMP);
  u64* selm = (u64*)(smem + ASEL);
  __syncthreads();
  const float* t5 = p.in[6];
  for (int e = tid; e < 512; e += 256) { int r = e >> 7, d = e & 127; lut[e] = t5[T5BUCKET[d] * 8 + g * 4 + r] * LOG2E; }
  for (int e = tid; e < 2048; e += 256) imp[e] = 0.f;
  const int hl = fr & 3, h = g * 4 + hl;
  int tl[2], t[2];
  tl[0] = wid * 8 + (fr >> 2); tl[1] = tl[0] + 4;
#pragma unroll
  for (int rb = 0; rb < 2; ++rb) t[rb] = t0 + tl[rb];
  bf16x8 qf[2][2];
#pragma unroll
  for (int rb = 0; rb < 2; ++rb)
#pragma unroll
    for (int ks = 0; ks < 2; ++ks) qf[rb][ks] = *(const bf16x8*)(proj + ((long)b * 4096 + t[rb]) * PROJ_LD + h * 64 + ks * 32 + fq * 8);
  const float* gaux = (const float*)(ws + OFF_GAUX);
  f32x4* totl = (f32x4*)(ws + OFF_OXA) + (size_t)blockIdx.x * 8 * 256 + tid;
  const char* curslot = smem;
  const float* lutr = lut + hl * 128;
  const float sc = 0.125f * LOG2E;
  const int uw = __builtin_amdgcn_readfirstlane(wid);
  const int tmin0 = t0 + uw * 8, tmin1 = tmin0 + 4;
  __syncthreads();

  float m[2], l[2]; f32x4 o[5][2];
#define RESET_STATE                                                                                   \
  {                                                                                                   \
    m[0] = m[1] = -1e30f; l[0] = l[1] = 0.f;                                                          \
    _Pragma("unroll") for (int db = 0; db < 5; ++db) { o[db][0] = f32x4{0.f, 0.f, 0.f, 0.f}; o[db][1] = f32x4{0.f, 0.f, 0.f, 0.f}; } \
  }
#define ACCUM_BRANCH(GI, NORMALIZED)                                                                  \
  {                                                                                                   \
    _Pragma("unroll") for (int rb = 0; rb < 2; ++rb) {                                                \
      float f = gaux[((long)b * 4096 + t[rb]) * 32 + h * 3 + GI];                                     \
      if (!(NORMALIZED)) { float ls = o[4][rb][0]; f = ls > 0.f ? f / ls : 0.f; }                     \
      _Pragma("unroll") for (int db = 0; db < 4; ++db) {                                              \
        f32x4* tp = totl + (rb * 4 + db) * 256;                                                       \
        if (GI == 0) *tp = o[db][rb] * f; else *tp = *tp + o[db][rb] * f;                             \
      }                                                                                               \
    }                                                                                                 \
  }

  {
    const bf16* kc = (const bf16*)(ws + OFF_KC) + (long)(b * 2 + g) * 256 * 64;
    const bf16* vct = (const bf16*)(ws + OFF_VCT) + (long)(b * 2 + g) * 64 * 256;
    const int nct = (t0 >> 10) + 1;
    const u64 ctiles = (1ull << nct) - 1;
    auto kpc = [&](int tile, int row) { return kc + (long)(tile * 64 + row) * 64; };
    auto vpc = [&](int tile, int d) { return vct + (long)d * 256 + tile * 64; };
    auto sfc = [&](int rb, int kb, int j, int tile, float s) {
      int cend = (tile * 64 + kb * 16 + fq * 4 + j) * 16 + 31;
      int dist = t[rb] - cend;
      int di = min(max(dist, 0), 127);
      return dist >= 0 ? fmaf(s, sc, lutr[di]) : -INFINITY;
    };
    const float cbf = lutr[127];
    auto ffc = make_fast(sc, [=](int rb, int tile) { return cbf; });
    auto clc = [&](int rb, int tile) { return ((rb ? tmin1 : tmin0) - ((tile * 64 + 63) * 16 + 31) >= 113) ? 2 : 1; };
    RESET_STATE
    attn_run<64, 1, false, false>(ctiles, ctiles, qf, kpc, vpc, NoCum{}, sfc, ffc, clc, NoPost{}, m, l, o, smem, curslot);
#pragma unroll
    for (int rb = 0; rb < 2; ++rb) { float ls = row_lsum(l[rb]); l[rb] = ls > 0.f ? 1.f / ls : 0.f; }
    auto postc = [&](int tile, f32x4 (&s)[4][2]) {
#pragma unroll
      for (int rb = 0; rb < 2; ++rb)
#pragma unroll
        for (int kb = 0; kb < 4; ++kb) {
          float P[4];
#pragma unroll
          for (int j = 0; j < 4; ++j) P[j] = quad_sum(s[kb][rb][j]);
          if (hl == 0) {
            int n = tile * 16 + kb * 4 + fq;
            atomicAdd(&imp[tl[rb] * 64 + n], 2.f * (P[0] + P[1] + P[2]) + P[3]);
            if (n + 1 < 64) atomicAdd(&imp[tl[rb] * 64 + n + 1], P[3]);
          }
        }
    };
    attn_run<64, 2, false, false>(ctiles, ctiles, qf, kpc, vpc, NoCum{}, sfc, ffc, clc, postc, m, l, o, smem, curslot);
    ACCUM_BRANCH(0, true)
  }
  __syncthreads();
  {
    const int tli = wid * 8 + (lane >> 3), sub = lane & 7;
    const int curb = (t0 + tli) >> 6;
    float v[8];
#pragma unroll
    for (int i = 0; i < 8; ++i) {
      int n = sub * 8 + i;
      float x = imp[tli * 64 + n];
      bool cand = (n <= curb) && (n != 0) && (n != curb) && (n != curb - 1);
      v[i] = cand ? x : -1.f;
    }
    u64 mask = 1ull | (1ull << curb) | (1ull << (curb > 0 ? curb - 1 : 0));
#pragma unroll 1
    for (int round = 0; round < 5; ++round) {
      float bv = v[0]; int bi = 0;
#pragma unroll
      for (int i = 1; i < 8; ++i) if (v[i] > bv) { bv = v[i]; bi = i; }
      int bn = sub * 8 + bi;
#pragma unroll
      for (int off = 1; off < 8; off <<= 1) {
        float ov = __shfl_xor(bv, off); int on = __shfl_xor(bn, off);
        if (ov > bv || (ov == bv && on < bn)) { bv = ov; bn = on; }
      }
      if (bv >= 0.f) mask |= 1ull << bn;
      const bool owner = (bn >> 3) == sub;
#pragma unroll
      for (int i = 0; i < 8; ++i) v[i] = (owner && i == (bn & 7)) ? -2.f : v[i];
    }
    if (curb < 8) mask = (2ull << curb) - 1;
    if (sub == 0) selm[tli] = mask;
  }
  __syncthreads();
  {
    u64 msk[2] = {selm[tl[0]], selm[tl[1]]};
    u64 U = 0;
    for (int i = 0; i < 32; ++i) U |= selm[i];
    const bf16* kb_ = proj + (long)b * 4096 * PROJ_LD + 768 + g * 64;
    const bf16* vst = (const bf16*)(ws + OFF_VST) + (long)(b * 2 + g) * 64 * 4096;
    auto kps = [&](int tile, int row) { return kb_ + (long)(tile * 64 + row) * PROJ_LD; };
    auto vps = [&](int tile, int d) { return vst + (long)d * 4096 + tile * 64; };
    auto sfs = [&](int rb, int kb, int j, int tile, float s) {
      int dist = t[rb] - (tile * 64 + kb * 16 + fq * 4 + j);
      int di = min(max(dist, 0), 127);
      bool ok = dist >= 0 && ((msk[rb] >> tile) & 1);
      return ok ? fmaf(s, sc, lutr[di]) : -INFINITY;
    };
    u64 orm[2], andm[2];
#pragma unroll
    for (int rb = 0; rb < 2; ++rb) {
      unsigned olo = (unsigned)msk[rb], ohi = (unsigned)(msk[rb] >> 32), alo = olo, ahi = ohi;
      olo |= dppu<DPP_X1>(olo); ohi |= dppu<DPP_X1>(ohi); alo &= dppu<DPP_X1>(alo); ahi &= dppu<DPP_X1>(ahi);
      olo |= dppu<DPP_X2>(olo); ohi |= dppu<DPP_X2>(ohi); alo &= dppu<DPP_X2>(alo); ahi &= dppu<DPP_X2>(ahi);
      olo |= dppu<DPP_HM>(olo); ohi |= dppu<DPP_HM>(ohi); alo &= dppu<DPP_HM>(alo); ahi &= dppu<DPP_HM>(ahi);
      olo |= dppu<DPP_M>(olo); ohi |= dppu<DPP_M>(ohi); alo &= dppu<DPP_M>(alo); ahi &= dppu<DPP_M>(ahi);
      orm[rb] = ((u64)(unsigned)__builtin_amdgcn_readfirstlane((int)ohi) << 32) | (unsigned)__builtin_amdgcn_readfirstlane((int)olo);
      andm[rb] = ((u64)(unsigned)__builtin_amdgcn_readfirstlane((int)ahi) << 32) | (unsigned)__builtin_amdgcn_readfirstlane((int)alo);
    }
    const float cbf = lutr[127];
    const u64 msk0 = msk[0], msk1 = msk[1];
    auto ffs = make_fast(sc, [=](int rb, int tile) { return (((rb ? msk1 : msk0) >> tile) & 1) ? cbf : -INFINITY; });
    auto cls = [&](int rb, int tile) {
      const u64 om = rb ? orm[1] : orm[0], am = rb ? andm[1] : andm[0];
      if (!((om >> tile) & 1)) return 0;
      return ((rb ? tmin1 : tmin0) - (tile * 64 + 63) >= 113) ? 2 : 1;
    };
    RESET_STATE
    attn_run<64, 0, true, false>(U, orm[0] | orm[1], qf, kps, vps, NoCum{}, sfs, ffs, cls, NoPost{}, m, l, o, smem, curslot);
    ACCUM_BRANCH(1, false)
  }
  {
    const int lo = (t0 >= 511 ? t0 - 511 : 0) >> 6, hi = (t0 + 31) >> 6;
    const u64 wt = ((hi == 63) ? ~0ull : ((1ull << (hi + 1)) - 1)) & ~((1ull << lo) - 1);
    const bf16* kb_ = proj + (long)b * 4096 * PROJ_LD + 1024 + g * 64;
    const bf16* vwt = (const bf16*)(ws + OFF_VWT) + (long)(b * 2 + g) * 64 * 4096;
    auto kpw = [&](int tile, int row) { return kb_ + (long)(tile * 64 + row) * PROJ_LD; };
    auto vpw = [&](int tile, int d) { return vwt + (long)d * 4096 + tile * 64; };
    auto sfw = [&](int rb, int kb, int j, int tile, float s) {
      int dist = t[rb] - (tile * 64 + kb * 16 + fq * 4 + j);
      int di = min(max(dist, 0), 127);
      bool ok = dist >= 0 && dist < 512;
      return ok ? fmaf(s, sc, lutr[di]) : -INFINITY;
    };
    const float cbf = lutr[127];
    auto ffw = make_fast(sc, [=](int rb, int tile) { return cbf; });
    auto clw = [&](int rb, int tile) {
      const int tm = rb ? tmin1 : tmin0;
      return (tm - (tile * 64 + 63) >= 113 && tm + 3 - tile * 64 < 512) ? 2 : 1;
    };
    RESET_STATE
    attn_run<64, 0, false, false>(wt, wt, qf, kpw, vpw, NoCum{}, sfw, ffw, clw, NoPost{}, m, l, o, smem, curslot);
    ACCUM_BRANCH(2, false)
  }
#undef RESET_STATE
#undef ACCUM_BRANCH
  bf16* ocat = (bf16*)(ws + OFF_OCAT);
#pragma unroll
  for (int rb = 0; rb < 2; ++rb)
#pragma unroll
    for (int db = 0; db < 4; ++db) {
      const f32x4 tv = totl[(rb * 4 + db) * 256];
      u32x2 v; v[0] = pack2(tv[0], tv[1]); v[1] = pack2(tv[2], tv[3]);
      *(u32x2*)(ocat + ((long)b * 4096 + t[rb]) * 1024 + h * 64 + db * 16 + fq * 4) = v;
    }
}

template <int KIND>
DEVI void mha_item(const Params& p, int b, int h, int t0, char* smem) {
  constexpr int DK = KIND == 0 ? 96 : 64;
  char* ws = opaque_ptr(p.ws);
  const int tid = opaque_tid(), lane = tid & 63, wid = tid >> 6, fr = lane & 15, fq = lane >> 4;
  int t[2]; long tok[2];
#pragma unroll
  for (int rb = 0; rb < 2; ++rb) { t[rb] = t0 + wid * 32 + rb * 16 + fr; tok[rb] = (long)b * 4096 + t[rb]; }
  const bf16* qb; long qld; const bf16* kbase; long kld; const bf16* vbase; long vld;
  if (KIND == 0) {
    qb = (const bf16*)(ws + OFF_QMLA) + h * 96; qld = 384;
    kbase = (const bf16*)(ws + OFF_KMLA) + (long)b * 4096 * 384 + h * 96; kld = 384;
    vbase = (const bf16*)(ws + OFF_VMT) + (long)(b * 4 + h) * 64 * 4096; vld = 4096;
  } else if (KIND == 1) {
    qb = (const bf16*)(ws + OFF_PROJ) + 1792 + h * 64; qld = PROJ_LD;
    kbase = (const bf16*)(ws + OFF_PROJ) + (long)b * 4096 * PROJ_LD + 2048 + h * 64; kld = PROJ_LD;
    vbase = (const bf16*)(ws + OFF_VFT) + (long)(b * 4 + h) * 64 * 4096; vld = 4096;
  } else {
    qb = (const bf16*)(ws + OFF_XQ) + h * 64; qld = 256;
    kbase = (const bf16*)(ws + OFF_KXA) + (long)b * 256 * 256 + h * 64; kld = 256;
    vbase = (const bf16*)(ws + OFF_VXA) + (long)(b * 4 + h) * 64 * 256; vld = 256;
  }
  bf16x8 qf[2][DK / 32];
#pragma unroll
  for (int rb = 0; rb < 2; ++rb)
#pragma unroll
    for (int ks = 0; ks < DK / 32; ++ks) qf[rb][ks] = *(const bf16x8*)(qb + tok[rb] * qld + ks * 32 + fq * 8);
  u64 tiles, wtiles;
  if (KIND == 2) { tiles = 0xF; wtiles = 0xF; }
  else {
    int nt = (t0 >> 6) + 2; tiles = nt >= 64 ? ~0ull : ((1ull << nt) - 1);
    int nw = ((t0 + wid * 32 + 31) >> 6) + 1; wtiles = nw >= 64 ? ~0ull : ((1ull << nw) - 1);
  }
  const float sc = (KIND == 0 ? 0.10206207261596575f : 0.125f) * LOG2E;
  const float* cum = (const float*)(ws + OFF_CUM) + (long)(b * 4 + h) * 4096;
  float cq[2] = {0.f, 0.f};
  const char* curslot = smem;
  if (KIND == 1) { cq[0] = cum[t[0]]; cq[1] = cum[t[1]]; }
  auto kpf = [&](int tile, int row) { return kbase + (long)(tile * 64 + row) * kld; };
  auto vpf = [&](int tile, int d) { return vbase + (long)d * vld + tile * 64; };
  auto cpf = [&](int tile) { return cum + tile * 64; };
  auto sf = [&](int rb, int kb, int j, int tile, float s) {
    if (KIND == 2) return s * sc;
    int kpos = tile * 64 + kb * 16 + fq * 4 + j;
    float v = s * sc;
    if (KIND == 1) v += cq[rb] - *(const float*)(curslot + RingGeo<64>::ACO + (kb * 16 + fq * 4 + j) * 4);
    return kpos <= t[rb] ? v : -INFINITY;
  };
  float m[2] = {-1e30f, -1e30f}, l[2] = {0.f, 0.f};
  f32x4 o[5][2];
#pragma unroll
  for (int db = 0; db < 5; ++db) { o[db][0] = f32x4{0.f, 0.f, 0.f, 0.f}; o[db][1] = f32x4{0.f, 0.f, 0.f, 0.f}; }
  __syncthreads();
  const int uw = __builtin_amdgcn_readfirstlane(wid);
  const float cq0 = cq[0], cq1 = cq[1];
  const char* const* cslot = &curslot;
  auto ffm = make_fast_vec(sc, [=](int rb, int tile) { return KIND == 1 ? (rb ? cq1 : cq0) : 0.f; },
                           [=](int kb) { f32x4 z = f32x4{0.f, 0.f, 0.f, 0.f}; return KIND == 1 ? (z - *(const f32x4*)(*cslot + RingGeo<64>::ACO + (kb * 16 + fq * 4) * 4)) : z; });
  auto ffx = make_fast(sc, [=](int rb, int tile) { return 0.f; });
  auto clm = [&](int rb, int tile) { return (KIND == 2 || tile * 64 + 63 <= t0 + uw * 32 + rb * 16) ? 2 : 1; };
  if (KIND == 1) attn_run<DK, 0, false, true>(tiles, wtiles, qf, kpf, vpf, cpf, sf, ffm, clm, NoPost{}, m, l, o, smem, curslot);
  else attn_run<DK, 0, false, false>(tiles, wtiles, qf, kpf, vpf, cpf, sf, ffx, clm, NoPost{}, m, l, o, smem, curslot);
  bf16* dst; long dld;
  if (KIND == 0) { dst = (bf16*)(ws + OFF_OCAT) + 512 + h * 64; dld = 1024; }
  else if (KIND == 1) { dst = (bf16*)(ws + OFF_OCAT) + 768 + h * 64; dld = 1024; }
  else { dst = (bf16*)(ws + OFF_OXA) + h * 64; dld = 256; }
#pragma unroll
  for (int rb = 0; rb < 2; ++rb) {
    float ls = o[4][rb][0];
    float f = ls > 0.f ? 1.f / ls : 0.f;
#pragma unroll
    for (int db = 0; db < 4; ++db) {
      u32x2 v; v[0] = pack2(o[db][rb][0] * f, o[db][rb][1] * f); v[1] = pack2(o[db][rb][2] * f, o[db][rb][3] * f);
      *(u32x2*)(dst + tok[rb] * dld + db * 16 + fq * 4) = v;
    }
  }
}

DEVI int next_item(unsigned* ctr, char* smem) {
  __syncthreads();
  if (opaque_tid() == 0) *(int*)(smem + AITEM) = (int)atomicAdd(ctr, 1u);
  __syncthreads();
  return *(volatile int*)(smem + AITEM);
}

DEVI void phase_attn(const Params& p, int L, char* smem, int rep) {
  unsigned* ctr = (unsigned*)(p.ws + OFF_CNT) + L + 8 * rep;
  for (;;) {
    int it = next_item(ctr, smem);
    if (it >= 4096) break;
    int level = it >> 7, w = it & 127; int q128 = 31 - level;
    if (w < 64) { int sub = w & 3, bg = w >> 2; nsa_item(p, bg >> 1, bg & 1, q128 * 128 + sub * 32, smem); }
    else if (w < 96) { int bh = w - 64; mha_item<0>(p, bh >> 2, bh & 3, q128 * 128, smem); }
    else { int bh = w - 96; mha_item<1>(p, bh >> 2, bh & 3, q128 * 128, smem); }
  }
}

DEVI void phase_xattn(const Params& p, char* smem) {
  for (int it = blockIdx.x; it < 1024; it += gridDim.x) {
    int bh = it & 31, q = it >> 5;
    mha_item<2>(p, bh >> 2, bh & 3, q * 128, smem);
  }
}

DEVI void phase_merge(const Params& p, char* smem) {
  char* ws = opaque_ptr(p.ws);
  const bf16* xb = (const bf16*)(ws + OFF_XB);
  const bf16* ocat = (const bf16*)(ws + OFF_OCAT);
  const bf16* wg = (const bf16*)(ws + OFF_WG);
  u32x4* brg = (u32x4*)(ws + OFF_QMLA) + (size_t)blockIdx.x * 8 * 256 + opaque_tid();
  int t = blockIdx.x;
  if (t < 256 * 8) {
    int mt, nt; tile_swz(t, 256, 8, mt, nt);
    __syncthreads();
    gemm_prefetch0<4>(ocat, RowLinear{1024}, (const bf16*)(ws + OFF_WBN), 512, mt * 128, nt * 128, smem);
  }
  for (; t < 256 * 8; t += gridDim.x) {
    int mt, nt; tile_swz(t, 256, 8, mt, nt);
    f32x4 res[4][4]; zero_acc(res);
#pragma unroll 1
    for (int i = 0; i < 3; ++i) {
      const bf16* wb = (const bf16*)(ws + (i == 0 ? OFF_WBN : (i == 1 ? OFF_WBM : OFF_WBF)));
      const int kk = i == 0 ? 512 : 256;
      const int ko = i == 0 ? 0 : (i == 1 ? 512 : 768);
      f32x4 acc[4][4]; zero_acc(acc);
      gemm_mainloop_g<4, true, RowLinear, true>(acc, ocat + ko, RowLinear{1024}, 64, wb, kk, kk, mt * 128, nt * 128, smem);
      gemm_prefetch0<4>(xb, RowLinear{1024}, wg + (long)i * 1024 * 1024, 1024, mt * 128, nt * 128, smem);
#pragma unroll
      for (int m = 0; m < 4; ++m)
#pragma unroll
        for (int n = 0; n < 4; n += 2)
          brg[(m * 2 + (n >> 1)) * 256] = u32x4{pack2(acc[m][n][0], acc[m][n][1]), pack2(acc[m][n][2], acc[m][n][3]),
                                                pack2(acc[m][n + 1][0], acc[m][n + 1][1]), pack2(acc[m][n + 1][2], acc[m][n + 1][3])};
      zero_acc(acc);
      gemm_mainloop_g<4, true, RowLinear, true>(acc, xb, RowLinear{1024}, 64, wg + (long)i * 1024 * 1024, 1024, 1024, mt * 128, nt * 128, smem);
      if (i < 2) {
        const bf16* wb2 = (const bf16*)(ws + (i == 0 ? OFF_WBM : OFF_WBF));
        gemm_prefetch0<4>(ocat + (i == 0 ? 512 : 768), RowLinear{1024}, wb2, 256, mt * 128, nt * 128, smem);
      } else if (t + (int)gridDim.x < 256 * 8) {
        int mt2, nt2; tile_swz(t + gridDim.x, 256, 8, mt2, nt2);
        gemm_prefetch0<4>(ocat, RowLinear{1024}, (const bf16*)(ws + OFF_WBN), 512, mt2 * 128, nt2 * 128, smem);
      }
#pragma unroll
      for (int m = 0; m < 4; ++m)
#pragma unroll
        for (int n = 0; n < 4; ++n) {
          const u32x4 bq = brg[(m * 2 + (n >> 1)) * 256];
          const unsigned b0 = bq[(n & 1) * 2], b1 = bq[(n & 1) * 2 + 1];
          res[m][n][0] += sigmoidf(acc[m][n][0]) * bf2f(b0 & 0xffffu);
          res[m][n][1] += sigmoidf(acc[m][n][1]) * __uint_as_float(b0 & 0xffff0000u);
          res[m][n][2] += sigmoidf(acc[m][n][2]) * bf2f(b1 & 0xffffu);
          res[m][n][3] += sigmoidf(acc[m][n][3]) * __uint_as_float(b1 & 0xffff0000u);
        }
    }
    store_rm_sw(res, (bf16*)(ws + OFF_MERGED), 1024, mt * 128, nt * 128);
  }
}

enum { EPI_RESID = 0, EPI_RM = 1, EPI_RELU2 = 2 };
template <int EPI>
DEVI void phase_gemm(const Params& p, const bf16* A, int lda, const bf16* Bt, int K, int NT, bf16* dst, int ldd, char* smem, bool nostore = false,
                     const float* lng = nullptr, const float* lnb = nullptr) {
  int t = blockIdx.x;
  if (t < 256 * NT) {
    int mt, nt; tile_swz(t, 256, NT, mt, nt);
    __syncthreads();
    gemm_prefetch0<4>(A, RowLinear{lda}, Bt, K, mt * 128, nt * 128, smem, KROT ? k_rot(mt, nt, K >> 6) : 0);
  }
  for (; t < 256 * NT; t += gridDim.x) {
    int mt, nt; tile_swz(t, 256, NT, mt, nt);
    f32x4 acc[4][4]; zero_acc(acc);
    gemm_mainloop_g<4, true, RowLinear, true, DEEP_FRAG != 0>(acc, A, RowLinear{lda}, 64, Bt, K, K, mt * 128, nt * 128, smem, KROT ? k_rot(mt, nt, K >> 6) : 0);
    if (t + (int)gridDim.x < 256 * NT) {
      int mt2, nt2; tile_swz(t + gridDim.x, 256, NT, mt2, nt2);
      gemm_prefetch0<4>(A, RowLinear{lda}, Bt, K, mt2 * 128, nt2 * 128, smem, KROT ? k_rot(mt2, nt2, K >> 6) : 0);
    }
    if (EPI == EPI_RESID) {
      const int tid = opaque_tid(), lane = tid & 63, wid = tid >> 6, wr = wid >> 1, wc = wid & 1, fr = lane & 15, fq = lane >> 4;
      float* x = p.out;
      const float* stats = (const float*)(p.ws + OFF_STATS);
      const int cb0 = nt * 128 + wc * 64 + fq * 4;
      f32x4 gv[4], bv[4];
      if (lng) {
#pragma unroll
        for (int n = 0; n < 4; ++n) { gv[n] = *(const f32x4*)(lng + cb0 + n * 16); bv[n] = *(const f32x4*)(lnb + cb0 + n * 16); }
      }
#pragma unroll
      for (int m = 0; m < 4; ++m) {
        const int row = mt * 128 + wr * 64 + m * 16 + fr;
        float* rp = x + (long)row * 1024 + cb0;
        float mu = 0.f, rstd = 1.f;
        if (lng) { mu = stats[row * 2]; rstd = stats[row * 2 + 1]; }
        f32x4 v[4];
#pragma unroll
        for (int n = 0; n < 4; ++n) v[n] = *(const f32x4*)(rp + n * 16);
#pragma unroll
        for (int n = 0; n < 4; ++n) {
          f32x4 xv = v[n];
          if (lng) xv = (xv - mu) * rstd * gv[n] + bv[n];
          *(f32x4*)(rp + n * 16) = xv * DN_ALPHA + acc[m][n];
        }
      }
    } else if (EPI == EPI_RELU2) {
#pragma unroll
      for (int m = 0; m < 4; ++m)
#pragma unroll
        for (int n = 0; n < 4; ++n)
#pragma unroll
          for (int j = 0; j < 4; ++j) { float v = fmaxf(acc[m][n][j], 0.f); acc[m][n][j] = v * v; }
      if (!nostore || acc[0][0][0] == 123.456f) store_rm_sw(acc, dst, ldd, mt * 128, nt * 128);
    } else {
      store_rm_sw(acc, dst, ldd, mt * 128, nt * 128);
    }
  }
}

DEVI void phase_ln(const Params& p, int L, int which) {
  const int lane = opaque_tid() & 63, wid = opaque_tid() >> 6;
  const int gw = blockIdx.x * 4 + wid, nw = gridDim.x * 4;
  const float* g = p.in[22] + (L * 3 + which) * 1024;
  const float* bb = p.in[23] + (L * 3 + which) * 1024;
  char* ws = opaque_ptr(p.ws);
  bf16* xb = (bf16*)(ws + OFF_XB);
  float* stats = (float*)(ws + OFF_STATS);
  const bool final_out = (L == 3 && which == 2);
  const f32x4 g0 = *(const f32x4*)(g + lane * 4), g1 = *(const f32x4*)(g + 256 + lane * 4), g2 = *(const f32x4*)(g + 512 + lane * 4), g3 = *(const f32x4*)(g + 768 + lane * 4);
  const f32x4 b0 = *(const f32x4*)(bb + lane * 4), b1 = *(const f32x4*)(bb + 256 + lane * 4), b2 = *(const f32x4*)(bb + 512 + lane * 4), b3 = *(const f32x4*)(bb + 768 + lane * 4);
  for (int row = gw; row < T_TOK; row += nw) {
    float* xr = p.out + (long)row * 1024;
    f32x4 v0 = *(const f32x4*)(xr + lane * 4), v1 = *(const f32x4*)(xr + 256 + lane * 4);
    f32x4 v2 = *(const f32x4*)(xr + 512 + lane * 4), v3 = *(const f32x4*)(xr + 768 + lane * 4);
    f32x4 sv = v0 + v1 + v2 + v3;
    float s = sv[0] + sv[1] + sv[2] + sv[3];
    s = wave_sum(s);
    const float mu = s * (1.f / 1024.f);
    v0 -= mu; v1 -= mu; v2 -= mu; v3 -= mu;
    f32x4 qv = v0 * v0 + v1 * v1 + v2 * v2 + v3 * v3;
    float q = qv[0] + qv[1] + qv[2] + qv[3];
    q = wave_sum(q);
    const float rstd = rsqrtf(q * (1.f / 1024.f) + 1e-5f);
    if (lane == 0) { stats[row * 2] = mu; stats[row * 2 + 1] = rstd; }
#define LN_OUT(V, GG, BB, I)                                                                           \
    {                                                                                                  \
      f32x4 o = V * rstd * GG + BB;                                                                    \
      if (final_out) *(f32x4*)(xr + I * 256 + lane * 4) = o;                                           \
      *(u32x2*)(xb + (long)row * 1024 + I * 256 + lane * 4) = u32x2{pack2(o[0], o[1]), pack2(o[2], o[3])}; \
    }
    LN_OUT(v0, g0, b0, 0) LN_OUT(v1, g1, b1, 1) LN_OUT(v2, g2, b2, 2) LN_OUT(v3, g3, b3, 3)
#undef LN_OUT
  }
}

__global__ void __launch_bounds__(256, 2) mega(Params p) {
  __shared__ __attribute__((aligned(16))) char smem[SMEM_BYTES];
  cg::grid_group grid = cg::this_grid();
  char* ws = opaque_ptr(p.ws);
  volatile LAS unsigned* xst = (volatile LAS unsigned*)(smem + XBST);
  if (opaque_tid() < 4) xst[opaque_tid()] = 0u;
  __syncthreads();
  XcdBarrier xb = xcd_barrier_post((unsigned*)(ws + OFF_BAR), xst);
  grid.sync();
#pragma unroll 1
  for (int L = -1; L < 4; ++L) {
    char* ws = opaque_ptr(p.ws);
    if (L >= 0) {
    for (int r = 0; r < REP_PROJ; ++r) { phase_proj(p, L, smem);
    xcd_barrier(xb); }
    for (int r = 0; r < REP_DERIVED; ++r) { phase_derived(p, L, smem);
    xcd_barrier(xb); }
    for (int r = 0; r < REP_ATTN; ++r) { phase_attn(p, L, smem, r);
    xcd_barrier(xb); }
    for (int r = 0; r < REP_MERGE; ++r) { phase_merge(p, smem);
    xcd_barrier(xb); }
    phase_gemm<EPI_RESID>(p, (const bf16*)(ws + OFF_MERGED), 1024, (const bf16*)(ws + OFF_WOUT), 1024, 8, nullptr, 0, smem, false,
                          L ? p.in[22] + ((L - 1) * 3 + 2) * 1024 : nullptr, L ? p.in[23] + ((L - 1) * 3 + 2) * 1024 : nullptr);
    xcd_barrier(xb);
    phase_ln(p, L, 0);
    xcd_barrier(xb);
    phase_gemm<EPI_RM>(p, (const bf16*)(ws + OFF_XB), 1024, (const bf16*)(ws + OFF_WXQ), 1024, 2, (bf16*)(ws + OFF_XQ), 256, smem);
    xcd_barrier(xb);
    for (int r = 0; r < REP_XA; ++r) { phase_xattn(p, smem);
    xcd_barrier(xb); }
    phase_gemm<EPI_RESID>(p, (const bf16*)(ws + OFF_OXA), 256, (const bf16*)(ws + OFF_WXO), 256, 8, nullptr, 0, smem, false,
                          p.in[22] + (L * 3 + 0) * 1024, p.in[23] + (L * 3 + 0) * 1024);
    xcd_barrier(xb);
    phase_ln(p, L, 1);
    xcd_barrier(xb);
    for (int r = 0; r < REP_UP; ++r) { phase_gemm<EPI_RELU2>(p, (const bf16*)(ws + OFF_XB), 1024, (const bf16*)(ws + OFF_WUP), 1024, 32, (bf16*)(ws + OFF_HID), 4096, smem, (PROBE_NOSTORE && r > 0));
    xcd_barrier(xb); }
    phase_gemm<EPI_RESID>(p, (const bf16*)(ws + OFF_HID), 4096, (const bf16*)(ws + OFF_WDN), 4096, 8, nullptr, 0, smem, false,
                          p.in[22] + (L * 3 + 1) * 1024, p.in[23] + (L * 3 + 1) * 1024);
    xcd_barrier(xb);
    phase_ln(p, L, 2);
    }
    if (L < 3) { phase_prep(p, L + 1, smem); xcd_barrier(xb); }
  }
}

extern "C" void kernel_launch(void* const* d_in, const int* in_sizes, int n_in, void* d_out, int out_size,
                              void* d_ws, size_t ws_size, hipStream_t stream) {
  static int grid_blocks = 0;
  if (!grid_blocks) {
    int dev = 0, cus = 0, per_cu = 0;
    (void)hipGetDevice(&dev);
    (void)hipDeviceGetAttribute(&cus, hipDeviceAttributeMultiprocessorCount, dev);
    (void)hipOccupancyMaxActiveBlocksPerMultiprocessor(&per_cu, mega, 256, 0);
    if (per_cu > 2) per_cu = 2;
    if (per_cu < 1) per_cu = 1;
    grid_blocks = cus * per_cu;
    grid_blocks &= ~7;
    if (grid_blocks > 512) grid_blocks = 512;
  }
  if (ws_size < WS_TOTAL) fprintf(stderr, "workspace too small: %zu < %zu\n", ws_size, (size_t)WS_TOTAL);
  Params p{};
  for (int i = 0; i < 24; ++i) p.in[i] = (const float*)d_in[i];
  p.out = (float*)d_out;
  p.ws = (char*)d_ws;
  (void)hipMemsetAsync((char*)d_ws + OFF_BAR, 0, 16384, stream);
  void* args[] = {&p};
  hipError_t e = hipLaunchCooperativeKernel((void*)mega, dim3(grid_blocks), dim3(256), args, 0, stream);
  if (e != hipSuccess) fprintf(stderr, "cooperative launch failed: %s (grid %d)\n", hipGetErrorString(e), grid_blocks);
}
```

```cpp
#include <hip/hip_runtime.h>
#include <hip/hip_cooperative_groups.h>
#include <cstdio>
#include <cstdint>
namespace cg = cooperative_groups;

typedef unsigned short bf16;
typedef __attribute__((ext_vector_type(8))) short bf16x8;
typedef __attribute__((ext_vector_type(4))) float f32x4;
typedef __attribute__((ext_vector_type(2))) __bf16 bf2_t;
typedef __attribute__((ext_vector_type(4))) unsigned u32x4;
typedef unsigned long long u64;
typedef __attribute__((ext_vector_type(2))) unsigned u32x2;

#ifndef EXTRA_SYNC
#define EXTRA_SYNC 0
#endif
#ifndef PROBE_NOSTORE
#define PROBE_NOSTORE 0
#endif
#ifndef USE_RING
#define USE_RING 0
#endif
#if USE_RING
#define GEMM_ML gemm_mainloop_r
#else
#define GEMM_ML gemm_mainloop_g
#endif
#ifndef SWZ_MODE
#define SWZ_MODE 0
#endif
#ifndef KROT
#define KROT 0
#endif
#ifndef DEEP_FRAG
#define DEEP_FRAG 1
#endif
#ifndef REP_ATTN
#define REP_ATTN 1
#endif
#ifndef REP_PROJ
#define REP_PROJ 1
#endif
#ifndef REP_UP
#define REP_UP 1
#endif
#ifndef REP_MERGE
#define REP_MERGE 1
#endif
#ifndef REP_DERIVED
#define REP_DERIVED 1
#endif
#ifndef REP_PREP
#define REP_PREP 1
#endif
#ifndef REP_XA
#define REP_XA 1
#endif
#define DEVI __device__ __forceinline__

DEVI int opaque_tid() { int t = __builtin_amdgcn_workitem_id_x(); asm volatile("" : "+v"(t)); return t; }
DEVI char* opaque_ptr(char* p) { asm volatile("" : "+s"(p)); return p; }
DEVI float opq(float x) { asm("" : "+v"(x)); return x; }
DEVI unsigned pack2(float a, float b) { bf2_t v; v[0] = (__bf16)a; v[1] = (__bf16)b; return __builtin_bit_cast(unsigned, v); }
DEVI bf16 f2bf(float a) { return __builtin_bit_cast(unsigned short, (__bf16)a); }
DEVI float bf2f(unsigned u) { return __uint_as_float(u << 16); }
DEVI float fexp2(float x) { return __builtin_amdgcn_exp2f(x); }
DEVI float sigmoidf(float x) { return 1.f / (1.f + __expf(-x)); }

constexpr int T_TOK = 32768;
constexpr int PROJ_LD = 2688;
constexpr float LOG2E = 1.4426950408889634f;
constexpr float DN_ALPHA = 1.681792830507429f;

constexpr size_t al256(size_t x) { return (x + 255) & ~(size_t)255; }
constexpr size_t OFF_BAR = 0;
constexpr size_t OFF_CNT = 14336;
constexpr size_t OFF_WIN = 16384;
constexpr size_t OFF_WG = OFF_WIN + (size_t)2688 * 1024 * 2;
constexpr size_t OFF_WBN = OFF_WG + (size_t)3072 * 1024 * 2;
constexpr size_t OFF_WBM = OFF_WBN + (size_t)1024 * 512 * 2;
constexpr size_t OFF_WBF = OFF_WBM + (size_t)1024 * 256 * 2;
constexpr size_t OFF_WOUT = OFF_WBF + (size_t)1024 * 256 * 2;
constexpr size_t OFF_WXQ = OFF_WOUT + (size_t)1024 * 1024 * 2;
constexpr size_t OFF_WXKV = OFF_WXQ + (size_t)256 * 1024 * 2;
constexpr size_t OFF_WXO = OFF_WXKV + (size_t)512 * 1024 * 2;
constexpr size_t OFF_WUP = OFF_WXO + (size_t)1024 * 256 * 2;
constexpr size_t OFF_WDN = OFF_WUP + (size_t)4096 * 1024 * 2;
constexpr size_t OFF_WUQ = OFF_WDN + (size_t)4096 * 1024 * 2;
constexpr size_t OFF_WUKV = OFF_WUQ + (size_t)384 * 384 * 2;
constexpr size_t OFF_WC1 = OFF_WUKV + (size_t)512 * 128 * 2;
constexpr size_t OFF_WC2 = OFF_WC1 + (size_t)2 * 128 * 2048 * 2;
constexpr size_t OFF_B1 = OFF_WC2 + (size_t)2 * 64 * 128 * 2;
constexpr size_t OFF_XB = al256(OFF_B1 + 2 * 32 * 128 * 4);
constexpr size_t OFF_MEMB = OFF_XB + (size_t)32768 * 1024 * 2;
constexpr size_t OFF_PROJ = OFF_MEMB + (size_t)2048 * 1024 * 2;
constexpr size_t OFF_OCAT = OFF_PROJ + (size_t)32768 * 2688 * 2;
constexpr size_t OFF_QMLA = OFF_OCAT + (size_t)32768 * 1024 * 2;
constexpr size_t OFF_KMLA = OFF_QMLA + (size_t)32768 * 384 * 2;
constexpr size_t OFF_VMT = OFF_KMLA + (size_t)32768 * 384 * 2;
constexpr size_t OFF_VST = OFF_VMT + (size_t)8 * 4 * 64 * 4096 * 2;
constexpr size_t OFF_VWT = OFF_VST + (size_t)8 * 2 * 64 * 4096 * 2;
constexpr size_t OFF_VFT = OFF_VWT + (size_t)8 * 2 * 64 * 4096 * 2;
constexpr size_t OFF_KC = OFF_VFT + (size_t)8 * 4 * 64 * 4096 * 2;
constexpr size_t OFF_VCT = OFF_KC + (size_t)16 * 256 * 64 * 2;
constexpr size_t OFF_GAUX = OFF_VCT + (size_t)16 * 256 * 64 * 2;
constexpr size_t OFF_FLOG = OFF_GAUX + (size_t)32768 * 32 * 4;
constexpr size_t OFF_CUM = OFF_FLOG + (size_t)32768 * 4 * 4;
constexpr size_t OFF_KXA = OFF_CUM + (size_t)32768 * 4 * 4;
constexpr size_t OFF_VXA = OFF_KXA + (size_t)2048 * 256 * 2;
constexpr size_t OFF_XQ = OFF_VXA + (size_t)2048 * 256 * 2;
constexpr size_t OFF_OXA = OFF_XQ + (size_t)32768 * 256 * 2;
constexpr size_t OFF_STATS = OFF_OXA + (size_t)32768 * 256 * 2;
constexpr size_t WS_TOTAL = OFF_STATS + (size_t)32768 * 2 * 4;
constexpr size_t OFF_HID = OFF_PROJ;
constexpr size_t OFF_MERGED = OFF_PROJ;

constexpr int LDS_ROW = 144;
constexpr int TILE_B = 128 * LDS_ROW;
constexpr int SM_ROWSS = 2 * TILE_B;
constexpr int ARING = 66560;
constexpr int XBST = 77216;
constexpr int SMEM_BYTES = XBST + 16;
constexpr int ALUT = ARING, AIMP = ALUT + 2176, ASEL = AIMP + 8192, AITEM = ASEL + 256;
template <int DK> struct RingGeo { static constexpr int AVO = DK == 64 ? 8192 : 12288, ACO = AVO + 8192, STRIDE = DK == 64 ? 16640 : 20992; };
static_assert(4 * 16640 <= ARING && 3 * 20992 <= ARING, "ring");
static_assert(AITEM + 16 <= XBST, "LDS map");


#define XB_TMO      128
#define XB_XCNT(j)  (256  + 64 * (j))
#define XB_XSUB(j)  (1280 + 64 * (j))
#define XB_XGEN(j)  (2304 + 64 * (j))
#define XB_TOP      3328
#define XB_TOPGEN   3392
#define XCD_BAR_WORDS 3456
#define XB_SPIN_CAP (1u << 18)
#define LAS __attribute__((address_space(3)))
DEVI unsigned xb_ld(unsigned* p) { return __hip_atomic_load(p, __ATOMIC_RELAXED, __HIP_MEMORY_SCOPE_AGENT); }
DEVI unsigned xb_add(unsigned* p, unsigned v) { return __hip_atomic_fetch_add(p, v, __ATOMIC_RELAXED, __HIP_MEMORY_SCOPE_AGENT); }
DEVI unsigned xb_xcc_id() { return (unsigned)__builtin_amdgcn_s_getreg((3 << 11) | 20) & 0xFu; }
#define XB_SPIN(cond, bar) do { unsigned _sp = 0; while (cond) { __builtin_amdgcn_s_sleep(1); \
    if ((++_sp & 255u) == 0u) { if (xb_ld(&(bar)[XB_TMO])) break; if (_sp > XB_SPIN_CAP) { atomicAdd(&(bar)[XB_TMO], 1u); break; } } } } while (0)
struct XcdBarrier { unsigned* bar; unsigned x; volatile LAS unsigned* st; };
DEVI XcdBarrier xcd_barrier_post(unsigned* bar, volatile LAS unsigned* st) {
  XcdBarrier b; b.bar = bar; b.x = xb_xcc_id(); b.st = st;
  if (opaque_tid() == 0) (void)xb_add(&bar[XB_XCNT(b.x)], 1u);
  return b;
}
DEVI void xcd_barrier_complete(unsigned* bar, unsigned x, unsigned& nloc, unsigned& nx) {
  const unsigned G = gridDim.x * gridDim.y * gridDim.z;
  unsigned sum, cnt, mine, sp = 0u;
  for (;;) {
    sum = 0u; cnt = 0u; mine = 0u;
#pragma unroll
    for (unsigned j = 0; j < 16; ++j) { const unsigned c = xb_ld(&bar[XB_XCNT(j)]); sum += c; cnt += (c > 0u) ? 1u : 0u; mine = (j == x) ? c : mine; }
    if (sum == G) break;
    __builtin_amdgcn_s_sleep(1);
    if ((++sp & 255u) == 0u) { if (xb_ld(&bar[XB_TMO])) break; if (sp > XB_SPIN_CAP) { atomicAdd(&bar[XB_TMO], 1u); break; } }
  }
  nloc = mine > 0u ? mine : 1u; nx = cnt > 0u ? cnt : 1u;
}
DEVI void xcd_barrier(const XcdBarrier& b) {
  asm volatile("s_waitcnt vmcnt(0)" ::: "memory");
  __syncthreads();
  if (opaque_tid() == 0) {
    unsigned* bar = b.bar;
    __builtin_amdgcn_s_waitcnt(0);
    unsigned nloc = b.st[0], nx = b.st[1];
    if (nloc == 0u) { xcd_barrier_complete(bar, b.x, nloc, nx); b.st[0] = nloc; b.st[1] = nx; }
    const unsigned old = xb_add(&bar[XB_XSUB(b.x)], 1u);
    const unsigned gen = old / nloc;
    if (old + 1u == (gen + 1u) * nloc) {
      __builtin_amdgcn_fence(__ATOMIC_RELEASE, "agent");
      asm volatile("s_waitcnt vmcnt(0)" ::: "memory");
      const unsigned og = xb_add(&bar[XB_TOP], 1u);
      const unsigned tg = og / nx;
      if (og + 1u == (tg + 1u) * nx) xb_add(&bar[XB_TOPGEN], 1u);
      else XB_SPIN(xb_ld(&bar[XB_TOPGEN]) == tg, bar);
      __builtin_amdgcn_fence(__ATOMIC_ACQUIRE, "agent");
      xb_add(&bar[XB_XGEN(b.x)], 1u);
      asm volatile("s_waitcnt vmcnt(0)" ::: "memory");
    } else {
      XB_SPIN(xb_ld(&bar[XB_XGEN(b.x)]) == gen, bar);
      __builtin_amdgcn_fence(__ATOMIC_ACQUIRE, "agent");
      asm volatile("s_waitcnt vmcnt(0)" ::: "memory");
    }
  }
  __syncthreads();
}

struct Params {
  const float* in[24];
  float* out;
  char* ws;
};

__device__ const unsigned char T5BUCKET[128] = {
  0, 1, 2, 3, 4, 5, 6, 7, 8, 9, 10, 11, 12, 13, 14, 15, 16, 16, 16, 17, 17, 18, 18, 18, 19, 19, 19, 20, 20, 20, 20, 21,
  21, 21, 21, 22, 22, 22, 22, 22, 23, 23, 23, 23, 23, 23, 24, 24, 24, 24, 24, 24, 25, 25, 25, 25, 25, 25, 25, 26, 26, 26, 26, 26,
  26, 26, 26, 27, 27, 27, 27, 27, 27, 27, 27, 27, 27, 28, 28, 28, 28, 28, 28, 28, 28, 28, 28, 29, 29, 29, 29, 29, 29, 29, 29, 29,
  29, 29, 29, 30, 30, 30, 30, 30, 30, 30, 30, 30, 30, 30, 30, 30, 30, 31, 31, 31, 31, 31, 31, 31, 31, 31, 31, 31, 31, 31, 31, 31};

struct RowLinear { long ld; DEVI long operator()(int r) const { return (long)r * ld; } };
struct RowCmp {
  int colbase;
  DEVI long operator()(int r) const {
    int bg = r >> 8, c = r & 255; if (c > 254) c = 254;
    int b = bg >> 1, g = bg & 1;
    return ((long)(b * 4096 + c * 16)) * PROJ_LD + colbase + g * 64;
  }
};

DEVI float sumsq8(u32x4 v) {
  float s = 0.f;
  unsigned w[4] = {v[0], v[1], v[2], v[3]};
#pragma unroll
  for (int i = 0; i < 4; ++i) { float a = bf2f(w[i] & 0xffffu), b = __uint_as_float(w[i] & 0xffff0000u); s += a * a + b * b; }
  return s;
}

template <bool ROWSS, int NF, class ARow>
DEVI void gemm_mainloop_t(f32x4 (&acc)[4][NF], const bf16* __restrict__ A, ARow arow, int kstrideA,
                          const bf16* __restrict__ Bt, int ldb, int K, int m0, int n0, char* smem) {
  constexpr int NBI = NF;
  char* As = smem; char* Bs = smem + TILE_B;
  const int tid = opaque_tid(), lane = tid & 63, wid = tid >> 6, wr = wid >> 1, wc = wid & 1, fr = lane & 15, fq = lane >> 4;
  const int lrow = tid >> 3, lkc = tid & 7;
  unsigned aoff[4], boff[NBI];
#pragma unroll
  for (int i = 0; i < 4; ++i) aoff[i] = (unsigned)(arow(m0 + lrow + 32 * i) + lkc * 8);
#pragma unroll
  for (int i = 0; i < NBI; ++i) boff[i] = (unsigned)((n0 + lrow + 32 * i) * ldb + lkc * 8);
  u32x4 ra[4], rb[NBI];
  float ss[4] = {0.f, 0.f, 0.f, 0.f};
  const int nk = K >> 6;
#pragma unroll
  for (int i = 0; i < 4; ++i) ra[i] = *(const u32x4*)(A + aoff[i]);
#pragma unroll
  for (int i = 0; i < NBI; ++i) rb[i] = *(const u32x4*)(Bt + boff[i]);
  for (int kt = 0; kt < nk; ++kt) {
    __syncthreads();
#pragma unroll
    for (int i = 0; i < 4; ++i) {
      *(u32x4*)(As + (lrow + 32 * i) * LDS_ROW + lkc * 16) = ra[i];
      if (ROWSS) ss[i] += sumsq8(ra[i]);
    }
#pragma unroll
    for (int i = 0; i < NBI; ++i) *(u32x4*)(Bs + (lrow + 32 * i) * LDS_ROW + lkc * 16) = rb[i];
    __syncthreads();
    if (kt + 1 < nk) {
      const unsigned ka = (unsigned)((kt + 1) * kstrideA), kb = (unsigned)((kt + 1) * 64);
#pragma unroll
      for (int i = 0; i < 4; ++i) ra[i] = *(const u32x4*)(A + (aoff[i] + ka));
#pragma unroll
      for (int i = 0; i < NBI; ++i) rb[i] = *(const u32x4*)(Bt + (boff[i] + kb));
    }
#pragma unroll
    for (int ks = 0; ks < 2; ++ks) {
      bf16x8 af[4], bfr[NF];
#pragma unroll
      for (int m = 0; m < 4; ++m) af[m] = *(const bf16x8*)(As + (wr * 64 + m * 16 + fr) * LDS_ROW + ks * 64 + fq * 16);
#pragma unroll
      for (int n = 0; n < NF; ++n) bfr[n] = *(const bf16x8*)(Bs + (wc * 16 * NF + n * 16 + fr) * LDS_ROW + ks * 64 + fq * 16);
#pragma unroll
      for (int m = 0; m < 4; ++m)
#pragma unroll
        for (int n = 0; n < NF; ++n) acc[m][n] = __builtin_amdgcn_mfma_f32_16x16x32_bf16(af[m], bfr[n], acc[m][n], 0, 0, 0);
    }
  }
  if (ROWSS) {
    float* rowss = (float*)(smem + SM_ROWSS);
#pragma unroll
    for (int i = 0; i < 4; ++i) {
      float s = ss[i];
      s += __shfl_xor(s, 1); s += __shfl_xor(s, 2); s += __shfl_xor(s, 4);
      if (lkc == 0) rowss[lrow + 32 * i] = s;
    }
    __syncthreads();
  }
}
template <bool ROWSS, class ARow>
DEVI void gemm_mainloop(f32x4 (&acc)[4][4], const bf16* __restrict__ A, ARow arow, int kstrideA,
                        const bf16* __restrict__ Bt, int ldb, int K, int m0, int n0, char* smem) {
  gemm_mainloop_t<ROWSS, 4>(acc, A, arow, kstrideA, Bt, ldb, K, m0, n0, smem);
}

DEVI int k_rot(int mt, int nt, int nk) { return (((mt & 7) + (nt & 7)) & 7) * nk >> 3; }

template <int NF, class ARow>
DEVI void gemm_prefetch0(const bf16* __restrict__ A, ARow arow, const bf16* __restrict__ Bt, int ldb, int m0, int n0, char* smem, int koff = 0) {
  const int tid = opaque_tid();
  const int lrow = tid >> 3, lpos = tid & 7;
  const int gch = (lpos ^ (lrow & 7)) * 8 + koff * 64;
  char* ab = smem + tid * 16;
#pragma unroll
  for (int i = 0; i < 4; ++i)
    __builtin_amdgcn_global_load_lds((const unsigned*)(A + (unsigned)(arow(m0 + lrow + 32 * i) + gch)), (unsigned*)(ab + i * 4096), 16, 0, 0);
#pragma unroll
  for (int i = 0; i < NF; ++i)
    __builtin_amdgcn_global_load_lds((const unsigned*)(Bt + (unsigned)((n0 + lrow + 32 * i) * ldb + gch)), (unsigned*)(ab + 16384 + i * 4096), 16, 0, 0);
}

template <int NF, bool SWAP, class ARow, bool PRE = false, bool DEEP = false>
DEVI void gemm_mainloop_g(f32x4 (&acc)[4][NF], const bf16* __restrict__ A, ARow arow, int kstrideA,
                          const bf16* __restrict__ Bt, int ldb, int K, int m0, int n0, char* smem, int koff = 0) {
  const int tid = opaque_tid(), lane = tid & 63, wid = tid >> 6, wr = wid >> 1, wc = wid & 1, fr = lane & 15, fq = lane >> 4;
  const int lrow = tid >> 3, lpos = tid & 7;
  const int gch = (lpos ^ (lrow & 7)) * 8;
  unsigned aoff[4], boff[NF];
#pragma unroll
  for (int i = 0; i < 4; ++i) aoff[i] = (unsigned)(arow(m0 + lrow + 32 * i) + gch);
#pragma unroll
  for (int i = 0; i < NF; ++i) boff[i] = (unsigned)((n0 + lrow + 32 * i) * ldb + gch);
  const int nk = K >> 6;
  if (!PRE) __syncthreads();
#define GL_ISSUE(KT, BUF)                                                                                  \
  {                                                                                                        \
    char* ab = smem + (BUF) * 32768 + tid * 16;                                                            \
    const int kr_ = ((KT) + koff) & (nk - 1);                                                              \
    const unsigned ka = (unsigned)(kr_ * kstrideA), kb = (unsigned)(kr_ * 64);                             \
    _Pragma("unroll") for (int i = 0; i < 4; ++i)                                                          \
      __builtin_amdgcn_global_load_lds((const unsigned*)(A + (aoff[i] + ka)), (unsigned*)(ab + i * 4096), 16, 0, 0); \
    _Pragma("unroll") for (int i = 0; i < NF; ++i)                                                         \
      __builtin_amdgcn_global_load_lds((const unsigned*)(Bt + (boff[i] + kb)), (unsigned*)(ab + 16384 + i * 4096), 16, 0, 0); \
  }
  if (!PRE) GL_ISSUE(0, 0)
  asm volatile("s_waitcnt vmcnt(0)" ::: "memory");
  __syncthreads();
  const int swz = fr & 7;
  for (int kt = 0; kt < nk; ++kt) {
    if (kt + 1 < nk) GL_ISSUE(kt + 1, (kt + 1) & 1)
    const char* As = smem + (kt & 1) * 32768;
    const char* Bs = As + 16384;
    if (DEEP) {
    bf16x8 af[2][4], bfr[2][NF];
#pragma unroll
    for (int ks = 0; ks < 2; ++ks) {
      const int co = ((ks * 4 + fq) ^ swz) * 16;
#pragma unroll
      for (int m = 0; m < 4; ++m) af[ks][m] = *(const bf16x8*)(As + (wr * 64 + m * 16 + fr) * 128 + co);
#pragma unroll
      for (int n = 0; n < NF; ++n) bfr[ks][n] = *(const bf16x8*)(Bs + (wc * 16 * NF + n * 16 + fr) * 128 + co);
    }
    __builtin_amdgcn_s_setprio(1);
#pragma unroll
    for (int ks = 0; ks < 2; ++ks)
#pragma unroll
      for (int m = 0; m < 4; ++m)
#pragma unroll
        for (int n = 0; n < NF; ++n) {
          if (SWAP) acc[m][n] = __builtin_amdgcn_mfma_f32_16x16x32_bf16(bfr[ks][n], af[ks][m], acc[m][n], 0, 0, 0);
          else acc[m][n] = __builtin_amdgcn_mfma_f32_16x16x32_bf16(af[ks][m], bfr[ks][n], acc[m][n], 0, 0, 0);
        }
    __builtin_amdgcn_s_setprio(0);
    __builtin_amdgcn_sched_group_barrier(0x100, 4 + NF, 0);
#pragma unroll
    for (int i = 0; i < 4 + NF; ++i) { __builtin_amdgcn_sched_group_barrier(0x008, 2, 0); __builtin_amdgcn_sched_group_barrier(0x100, 1, 0); }
    __builtin_amdgcn_sched_group_barrier(0x008, 8 * NF - 2 * (4 + NF), 0);
    } else {
#pragma unroll
    for (int ks = 0; ks < 2; ++ks) {
      const int co = ((ks * 4 + fq) ^ swz) * 16;
      bf16x8 af[4], bfr[NF];
#pragma unroll
      for (int m = 0; m < 4; ++m) af[m] = *(const bf16x8*)(As + (wr * 64 + m * 16 + fr) * 128 + co);
#pragma unroll
      for (int n = 0; n < NF; ++n) bfr[n] = *(const bf16x8*)(Bs + (wc * 16 * NF + n * 16 + fr) * 128 + co);
      __builtin_amdgcn_s_setprio(1);
#pragma unroll
      for (int m = 0; m < 4; ++m)
#pragma unroll
        for (int n = 0; n < NF; ++n) {
          if (SWAP) acc[m][n] = __builtin_amdgcn_mfma_f32_16x16x32_bf16(bfr[n], af[m], acc[m][n], 0, 0, 0);
          else acc[m][n] = __builtin_amdgcn_mfma_f32_16x16x32_bf16(af[m], bfr[n], acc[m][n], 0, 0, 0);
        }
      __builtin_amdgcn_s_setprio(0);
    }
    }
    asm volatile("s_waitcnt vmcnt(0)" ::: "memory");
    __syncthreads();
  }
#undef GL_ISSUE
}

template <int NF, bool SWAP, class ARow>
DEVI void gemm_mainloop_r(f32x4 (&acc)[4][NF], const bf16* __restrict__ A, ARow arow, int kstrideA,
                          const bf16* __restrict__ Bt, int ldb, int K, int m0, int n0, char* smem) {
  constexpr int NBI = NF / 2;
  const int tid = opaque_tid(), lane = tid & 63, wid = tid >> 6, wr = wid >> 1, wc = wid & 1, fr = lane & 15, fq = lane >> 4;
  const int lrow = tid >> 2, lpos = tid & 3;
  const int gch = (lpos ^ ((4 - ((lrow >> 2) & 3)) & 3)) * 8;
  unsigned aoff[2], boff[NBI];
#pragma unroll
  for (int i = 0; i < 2; ++i) aoff[i] = (unsigned)(arow(m0 + lrow + 64 * i) + gch);
#pragma unroll
  for (int i = 0; i < NBI; ++i) boff[i] = (unsigned)((n0 + lrow + 64 * i) * ldb + gch);
  const int nh = K >> 5;
  __syncthreads();
#define GR_ISSUE(H)                                                                                        \
  {                                                                                                        \
    char* ab = smem + ((H) & 3) * 16384 + tid * 16;                                                        \
    const unsigned ka = (unsigned)(((H) >> 1) * kstrideA + ((H) & 1) * 32), kb = (unsigned)((H) * 32);     \
    _Pragma("unroll") for (int i = 0; i < 2; ++i)                                                          \
      __builtin_amdgcn_global_load_lds((const unsigned*)(A + (aoff[i] + ka)), (unsigned*)(ab + i * 4096), 16, 0, 0); \
    _Pragma("unroll") for (int i = 0; i < NBI; ++i)                                                        \
      __builtin_amdgcn_global_load_lds((const unsigned*)(Bt + (boff[i] + kb)), (unsigned*)(ab + 8192 + i * 4096), 16, 0, 0); \
  }
  GR_ISSUE(0) GR_ISSUE(1) GR_ISSUE(2)
  const int co = (fq ^ ((4 - ((fr >> 2) & 3)) & 3)) * 16;
  for (int h = 0; h < nh; ++h) {
    if (h + 2 < nh) { if (NF == 4) asm volatile("s_waitcnt vmcnt(8)" ::: "memory"); else asm volatile("s_waitcnt vmcnt(6)" ::: "memory"); }
    else if (h + 1 < nh) { if (NF == 4) asm volatile("s_waitcnt vmcnt(4)" ::: "memory"); else asm volatile("s_waitcnt vmcnt(3)" ::: "memory"); }
    else asm volatile("s_waitcnt vmcnt(0)" ::: "memory");
    __builtin_amdgcn_s_barrier();
    if (h + 3 < nh) GR_ISSUE(h + 3)
    const char* As = smem + (h & 3) * 16384;
    const char* Bs = As + 8192;
    bf16x8 af[4], bfr[NF];
#pragma unroll
    for (int m = 0; m < 4; ++m) af[m] = *(const bf16x8*)(As + (wr * 64 + m * 16 + fr) * 64 + co);
#pragma unroll
    for (int n = 0; n < NF; ++n) bfr[n] = *(const bf16x8*)(Bs + (wc * 16 * NF + n * 16 + fr) * 64 + co);
#pragma unroll
    for (int m = 0; m < 4; ++m)
#pragma unroll
      for (int n = 0; n < NF; ++n) {
        if (SWAP) acc[m][n] = __builtin_amdgcn_mfma_f32_16x16x32_bf16(bfr[n], af[m], acc[m][n], 0, 0, 0);
        else acc[m][n] = __builtin_amdgcn_mfma_f32_16x16x32_bf16(af[m], bfr[n], acc[m][n], 0, 0, 0);
      }
  }
#undef GR_ISSUE
  __syncthreads();
}

DEVI void zero_acc(f32x4 (&acc)[4][4]) {
#pragma unroll
  for (int m = 0; m < 4; ++m)
#pragma unroll
    for (int n = 0; n < 4; ++n) acc[m][n] = f32x4{0.f, 0.f, 0.f, 0.f};
}

DEVI void tile_swz(int t, int MT, int NT, int& mt, int& nt) {
#if SWZ_MODE == 1
  mt = t / NT; nt = t - mt * NT; return;
#elif SWZ_MODE == 2
  nt = t / MT; mt = t - nt * MT; return;
#endif
  int per = (MT * NT) >> 3;
  int v = (t & 7) * per + (t >> 3);
  int band = v / (8 * NT);
  int w = v - band * 8 * NT;
  mt = band * 8 + (w & 7);
  nt = w >> 3;
}

DEVI void store_rm(const f32x4 (&acc)[4][4], bf16* dst, long ld, int m0, int n0) {
  const int tid = opaque_tid(), lane = tid & 63, wid = tid >> 6, wr = wid >> 1, wc = wid & 1, fr = lane & 15, fq = lane >> 4;
#pragma unroll
  for (int m = 0; m < 4; ++m)
#pragma unroll
    for (int j = 0; j < 4; ++j) {
      bf16* rp = dst + (long)(m0 + wr * 64 + m * 16 + fq * 4 + j) * ld + n0 + wc * 64 + fr;
#pragma unroll
      for (int n = 0; n < 4; ++n) rp[n * 16] = f2bf(acc[m][n][j]);
    }
}

DEVI void store_rm_sw(const f32x4 (&acc)[4][4], bf16* dst, long ld, int m0, int n0) {
  const int tid = opaque_tid(), lane = tid & 63, wid = tid >> 6, wr = wid >> 1, wc = wid & 1, fr = lane & 15, fq = lane >> 4;
  const int cofs = (fq & 1) * 16 + (fq & 2) * 4;
#pragma unroll
  for (int m = 0; m < 4; ++m) {
    bf16* rp = dst + (long)(m0 + wr * 64 + m * 16 + fr) * ld + n0 + wc * 64 + cofs;
#pragma unroll
    for (int n = 0; n < 4; n += 2) {
      const unsigned x0 = pack2(acc[m][n][0], acc[m][n][1]), x1 = pack2(acc[m][n][2], acc[m][n][3]);
      const unsigned y0 = pack2(acc[m][n + 1][0], acc[m][n + 1][1]), y1 = pack2(acc[m][n + 1][2], acc[m][n + 1][3]);
      const u32x2 s0 = __builtin_amdgcn_permlane16_swap(x0, y0, false, false);
      const u32x2 s1 = __builtin_amdgcn_permlane16_swap(x1, y1, false, false);
      *(u32x4*)(rp + n * 16) = u32x4{s0[0], s1[0], s0[1], s1[1]};
    }
  }
}

DEVI void store_tr_wave(const f32x4 (&acc)[4][4], bf16* dstplane, long rowlen, int pos0  ) {
  const int lane = opaque_tid() & 63, fr = lane & 15, fq = lane >> 4;
#pragma unroll
  for (int m = 0; m < 4; ++m)
#pragma unroll
    for (int n = 0; n < 4; n += 2) {
      const unsigned x0 = pack2(acc[m][n][0], acc[m][n][1]), x1 = pack2(acc[m][n][2], acc[m][n][3]);
      const unsigned y0 = pack2(acc[m][n + 1][0], acc[m][n + 1][1]), y1 = pack2(acc[m][n + 1][2], acc[m][n + 1][3]);
      const u32x2 s0 = __builtin_amdgcn_permlane16_swap(x0, y0, false, false);
      const u32x2 s1 = __builtin_amdgcn_permlane16_swap(x1, y1, false, false);
      *(u32x4*)(dstplane + (long)((n + (fq & 1)) * 16 + fr) * rowlen + pos0 + m * 16 + (fq & 2) * 4) = u32x4{s0[0], s1[0], s0[1], s1[1]};
    }
}

DEVI void rope_sincos(int t, int i, float& sn, float& cs) {
  float inv = __powf(10000.f, -(float)i * (1.f / 16.f));
  float ang = (float)t * inv;
  float k = rintf(ang * 0.15915494309189535f);
  float r = fmaf(-k, 6.28125f, ang);
  r = fmaf(-k, 1.9353071795864769e-3f, r);
  sn = __sinf(r); cs = __cosf(r);
}

DEVI int win_srccol(int n) {
  if (n < 1280) return n;
  if (n < 1664) return 1304 + (n - 1280);
  if (n < 1792) return 1688 + (n - 1664);
  if (n < 2560) return 1848 + (n - 1792);
  if (n < 2592) return 1816 + (n - 2560);
  if (n < 2616) return 1280 + (n - 2592);
  if (n < 2620) return n;
  return -1;
}

template <int MODE>
DEVI void prep_transpose(const float* __restrict__ src, int ldsrc, int K, int Ndst, bf16* __restrict__ dst,
                         const float* __restrict__ kscale, char* smem, int rot) {
  float(*tile)[65] = (float(*)[65])smem;
  const int tid = opaque_tid();
  const int KT = K >> 6, NTL = Ndst >> 6, ntiles = KT * NTL;
  const int c4 = (tid & 15) * 4, r16 = tid >> 4;
  int start = (int)blockIdx.x - rot; if (start < 0) start += gridDim.x;
  for (int t = start; t < ntiles; t += gridDim.x) {
    int kt = t % KT, nt = t / KT;
    int n = nt * 64 + c4;
    int sc = MODE == 1 ? win_srccol(n) : n;
    __syncthreads();
#pragma unroll
    for (int i = 0; i < 4; ++i) {
      int k = i * 16 + r16;
      f32x4 v = f32x4{0.f, 0.f, 0.f, 0.f};
      if (sc >= 0) v = *(const f32x4*)(src + (long)(kt * 64 + k) * ldsrc + sc);
      if (kscale) v *= kscale[kt * 64 + k];
      tile[k][c4] = v[0]; tile[k][c4 + 1] = v[1]; tile[k][c4 + 2] = v[2]; tile[k][c4 + 3] = v[3];
    }
    __syncthreads();
    int nn = tid >> 2, kq = tid & 3;
    unsigned w[8];
#pragma unroll
    for (int e = 0; e < 8; ++e) w[e] = pack2(tile[kq * 16 + 2 * e][nn], tile[kq * 16 + 2 * e + 1][nn]);
    u32x4* dp = (u32x4*)(dst + (long)(nt * 64 + nn) * K + kt * 64 + kq * 16);
    dp[0] = u32x4{w[0], w[1], w[2], w[3]};
    dp[1] = u32x4{w[4], w[5], w[6], w[7]};
  }
}

DEVI void phase_prep(const Params& p, int L, char* smem) {
  char* ws = opaque_ptr(p.ws);
  const int G = gridDim.x;
  int rot = 0;
#define PREP(MODE, SRC, LDS_, KK, ND, DST, SC) \
  { prep_transpose<MODE>(SRC, LDS_, KK, ND, (bf16*)(ws + DST), SC, smem, rot); rot = (rot + ((KK) >> 6) * ((ND) >> 6)) % G; }
  PREP(1, p.in[2] + (size_t)L * 1024 * 2620, 2620, 1024, 2688, OFF_WIN, nullptr)
  PREP(0, p.in[12] + (size_t)L * 1024 * 3072, 3072, 1024, 3072, OFF_WG, nullptr)
  PREP(0, p.in[13] + (size_t)L * 512 * 1024, 1024, 512, 1024, OFF_WBN, nullptr)
  PREP(0, p.in[14] + (size_t)L * 256 * 1024, 1024, 256, 1024, OFF_WBM, nullptr)
  PREP(0, p.in[15] + (size_t)L * 256 * 1024, 1024, 256, 1024, OFF_WBF, nullptr)
  PREP(0, p.in[16] + (size_t)L * 1024 * 1024, 1024, 1024, 1024, OFF_WOUT, nullptr)
  PREP(0, p.in[17] + (size_t)L * 1024 * 256, 256, 1024, 256, OFF_WXQ, nullptr)
  PREP(0, p.in[18] + (size_t)L * 1024 * 512, 512, 1024, 512, OFF_WXKV, nullptr)
  PREP(0, p.in[19] + (size_t)L * 256 * 1024, 1024, 256, 1024, OFF_WXO, nullptr)
  PREP(0, p.in[20] + (size_t)L * 1024 * 4096, 4096, 1024, 4096, OFF_WUP, nullptr)
  PREP(0, p.in[21] + (size_t)L * 4096 * 1024, 1024, 4096, 1024, OFF_WDN, nullptr)
  PREP(0, p.in[8] + (size_t)L * 384 * 384, 384, 384, 384, OFF_WUQ, p.in[7] + L * 384)
  PREP(0, p.in[10] + (size_t)L * 128 * 512, 512, 128, 512, OFF_WUKV, p.in[9] + L * 128)
  PREP(0, p.in[4] + (size_t)(L * 2 + 0) * 2048 * 128, 128, 2048, 128, OFF_WC1, nullptr)
  PREP(0, p.in[4] + (size_t)(L * 2 + 1) * 2048 * 128, 128, 2048, 128, OFF_WC1 + (size_t)128 * 2048 * 2, nullptr)
  PREP(0, p.in[5] + (size_t)(L * 2 + 0) * 128 * 64, 64, 128, 64, OFF_WC2, nullptr)
  PREP(0, p.in[5] + (size_t)(L * 2 + 1) * 128 * 64, 64, 128, 64, OFF_WC2 + (size_t)64 * 128 * 2, nullptr)
#undef PREP
  {
    int bsel = (int)blockIdx.x - (G - 64);
    if (bsel >= 0) {
      const int tid = opaque_tid();
      const int kv = bsel >> 5, chunk = bsel & 31;
      const float* pe = p.in[3] + (size_t)(L * 2 + kv) * 2048 + chunk * 64;
      const float* w1 = p.in[4] + (size_t)(L * 2 + kv) * 2048 * 128 + (size_t)chunk * 64 * 128;
      int n = tid & 127, half = tid >> 7;
      float s = 0.f;
#pragma unroll 8
      for (int k = half * 32; k < half * 32 + 32; ++k) s += pe[k] * w1[(long)k * 128 + n];
      float* red = (float*)smem;
      __syncthreads();
      red[tid] = s;
      __syncthreads();
      if (tid < 128) ((float*)(ws + OFF_B1))[(kv * 32 + chunk) * 128 + tid] = red[tid] + red[tid + 128];
      __syncthreads();
    }
  }
  if (L == 0) {
    const long gt = (long)blockIdx.x * 256 + opaque_tid(), gn = (long)G * 256;
    const f32x4* xs = (const f32x4*)p.in[0];
    f32x4* xo = (f32x4*)p.out;
    u32x2* xb = (u32x2*)(ws + OFF_XB);
    for (long i = gt; i < (long)T_TOK * 1024 / 4; i += gn) {
      f32x4 v = xs[i]; xo[i] = v;
      xb[i] = u32x2{pack2(v[0], v[1]), pack2(v[2], v[3])};
    }
    const f32x4* ms = (const f32x4*)p.in[1];
    u32x2* mb = (u32x2*)(ws + OFF_MEMB);
    for (long i = gt; i < (long)2048 * 1024 / 4; i += gn) {
      f32x4 v = ms[i];
      mb[i] = u32x2{pack2(v[0], v[1]), pack2(v[2], v[3])};
    }
  }
}

DEVI void epi_proj(const Params& p, int L, f32x4 (&acc)[4][4], int m0, int nt) {
  char* ws = opaque_ptr(p.ws);
  const int tid = opaque_tid(), lane = tid & 63, wid = tid >> 6, wr = wid >> 1, wc = wid & 1, fr = lane & 15, fq = lane >> 4;
  const int mbase = m0 + wr * 64;
  if (nt == 7 || nt == 9 || nt == 18 || nt == 19) {
    const int b = mbase >> 12, t0 = mbase & 4095;
    bf16* dstp;
    if (nt == 7) dstp = (bf16*)(ws + OFF_VST) + (long)(b * 2 + wc) * 64 * 4096;
    else if (nt == 9) dstp = (bf16*)(ws + OFF_VWT) + (long)(b * 2 + wc) * 64 * 4096;
    else dstp = (bf16*)(ws + OFF_VFT) + (long)(b * 4 + (nt - 18) * 2 + wc) * 64 * 4096;
    store_tr_wave(acc, dstp, 4096, t0);
  } else if (nt == 20) {
    if (wc == 0) {
      float* mb = (float*)(ws + OFF_XQ);
#pragma unroll
      for (int m = 0; m < 4; ++m)
#pragma unroll
        for (int j = 0; j < 4; ++j) {
          float* rp = mb + (long)(mbase + m * 16 + fq * 4 + j) * 64 + fr;
#pragma unroll
          for (int n = 0; n < 4; ++n) rp[n * 16] = acc[m][n][j];
        }
      if (fr >= 8 && fr < 12) {
        float* flog = (float*)(ws + OFF_FLOG);
        const float bfh = p.in[11][L * 4 + (fr - 8)];
#pragma unroll
        for (int m = 0; m < 4; ++m)
#pragma unroll
          for (int j = 0; j < 4; ++j) {
            const float x = acc[m][3][j] + bfh;
            flog[(long)(mbase + m * 16 + fq * 4 + j) * 4 + (fr - 8)] = fminf(x, 0.f) - log1pf(__expf(-fabsf(x)));
          }
      }
    }
  } else {
    store_rm(acc, (bf16*)(ws + OFF_PROJ), PROJ_LD, m0, nt * 128);
  }
}

DEVI void phase_proj(const Params& p, int L, char* smem) {
  char* ws = opaque_ptr(p.ws);
  const bf16* xb = (const bf16*)(ws + OFF_XB);
  constexpr int NTILE = 256 * 21;
  for (int t = blockIdx.x; t < NTILE + 64; t += gridDim.x) {
    f32x4 acc[4][4];
    zero_acc(acc);
    if (t < NTILE) {
      int mt, nt; tile_swz(t, 256, 21, mt, nt);
      if (nt == 7 || nt == 9 || nt >= 18) {
        gemm_mainloop_g<4, false, RowLinear, false, true>(acc, xb, RowLinear{1024}, 64, (const bf16*)(ws + OFF_WIN), 1024, 1024, mt * 128, nt * 128, smem);
        epi_proj(p, L, acc, mt * 128, nt);
      } else {
        gemm_mainloop_g<4, true, RowLinear, false, true>(acc, xb, RowLinear{1024}, 64, (const bf16*)(ws + OFF_WIN), 1024, 1024, mt * 128, nt * 128, smem);
        store_rm_sw(acc, (bf16*)(ws + OFF_PROJ), PROJ_LD, mt * 128, nt * 128);
      }
    } else {
      int u = t - NTILE; int mt = u >> 2, nt = u & 3;
      GEMM_ML<4, false>(acc, (const bf16*)(ws + OFF_MEMB), RowLinear{1024}, 64, (const bf16*)(ws + OFF_WXKV), 1024, 1024, mt * 128, nt * 128, smem);
      const int wid = opaque_tid() >> 6, wr = wid >> 1, wc = wid & 1;
      if (nt < 2) store_rm(acc, (bf16*)(ws + OFF_KXA), 256, mt * 128, nt * 128);
      else {
        int row0 = mt * 128 + wr * 64; int b = row0 >> 8, mm = row0 & 255;
        int h = (nt - 2) * 2 + wc;
        store_tr_wave(acc, (bf16*)(ws + OFF_VXA) + (long)(b * 4 + h) * 64 * 256, 256, mm);
      }
    }
  }
}

DEVI float gelu_tanh(float x) {
  float u = 0.7978845608028654f * (x + 0.044715f * x * x * x);
  return 0.5f * x * (1.f + tanhf(u));
}

DEVI void phase_derived(const Params& p, int L, char* smem) {
  char* ws = opaque_ptr(p.ws);
  const int tid = opaque_tid(), lane = tid & 63, wid = tid >> 6, wr = wid >> 1, wc = wid & 1, fr = lane & 15, fq = lane >> 4;
  const bf16* proj = (const bf16*)(ws + OFF_PROJ);
  constexpr int N_CMP = 64, N_CUM = 8, N_MISC = 512, N_QUP = 768, N_KVUP = 1024;
  const bool cmpblk = (int)gridDim.x > 2 * N_CMP && (int)blockIdx.x < N_CMP;
  const int dstride = (int)gridDim.x > 2 * N_CMP ? (int)gridDim.x - N_CMP : (int)gridDim.x;
  for (int t0_ = blockIdx.x; t0_ < N_CMP + N_CUM + N_MISC + N_QUP + N_KVUP; t0_ += cmpblk ? (1 << 20) : dstride) {
    int t;
    if (t0_ < N_CMP) t = t0_;
    else if (t0_ < N_CMP + N_CUM) t = N_CMP + N_QUP + N_KVUP + (t0_ - N_CMP);
    else if (t0_ < N_CMP + N_CUM + N_MISC) t = N_CMP + N_QUP + N_KVUP + N_CUM + (t0_ - N_CMP - N_CUM);
    else t = N_CMP + (t0_ - N_CMP - N_CUM - N_MISC);
    if (t < N_CMP) {
      const int kv = t >> 5, mt = t & 31;
      f32x4 acc[4][4]; zero_acc(acc);
      GEMM_ML<4, false>(acc, proj, RowCmp{kv ? 640 : 512}, PROJ_LD, (const bf16*)(ws + OFF_WC1) + (long)kv * 128 * 2048, 2048, 2048, mt * 128, 0, smem);
      __syncthreads();
      bf16* Hs = (bf16*)smem;
      const float* b1 = (const float*)(ws + OFF_B1) + kv * 32 * 128;
#pragma unroll
      for (int n = 0; n < 4; ++n) {
        const int col = wc * 64 + n * 16 + fr;
        float bb = 0.f;
#pragma unroll 8
        for (int ch = 0; ch < 32; ++ch) bb += b1[ch * 128 + col];
#pragma unroll
        for (int m = 0; m < 4; ++m)
#pragma unroll
          for (int j = 0; j < 4; ++j) Hs[(wr * 64 + m * 16 + fq * 4 + j) * 136 + col] = f2bf(gelu_tanh(acc[m][n][j] + bb));
      }
      __syncthreads();
      f32x4 a2[4][2];
#pragma unroll
      for (int m = 0; m < 4; ++m) { a2[m][0] = f32x4{0.f, 0.f, 0.f, 0.f}; a2[m][1] = f32x4{0.f, 0.f, 0.f, 0.f}; }
      const bf16* w2 = (const bf16*)(ws + OFF_WC2) + (long)kv * 64 * 128;
#pragma unroll
      for (int ks = 0; ks < 4; ++ks) {
        bf16x8 af[4], bq[2];
#pragma unroll
        for (int m = 0; m < 4; ++m) af[m] = *(const bf16x8*)(Hs + (wr * 64 + m * 16 + fr) * 136 + ks * 32 + fq * 8);
#pragma unroll
        for (int n = 0; n < 2; ++n) bq[n] = *(const bf16x8*)(w2 + (wc * 32 + n * 16 + fr) * 128 + ks * 32 + fq * 8);
#pragma unroll
        for (int m = 0; m < 4; ++m)
#pragma unroll
          for (int n = 0; n < 2; ++n) a2[m][n] = __builtin_amdgcn_mfma_f32_16x16x32_bf16(af[m], bq[n], a2[m][n], 0, 0, 0);
      }
#pragma unroll
      for (int m = 0; m < 4; ++m)
#pragma unroll
        for (int n = 0; n < 2; ++n) {
          const int r0 = mt * 128 + wr * 64 + m * 16 + fq * 4;
          const int col = wc * 32 + n * 16 + fr;
          if (kv == 0) {
            bf16* kc = (bf16*)(ws + OFF_KC);
#pragma unroll
            for (int j = 0; j < 4; ++j) kc[(long)(r0 + j) * 64 + col] = f2bf(a2[m][n][j]);
          } else {
            bf16* vct = (bf16*)(ws + OFF_VCT);
            u32x2 v; v[0] = pack2(a2[m][n][0], a2[m][n][1]); v[1] = pack2(a2[m][n][2], a2[m][n][3]);
            *(u32x2*)(vct + ((long)(r0 >> 8) * 64 + col) * 256 + (r0 & 255)) = v;
          }
        }
    } else if (t < N_CMP + N_QUP) {
      const int u = t - N_CMP; const int mt = u / 3, nt = u - mt * 3;
      f32x4 acc[4][4]; zero_acc(acc);
      gemm_mainloop<true>(acc, proj + 1280, RowLinear{PROJ_LD}, 64, (const bf16*)(ws + OFF_WUQ), 384, 384, mt * 128, nt * 128, smem);
      const float* rowss = (const float*)(smem + SM_ROWSS);
      bf16* qmla = (bf16*)(ws + OFF_QMLA);
      const int nbase = nt * 128 + wc * 64;
#pragma unroll
      for (int m = 0; m < 4; ++m)
#pragma unroll
        for (int j = 0; j < 4; ++j) {
          const int lr = wr * 64 + m * 16 + fq * 4 + j;
          const int row = mt * 128 + lr;
          const float rinv = rsqrtf(rowss[lr] * (1.f / 384.f) + 1e-6f);
          float v[4];
#pragma unroll
          for (int n = 0; n < 4; ++n) v[n] = acc[m][n][j] * rinv;
#pragma unroll
          for (int n = 0; n < 3; ++n) {
            if (((nbase + n * 16) % 96) == 64) {
              float sn, cs; rope_sincos(row & 4095, fr, sn, cs);
              float x1 = v[n], x2 = v[n + 1];
              v[n] = x1 * cs - x2 * sn; v[n + 1] = x1 * sn + x2 * cs;
            }
          }
#pragma unroll
          for (int n = 0; n < 4; ++n) qmla[(long)row * 384 + nbase + n * 16 + fr] = f2bf(v[n]);
        }
    } else if (t < N_CMP + N_QUP + N_KVUP) {
      const int u = t - N_CMP - N_QUP; const int mt = u >> 2, nt = u & 3;
      f32x4 acc[4][4]; zero_acc(acc);
      gemm_mainloop<true>(acc, proj + 1664, RowLinear{PROJ_LD}, 64, (const bf16*)(ws + OFF_WUKV), 128, 128, mt * 128, nt * 128, smem);
      const float* rowss = (const float*)(smem + SM_ROWSS);
#pragma unroll
      for (int m = 0; m < 4; ++m)
#pragma unroll
        for (int j = 0; j < 4; ++j) {
          const float rinv = rsqrtf(rowss[wr * 64 + m * 16 + fq * 4 + j] * (1.f / 128.f) + 1e-6f);
#pragma unroll
          for (int n = 0; n < 4; ++n) acc[m][n][j] *= rinv;
        }
      const int mbase = mt * 128 + wr * 64;
      if (wc == 0) {
        bf16* kmla = (bf16*)(ws + OFF_KMLA);
#pragma unroll
        for (int m = 0; m < 4; ++m)
#pragma unroll
          for (int j = 0; j < 4; ++j) {
            bf16* rp = kmla + (long)(mbase + m * 16 + fq * 4 + j) * 384 + nt * 96 + fr;
#pragma unroll
            for (int n = 0; n < 4; ++n) rp[n * 16] = f2bf(acc[m][n][j]);
          }
      } else {
        const int b = mbase >> 12, t0 = mbase & 4095;
        store_tr_wave(acc, (bf16*)(ws + OFF_VMT) + (long)(b * 4 + nt) * 64 * 4096, 4096, t0);
      }
    } else if (t < N_CMP + N_QUP + N_KVUP + N_CUM) {
      const int u = t - N_CMP - N_QUP - N_KVUP;
      const int seq = u * 4 + wid;
      const int b = seq >> 2, h = seq & 3;
      const float* flog = (const float*)(ws + OFF_FLOG) + (long)b * 4096 * 4 + h;
      float* cum = (float*)(ws + OFF_CUM) + (long)seq * 4096;
      float s = 0.f;
      for (int i = 0; i < 64; ++i) s += flog[(long)(lane * 64 + i) * 4];
      float incl = s;
#pragma unroll
      for (int off = 1; off < 64; off <<= 1) { float o = __shfl_up(incl, off); if (lane >= off) incl += o; }
      float run = incl - s;
      for (int i = 0; i < 64; ++i) { run += flog[(long)(lane * 64 + i) * 4]; cum[lane * 64 + i] = run * LOG2E; }
    } else {
      const int u = t - N_CMP - N_QUP - N_KVUP - N_CUM;
      const int row = u * 64 + (tid >> 2), sub = tid & 3;
      const float* mb = (const float*)(ws + OFF_XQ) + (long)row * 64;
      bf16* kmla = (bf16*)(ws + OFF_KMLA) + (long)row * 384;
      float* gaux = (float*)(ws + OFF_GAUX) + (long)row * 32;
      const int tpos = row & 4095;
#pragma unroll
      for (int q = 0; q < 4; ++q) {
        const int i = sub * 4 + q;
        float sn, cs; rope_sincos(tpos, i, sn, cs);
        const float x1 = mb[i], x2 = mb[16 + i];
        const bf16 y1 = f2bf(x1 * cs - x2 * sn), y2 = f2bf(x1 * sn + x2 * cs);
#pragma unroll
        for (int hh = 0; hh < 4; ++hh) { kmla[hh * 96 + 64 + i] = y1; kmla[hh * 96 + 80 + i] = y2; }
      }
#pragma unroll
      for (int q = 0; q < 6; ++q) { const int gi = sub * 6 + q; gaux[gi] = sigmoidf(mb[32 + gi]); }
    }
  }
}

DEVI float xmax16(float x) {
  u32x2 r = __builtin_amdgcn_permlane16_swap(__float_as_uint(x), __float_as_uint(x), false, false);
  return fmaxf(__uint_as_float(r[0]), __uint_as_float(r[1]));
}
DEVI float xmax32(float x) {
  u32x2 r = __builtin_amdgcn_permlane32_swap(__float_as_uint(x), __float_as_uint(x), false, false);
  return fmaxf(__uint_as_float(r[0]), __uint_as_float(r[1]));
}
template <int CTRL> DEVI float dppf(float v) { return __int_as_float(__builtin_amdgcn_update_dpp(0, __float_as_int(v), CTRL, 0xF, 0xF, true)); }
template <int CTRL> DEVI unsigned dppu(unsigned v) { return (unsigned)__builtin_amdgcn_update_dpp(0, (int)v, CTRL, 0xF, 0xF, true); }
constexpr int DPP_X1 = 0xB1, DPP_X2 = 0x4E, DPP_HM = 0x141, DPP_M = 0x140;
DEVI float quad_sum(float v) { v += dppf<DPP_X1>(v); v += dppf<DPP_X2>(v); return v; }
DEVI float row16_sum(float v) { v = quad_sum(v); v += dppf<DPP_HM>(v); v += dppf<DPP_M>(v); return v; }
DEVI float wave_sum(float v) {
  v = row16_sum(v);
  u32x2 r = __builtin_amdgcn_permlane16_swap(__float_as_uint(v), __float_as_uint(v), false, false);
  v = __uint_as_float(r[0]) + __uint_as_float(r[1]);
  r = __builtin_amdgcn_permlane32_swap(__float_as_uint(v), __float_as_uint(v), false, false);
  return __uint_as_float(r[0]) + __uint_as_float(r[1]);
}
DEVI float max3f(float a, float b, float c) { return fmaxf(fmaxf(a, b), c); }
DEVI float max16(const f32x4& a, const f32x4& b, const f32x4& c, const f32x4& d) {
  const float t0 = max3f(a[0], a[1], a[2]), t1 = max3f(a[3], b[0], b[1]), t2 = max3f(b[2], b[3], c[0]);
  const float t3 = max3f(c[1], c[2], c[3]), t4 = max3f(d[0], d[1], d[2]);
  return fmaxf(max3f(t0, t1, t2), max3f(t3, t4, d[3]));
}
constexpr float DEFER_THR = 8.f;

template <int DK, int MODE, int RBM, class SF, class FF, class POST>
DEVI void attn_tile_body(const bf16x8 (&qf)[2][DK / 32], const char* Ks, const char* Vs, SF& sf, FF& ff, POST& post,
                         int cur, int c0, int c1, float (&m)[2], float (&l)[2], f32x4 (&o)[5][2], int fr, int fq) {
  constexpr int NKC = DK / 32;
  f32x4 s[4][2];
#pragma unroll
  for (int kb = 0; kb < 4; ++kb) { s[kb][0] = f32x4{0.f, 0.f, 0.f, 0.f}; s[kb][1] = f32x4{0.f, 0.f, 0.f, 0.f}; }
#pragma unroll
  for (int ks = 0; ks < NKC; ++ks)
#pragma unroll
    for (int kb = 0; kb < 4; ++kb) {
      const int koff = DK == 64 ? (kb * 16 + fr) * 128 + (((ks * 4 + fq) ^ (fr & 7)) * 16)
                                : (kb * 16 + fr) * 192 + ((ks * 4 + (fq ^ ((fr >> 2) & 3))) * 16);
      bf16x8 kf = *(const bf16x8*)(Ks + koff);
      if (RBM & 1) s[kb][0] = __builtin_amdgcn_mfma_f32_16x16x32_bf16(kf, qf[0][ks], s[kb][0], 0, 0, 0);
      if (RBM & 2) s[kb][1] = __builtin_amdgcn_mfma_f32_16x16x32_bf16(kf, qf[1][ks], s[kb][1], 0, 0, 0);
    }
#pragma unroll
  for (int rb = 0; rb < 2; ++rb) {
    if (!(RBM & (1 << rb))) continue;
    const int cm = rb == 0 ? c0 : c1;
    if (cm == 2) {
      const float cl = ff.cl(rb, cur);
      const float fsc = ff.sc;
      if (FF::HASVEC) {
#pragma unroll
        for (int kb = 0; kb < 4; ++kb) {
          const f32x4 av = ff.vec(kb);
#pragma unroll
          for (int j = 0; j < 4; ++j) s[kb][rb][j] = opq(fmaf(s[kb][rb][j], fsc, av[j]));
        }
      }
      if (MODE == 2) {
        const float c = cl - m[rb];
#pragma unroll
        for (int kb = 0; kb < 4; ++kb)
#pragma unroll
          for (int j = 0; j < 4; ++j) {
            const float e = FF::HASVEC ? opq(s[kb][rb][j] + c) : opq(fmaf(s[kb][rb][j], fsc, c));
            s[kb][rb][j] = opq(fexp2(e) * l[rb]);
          }
      } else if (MODE == 0) {
        float mx = max16(s[0][rb], s[1][rb], s[2][rb], s[3][rb]);
        mx = xmax16(mx); mx = xmax32(mx);
        const float cand = FF::HASVEC ? (mx + cl) : fmaf(mx, fsc, cl);
        if (__builtin_amdgcn_ballot_w64(cand > m[rb] + DEFER_THR) != 0) {
          const float mn = fmaxf(m[rb], cand);
          const float alpha = fexp2(m[rb] - mn);
          m[rb] = mn;
#pragma unroll
          for (int db = 0; db < 5; ++db)
#pragma unroll
            for (int j = 0; j < 4; ++j) o[db][rb][j] = opq(o[db][rb][j] * alpha);
        }
        const float c = cl - m[rb];
#pragma unroll
        for (int kb = 0; kb < 4; ++kb)
#pragma unroll
          for (int j = 0; j < 4; ++j) {
            const float e = FF::HASVEC ? opq(s[kb][rb][j] + c) : opq(fmaf(s[kb][rb][j], fsc, c));
            s[kb][rb][j] = fexp2(e);
          }
      } else {
        float mx = max16(s[0][rb], s[1][rb], s[2][rb], s[3][rb]);
        mx = xmax16(mx); mx = xmax32(mx);
        const float cand = FF::HASVEC ? (mx + cl) : fmaf(mx, fsc, cl);
        const float mn = fmaxf(m[rb], cand);
        const float alpha = fexp2(m[rb] - mn);
        m[rb] = mn;
        const float c = cl - mn;
        float rs0 = 0.f, rs1 = 0.f;
#pragma unroll
        for (int kb = 0; kb < 4; ++kb)
#pragma unroll
          for (int j = 0; j < 4; ++j) {
            const float e = FF::HASVEC ? opq(s[kb][rb][j] + c) : opq(fmaf(s[kb][rb][j], fsc, c));
            const float pv = fexp2(e);
            s[kb][rb][j] = pv;
            if (j & 1) rs1 = opq(rs1 + pv); else rs0 = opq(rs0 + pv);
          }
        l[rb] = fmaf(l[rb], alpha, rs0 + rs1);
      }
      continue;
    }
#pragma unroll
    for (int kb = 0; kb < 4; ++kb)
#pragma unroll
      for (int j = 0; j < 4; ++j) s[kb][rb][j] = sf(rb, kb, j, cur, s[kb][rb][j]);
    if (MODE == 2) {
#pragma unroll
      for (int kb = 0; kb < 4; ++kb)
#pragma unroll
        for (int j = 0; j < 4; ++j) s[kb][rb][j] = fexp2(s[kb][rb][j] - m[rb]) * l[rb];
    } else if (MODE == 0) {
      float mx = max16(s[0][rb], s[1][rb], s[2][rb], s[3][rb]);
      mx = xmax16(mx); mx = xmax32(mx);
      if (__builtin_amdgcn_ballot_w64(mx > m[rb] + DEFER_THR) != 0) {
        const float mn = fmaxf(m[rb], mx);
        const float alpha = fexp2(m[rb] - mn);
        m[rb] = mn;
#pragma unroll
        for (int db = 0; db < 5; ++db)
#pragma unroll
          for (int j = 0; j < 4; ++j) o[db][rb][j] = opq(o[db][rb][j] * alpha);
      }
      const float mm = m[rb];
#pragma unroll
      for (int kb = 0; kb < 4; ++kb)
#pragma unroll
        for (int j = 0; j < 4; ++j) s[kb][rb][j] = fexp2(s[kb][rb][j] - mm);
    } else {
      float mx = -INFINITY;
#pragma unroll
      for (int kb = 0; kb < 4; ++kb)
#pragma unroll
        for (int j = 0; j < 4; ++j) mx = fmaxf(mx, s[kb][rb][j]);
      mx = xmax16(mx); mx = xmax32(mx);
      const float mn = fmaxf(m[rb], mx);
      const float alpha = fexp2(m[rb] - mn);
      m[rb] = mn;
      float rs = 0.f;
#pragma unroll
      for (int kb = 0; kb < 4; ++kb)
#pragma unroll
        for (int j = 0; j < 4; ++j) { float pv = fexp2(s[kb][rb][j] - mn); s[kb][rb][j] = pv; rs += pv; }
      l[rb] = l[rb] * alpha + rs;
    }
  }
  if (MODE == 2) post(cur, s);
  if (MODE != 1) {
    bf16x8 pf[2][2];
#pragma unroll
    for (int rb = 0; rb < 2; ++rb) {
      if (!(RBM & (1 << rb))) continue;
#pragma unroll
      for (int kp2 = 0; kp2 < 2; ++kp2) {
        u32x4 w;
        w[0] = pack2(s[2 * kp2][rb][0], s[2 * kp2][rb][1]); w[1] = pack2(s[2 * kp2][rb][2], s[2 * kp2][rb][3]);
        w[2] = pack2(s[2 * kp2 + 1][rb][0], s[2 * kp2 + 1][rb][1]); w[3] = pack2(s[2 * kp2 + 1][rb][2], s[2 * kp2 + 1][rb][3]);
        pf[rb][kp2] = __builtin_bit_cast(bf16x8, w);
      }
    }
#pragma unroll
    for (int kp2 = 0; kp2 < 2; ++kp2)
#pragma unroll
      for (int db = 0; db < 4; ++db) {
        const char* base = Vs + (db * 16 + fr) * 128 + (fq & 1) * 8;
        const int c = kp2 * 4 + (fq >> 1);
        u32x2 lo = *(const u32x2*)(base + ((c ^ (fr & 7)) * 16));
        u32x2 hi = *(const u32x2*)(base + (((c + 2) ^ (fr & 7)) * 16));
        u32x4 w; w[0] = lo[0]; w[1] = lo[1]; w[2] = hi[0]; w[3] = hi[1];
        bf16x8 vf = __builtin_bit_cast(bf16x8, w);
        if (RBM & 1) o[db][0] = __builtin_amdgcn_mfma_f32_16x16x32_bf16(vf, pf[0][kp2], o[db][0], 0, 0, 0);
        if (RBM & 2) o[db][1] = __builtin_amdgcn_mfma_f32_16x16x32_bf16(vf, pf[1][kp2], o[db][1], 0, 0, 0);
      }
    if (MODE == 0) {
      u32x4 w1; w1[0] = w1[1] = w1[2] = w1[3] = 0x3F803F80u;
      const bf16x8 ones = __builtin_bit_cast(bf16x8, w1);
#pragma unroll
      for (int kp2 = 0; kp2 < 2; ++kp2) {
        if (RBM & 1) o[4][0] = __builtin_amdgcn_mfma_f32_16x16x32_bf16(ones, pf[0][kp2], o[4][0], 0, 0, 0);
        if (RBM & 2) o[4][1] = __builtin_amdgcn_mfma_f32_16x16x32_bf16(ones, pf[1][kp2], o[4][1], 0, 0, 0);
      }
    }
  }
}

template <int DK, int MODE, bool RBSKIP, bool HASCUM, class KP, class VP, class CP, class SF, class FF, class CLS, class POST>
DEVI void attn_run(u64 tiles, u64 wtiles, const bf16x8 (&qf)[2][DK / 32], KP kp, VP vp, CP cp, SF sf, FF ff, CLS cls, POST post,
                   float (&m)[2], float (&l)[2], f32x4 (&o)[5][2], char* smem, const char*& curslot) {
  constexpr int NKC = DK / 32;
  constexpr int CPR = DK / 8;
  const int tid = opaque_tid(), lane = tid & 63, fr = lane & 15, fq = lane >> 4;
  if (tiles == 0) return;
#define ATT_ISSUE(TILE, SLOT)                                                                             \
  {                                                                                                       \
    char* sb = smem + (SLOT) * GEO::STRIDE;                                                               \
    _Pragma("unroll") for (int i = 0; i < NKC; ++i) {                                                     \
      const int q = tid + 256 * i; const int row = q / CPR, pos = q - row * CPR;                          \
      const int gc = DK == 64 ? (pos ^ (row & 7)) : ((pos & ~3) | ((pos & 3) ^ ((row >> 2) & 3)));        \
      __builtin_amdgcn_global_load_lds((const unsigned*)(kp(TILE, row) + gc * 8), (unsigned*)(sb + q * 16), 16, 0, 0); \
    }                                                                                                     \
    if (MODE != 1) {                                                                                      \
      _Pragma("unroll") for (int i = 0; i < 2; ++i) {                                                     \
        const int q = tid + 256 * i; const int d = q >> 3, pos = q & 7;                                   \
        __builtin_amdgcn_global_load_lds((const unsigned*)(vp(TILE, d) + ((pos ^ (d & 7)) * 8)), (unsigned*)(sb + GEO::AVO + q * 16), 16, 0, 0); \
      }                                                                                                   \
    }                                                                                                     \
    if (HASCUM) {                                                                                         \
      if (lane < 16) __builtin_amdgcn_global_load_lds((const unsigned*)(cp(TILE) + lane * 4), (unsigned*)(sb + GEO::ACO + lane * 16), 16, 0, 0); \
    }                                                                                                     \
  }
#define ATT_POP(VAR) { VAR = -1; if (tiles) { VAR = __builtin_ctzll(tiles); tiles &= tiles - 1; } }
#define ATT_COMPUTE(TILE, SLOT)                                                                           \
  if ((wtiles >> (TILE)) & 1) {                                                                           \
    const char* sb = smem + (SLOT) * GEO::STRIDE;                                                         \
    curslot = sb;                                                                                         \
    const int c0 = cls(0, (TILE)), c1 = cls(1, (TILE));                                                   \
    if (RBSKIP) {                                                                                         \
      if (c0) attn_tile_body<DK, MODE, 1>(qf, sb, sb + GEO::AVO, sf, ff, post, (TILE), c0, c1, m, l, o, fr, fq); \
      if (c1) attn_tile_body<DK, MODE, 2>(qf, sb, sb + GEO::AVO, sf, ff, post, (TILE), c0, c1, m, l, o, fr, fq); \
    } else {                                                                                              \
      attn_tile_body<DK, MODE, 3>(qf, sb, sb + GEO::AVO, sf, ff, post, (TILE), c0, c1, m, l, o, fr, fq);  \
    }                                                                                                     \
  }
  using GEO = RingGeo<DK>;
  __syncthreads();
  if (DK == 64) {
    int ta, tb;
    ATT_POP(ta) ATT_ISSUE(ta, 0)
    ATT_POP(tb) if (tb >= 0) ATT_ISSUE(tb, 1)
    int sp = 0;
    for (;;) {
      asm volatile("s_waitcnt vmcnt(0)" ::: "memory");
      __builtin_amdgcn_s_barrier();
      int tc, td = -1;
      ATT_POP(tc)
      if (tc >= 0) { ATT_ISSUE(tc, sp ^ 2) ATT_POP(td) if (td >= 0) ATT_ISSUE(td, (sp ^ 2) + 1) }
      ATT_COMPUTE(ta, sp)
      if (tb >= 0) ATT_COMPUTE(tb, sp + 1)
      if (tc < 0) break;
      ta = tc; tb = td; sp ^= 2;
    }
  } else {
    int cur, n1;
    ATT_POP(cur) ATT_ISSUE(cur, 0)
    ATT_POP(n1) if (n1 >= 0) ATT_ISSUE(n1, 1)
    int si = 0;
    for (;;) {
      if (n1 >= 0) {
        constexpr int G = NKC + (MODE != 1 ? 2 : 0) + (HASCUM ? 1 : 0);
        if (G == 2) asm volatile("s_waitcnt vmcnt(2)" ::: "memory");
        else if (G == 4) asm volatile("s_waitcnt vmcnt(4)" ::: "memory");
        else if (G == 5) asm volatile("s_waitcnt vmcnt(5)" ::: "memory");
        else asm volatile("s_waitcnt vmcnt(0)" ::: "memory");
      } else {
        asm volatile("s_waitcnt vmcnt(0)" ::: "memory");
      }
      __builtin_amdgcn_s_barrier();
      int n2;
      ATT_POP(n2)
      if (n2 >= 0) { const int s2 = si >= 1 ? si - 1 : 2; ATT_ISSUE(n2, s2) }
      ATT_COMPUTE(cur, si)
      if (n1 < 0) break;
      cur = n1; n1 = n2; si = si == 2 ? 0 : si + 1;
    }
  }
#undef ATT_COMPUTE
#undef ATT_POP
#undef ATT_ISSUE
  __syncthreads();
}

template <class CL>
struct FastConst { static constexpr bool HASVEC = false; float sc; CL clf; DEVI float cl(int rb, int tile) const { return clf(rb, tile); } DEVI f32x4 vec(int) const { return f32x4{0.f, 0.f, 0.f, 0.f}; } };
template <class CL, class VF>
struct FastVec { static constexpr bool HASVEC = true; float sc; CL clf; VF vf; DEVI float cl(int rb, int tile) const { return clf(rb, tile); } DEVI f32x4 vec(int kb) const { return vf(kb); } };
template <class CL> DEVI FastConst<CL> make_fast(float sc, CL cl) { return FastConst<CL>{sc, cl}; }
template <class CL, class VF> DEVI FastVec<CL, VF> make_fast_vec(float sc, CL cl, VF vf) { return FastVec<CL, VF>{sc, cl, vf}; }

DEVI float row_lsum(float l) { l += __shfl_xor(l, 16); l += __shfl_xor(l, 32); return l; }

struct NoCum { DEVI const float* operator()(int) const { return nullptr; } };
struct NoPost { DEVI void operator()(int, f32x4 (&)[4][2]) const {} };

DEVI void nsa_item(const Params& p, int b, int g, int t0, char* smem) {
  char* ws = opaque_ptr(p.ws);
  const int tid = opaque_tid(), lane = tid & 63, wid = tid >> 6, fr = lane & 15, fq = lane >> 4;
  const bf16* proj = (const bf16*)(ws + OFF_PROJ);
  float* lut = (float*)(smem + ALUT);
  float* imp = (float*)(smem + AIMP);
  u64* selm = (u64*)(smem + ASEL);
  __syncthreads();
  const float* t5 = p.in[6];
  for (int e = tid; e < 512; e += 256) { int r = e >> 7, d = e & 127; lut[e] = t5[T5BUCKET[d] * 8 + g * 4 + r] * LOG2E; }
  for (int e = tid; e < 2048; e += 256) imp[e] = 0.f;
  const int hl = fr & 3, h = g * 4 + hl;
  int tl[2], t[2];
  tl[0] = wid * 8 + (fr >> 2); tl[1] = tl[0] + 4;
#pragma unroll
  for (int rb = 0; rb < 2; ++rb) t[rb] = t0 + tl[rb];
  bf16x8 qf[2][2];
#pragma unroll
  for (int rb = 0; rb < 2; ++rb)
#pragma unroll
    for (int ks = 0; ks < 2; ++ks) qf[rb][ks] = *(const bf16x8*)(proj + ((long)b * 4096 + t[rb]) * PROJ_LD + h * 64 + ks * 32 + fq * 8);
  const float* gaux = (const float*)(ws + OFF_GAUX);
  f32x4* totl = (f32x4*)(ws + OFF_OXA) + (size_t)blockIdx.x * 8 * 256 + tid;
  const char* curslot = smem;
  const float* lutr = lut + hl * 128;
  const float sc = 0.125f * LOG2E;
  const int uw = __builtin_amdgcn_readfirstlane(wid);
  const int tmin0 = t0 + uw * 8, tmin1 = tmin0 + 4;
  __syncthreads();

  float m[2], l[2]; f32x4 o[5][2];
#define RESET_STATE                                                                                   \
  {                                                                                                   \
    m[0] = m[1] = -1e30f; l[0] = l[1] = 0.f;                                                          \
    _Pragma("unroll") for (int db = 0; db < 5; ++db) { o[db][0] = f32x4{0.f, 0.f, 0.f, 0.f}; o[db][1] = f32x4{0.f, 0.f, 0.f, 0.f}; } \
  }
#define ACCUM_BRANCH(GI, NORMALIZED)                                                                  \
  {                                                                                                   \
    _Pragma("unroll") for (int rb = 0; rb < 2; ++rb) {                                                \
      float f = gaux[((long)b * 4096 + t[rb]) * 32 + h * 3 + GI];                                     \
      if (!(NORMALIZED)) { float ls = o[4][rb][0]; f = ls > 0.f ? f / ls : 0.f; }                     \
      _Pragma("unroll") for (int db = 0; db < 4; ++db) {                                              \
        f32x4* tp = totl + (rb * 4 + db) * 256;                                                       \
        if (GI == 0) *tp = o[db][rb] * f; else *tp = *tp + o[db][rb] * f;                             \
      }                                                                                               \
    }                                                                                                 \
  }

  {
    const bf16* kc = (const bf16*)(ws + OFF_KC) + (long)(b * 2 + g) * 256 * 64;
    const bf16* vct = (const bf16*)(ws + OFF_VCT) + (long)(b * 2 + g) * 64 * 256;
    const int nct = (t0 >> 10) + 1;
    const u64 ctiles = (1ull << nct) - 1;
    auto kpc = [&](int tile, int row) { return kc + (long)(tile * 64 + row) * 64; };
    auto vpc = [&](int tile, int d) { return vct + (long)d * 256 + tile * 64; };
    auto sfc = [&](int rb, int kb, int j, int tile, float s) {
      int cend = (tile * 64 + kb * 16 + fq * 4 + j) * 16 + 31;
      int dist = t[rb] - cend;
      int di = min(max(dist, 0), 127);
      return dist >= 0 ? fmaf(s, sc, lutr[di]) : -INFINITY;
    };
    const float cbf = lutr[127];
    auto ffc = make_fast(sc, [=](int rb, int tile) { return cbf; });
    auto clc = [&](int rb, int tile) { return ((rb ? tmin1 : tmin0) - ((tile * 64 + 63) * 16 + 31) >= 113) ? 2 : 1; };
    RESET_STATE
    attn_run<64, 1, false, false>(ctiles, ctiles, qf, kpc, vpc, NoCum{}, sfc, ffc, clc, NoPost{}, m, l, o, smem, curslot);
#pragma unroll
    for (int rb = 0; rb < 2; ++rb) { float ls = row_lsum(l[rb]); l[rb] = ls > 0.f ? 1.f / ls : 0.f; }
    auto postc = [&](int tile, f32x4 (&s)[4][2]) {
#pragma unroll
      for (int rb = 0; rb < 2; ++rb)
#pragma unroll
        for (int kb = 0; kb < 4; ++kb) {
          float P[4];
#pragma unroll
          for (int j = 0; j < 4; ++j) P[j] = quad_sum(s[kb][rb][j]);
          if (hl == 0) {
            int n = tile * 16 + kb * 4 + fq;
            atomicAdd(&imp[tl[rb] * 64 + n], 2.f * (P[0] + P[1] + P[2]) + P[3]);
            if (n + 1 < 64) atomicAdd(&imp[tl[rb] * 64 + n + 1], P[3]);
          }
        }
    };
    attn_run<64, 2, false, false>(ctiles, ctiles, qf, kpc, vpc, NoCum{}, sfc, ffc, clc, postc, m, l, o, smem, curslot);
    ACCUM_BRANCH(0, true)
  }
  __syncthreads();
  {
    const int tli = wid * 8 + (lane >> 3), sub = lane & 7;
    const int curb = (t0 + tli) >> 6;
    float v[8];
#pragma unroll
    for (int i = 0; i < 8; ++i) {
      int n = sub * 8 + i;
      float x = imp[tli * 64 + n];
      bool cand = (n <= curb) && (n != 0) && (n != curb) && (n != curb - 1);
      v[i] = cand ? x : -1.f;
    }
    u64 mask = 1ull | (1ull << curb) | (1ull << (curb > 0 ? curb - 1 : 0));
#pragma unroll 1
    for (int round = 0; round < 5; ++round) {
      float bv = v[0]; int bi = 0;
#pragma unroll
      for (int i = 1; i < 8; ++i) if (v[i] > bv) { bv = v[i]; bi = i; }
      int bn = sub * 8 + bi;
#pragma unroll
      for (int off = 1; off < 8; off <<= 1) {
        float ov = __shfl_xor(bv, off); int on = __shfl_xor(bn, off);
        if (ov > bv || (ov == bv && on < bn)) { bv = ov; bn = on; }
      }
      if (bv >= 0.f) mask |= 1ull << bn;
      const bool owner = (bn >> 3) == sub;
#pragma unroll
      for (int i = 0; i < 8; ++i) v[i] = (owner && i == (bn & 7)) ? -2.f : v[i];
    }
    if (curb < 8) mask = (2ull << curb) - 1;
    if (sub == 0) selm[tli] = mask;
  }
  __syncthreads();
  {
    u64 msk[2] = {selm[tl[0]], selm[tl[1]]};
    u64 U = 0;
    for (int i = 0; i < 32; ++i) U |= selm[i];
    const bf16* kb_ = proj + (long)b * 4096 * PROJ_LD + 768 + g * 64;
    const bf16* vst = (const bf16*)(ws + OFF_VST) + (long)(b * 2 + g) * 64 * 4096;
    auto kps = [&](int tile, int row) { return kb_ + (long)(tile * 64 + row) * PROJ_LD; };
    auto vps = [&](int tile, int d) { return vst + (long)d * 4096 + tile * 64; };
    auto sfs = [&](int rb, int kb, int j, int tile, float s) {
      int dist = t[rb] - (tile * 64 + kb * 16 + fq * 4 + j);
      int di = min(max(dist, 0), 127);
      bool ok = dist >= 0 && ((msk[rb] >> tile) & 1);
      return ok ? fmaf(s, sc, lutr[di]) : -INFINITY;
    };
    u64 orm[2], andm[2];
#pragma unroll
    for (int rb = 0; rb < 2; ++rb) {
      unsigned olo = (unsigned)msk[rb], ohi = (unsigned)(msk[rb] >> 32), alo = olo, ahi = ohi;
      olo |= dppu<DPP_X1>(olo); ohi |= dppu<DPP_X1>(ohi); alo &= dppu<DPP_X1>(alo); ahi &= dppu<DPP_X1>(ahi);
      olo |= dppu<DPP_X2>(olo); ohi |= dppu<DPP_X2>(ohi); alo &= dppu<DPP_X2>(alo); ahi &= dppu<DPP_X2>(ahi);
      olo |= dppu<DPP_HM>(olo); ohi |= dppu<DPP_HM>(ohi); alo &= dppu<DPP_HM>(alo); ahi &= dppu<DPP_HM>(ahi);
      olo |= dppu<DPP_M>(olo); ohi |= dppu<DPP_M>(ohi); alo &= dppu<DPP_M>(alo); ahi &= dppu<DPP_M>(ahi);
      orm[rb] = ((u64)(unsigned)__builtin_amdgcn_readfirstlane((int)ohi) << 32) | (unsigned)__builtin_amdgcn_readfirstlane((int)olo);
      andm[rb] = ((u64)(unsigned)__builtin_amdgcn_readfirstlane((int)ahi) << 32) | (unsigned)__builtin_amdgcn_readfirstlane((int)alo);
    }
    const float cbf = lutr[127];
    const u64 msk0 = msk[0], msk1 = msk[1];
    auto ffs = make_fast(sc, [=](int rb, int tile) { return (((rb ? msk1 : msk0) >> tile) & 1) ? cbf : -INFINITY; });
    auto cls = [&](int rb, int tile) {
      const u64 om = rb ? orm[1] : orm[0], am = rb ? andm[1] : andm[0];
      if (!((om >> tile) & 1)) return 0;
      return ((rb ? tmin1 : tmin0) - (tile * 64 + 63) >= 113) ? 2 : 1;
    };
    RESET_STATE
    attn_run<64, 0, true, false>(U, orm[0] | orm[1], qf, kps, vps, NoCum{}, sfs, ffs, cls, NoPost{}, m, l, o, smem, curslot);
    ACCUM_BRANCH(1, false)
  }
  {
    const int lo = (t0 >= 511 ? t0 - 511 : 0) >> 6, hi = (t0 + 31) >> 6;
    const u64 wt = ((hi == 63) ? ~0ull : ((1ull << (hi + 1)) - 1)) & ~((1ull << lo) - 1);
    const bf16* kb_ = proj + (long)b * 4096 * PROJ_LD + 1024 + g * 64;
    const bf16* vwt = (const bf16*)(ws + OFF_VWT) + (long)(b * 2 + g) * 64 * 4096;
    auto kpw = [&](int tile, int row) { return kb_ + (long)(tile * 64 + row) * PROJ_LD; };
    auto vpw = [&](int tile, int d) { return vwt + (long)d * 4096 + tile * 64; };
    auto sfw = [&](int rb, int kb, int j, int tile, float s) {
      int dist = t[rb] - (tile * 64 + kb * 16 + fq * 4 + j);
      int di = min(max(dist, 0), 127);
      bool ok = dist >= 0 && dist < 512;
      return ok ? fmaf(s, sc, lutr[di]) : -INFINITY;
    };
    const float cbf = lutr[127];
    auto ffw = make_fast(sc, [=](int rb, int tile) { return cbf; });
    auto clw = [&](int rb, int tile) {
      const int tm = rb ? tmin1 : tmin0;
      return (tm - (tile * 64 + 63) >= 113 && tm + 3 - tile * 64 < 512) ? 2 : 1;
    };
    RESET_STATE
    attn_run<64, 0, false, false>(wt, wt, qf, kpw, vpw, NoCum{}, sfw, ffw, clw, NoPost{}, m, l, o, smem, curslot);
    ACCUM_BRANCH(2, false)
  }
#undef RESET_STATE
#undef ACCUM_BRANCH
  bf16* ocat = (bf16*)(ws + OFF_OCAT);
#pragma unroll
  for (int rb = 0; rb < 2; ++rb)
#pragma unroll
    for (int db = 0; db < 4; ++db) {
      const f32x4 tv = totl[(rb * 4 + db) * 256];
      u32x2 v; v[0] = pack2(tv[0], tv[1]); v[1] = pack2(tv[2], tv[3]);
      *(u32x2*)(ocat + ((long)b * 4096 + t[rb]) * 1024 + h * 64 + db * 16 + fq * 4) = v;
    }
}

template <int KIND>
DEVI void mha_item(const Params& p, int b, int h, int t0, char* smem) {
  constexpr int DK = KIND == 0 ? 96 : 64;
  char* ws = opaque_ptr(p.ws);
  const int tid = opaque_tid(), lane = tid & 63, wid = tid >> 6, fr = lane & 15, fq = lane >> 4;
  int t[2]; long tok[2];
#pragma unroll
  for (int rb = 0; rb < 2; ++rb) { t[rb] = t0 + wid * 32 + rb * 16 + fr; tok[rb] = (long)b * 4096 + t[rb]; }
  const bf16* qb; long qld; const bf16* kbase; long kld; const bf16* vbase; long vld;
  if (KIND == 0) {
    qb = (const bf16*)(ws + OFF_QMLA) + h * 96; qld = 384;
    kbase = (const bf16*)(ws + OFF_KMLA) + (long)b * 4096 * 384 + h * 96; kld = 384;
    vbase = (const bf16*)(ws + OFF_VMT) + (long)(b * 4 + h) * 64 * 4096; vld = 4096;
  } else if (KIND == 1) {
    qb = (const bf16*)(ws + OFF_PROJ) + 1792 + h * 64; qld = PROJ_LD;
    kbase = (const bf16*)(ws + OFF_PROJ) + (long)b * 4096 * PROJ_LD + 2048 + h * 64; kld = PROJ_LD;
    vbase = (const bf16*)(ws + OFF_VFT) + (long)(b * 4 + h) * 64 * 4096; vld = 4096;
  } else {
    qb = (const bf16*)(ws + OFF_XQ) + h * 64; qld = 256;
    kbase = (const bf16*)(ws + OFF_KXA) + (long)b * 256 * 256 + h * 64; kld = 256;
    vbase = (const bf16*)(ws + OFF_VXA) + (long)(b * 4 + h) * 64 * 256; vld = 256;
  }
  bf16x8 qf[2][DK / 32];
#pragma unroll
  for (int rb = 0; rb < 2; ++rb)
#pragma unroll
    for (int ks = 0; ks < DK / 32; ++ks) qf[rb][ks] = *(const bf16x8*)(qb + tok[rb] * qld + ks * 32 + fq * 8);
  u64 tiles, wtiles;
  if (KIND == 2) { tiles = 0xF; wtiles = 0xF; }
  else {
    int nt = (t0 >> 6) + 2; tiles = nt >= 64 ? ~0ull : ((1ull << nt) - 1);
    int nw = ((t0 + wid * 32 + 31) >> 6) + 1; wtiles = nw >= 64 ? ~0ull : ((1ull << nw) - 1);
  }
  const float sc = (KIND == 0 ? 0.10206207261596575f : 0.125f) * LOG2E;
  const float* cum = (const float*)(ws + OFF_CUM) + (long)(b * 4 + h) * 4096;
  float cq[2] = {0.f, 0.f};
  const char* curslot = smem;
  if (KIND == 1) { cq[0] = cum[t[0]]; cq[1] = cum[t[1]]; }
  auto kpf = [&](int tile, int row) { return kbase + (long)(tile * 64 + row) * kld; };
  auto vpf = [&](int tile, int d) { return vbase + (long)d * vld + tile * 64; };
  auto cpf = [&](int tile) { return cum + tile * 64; };
  auto sf = [&](int rb, int kb, int j, int tile, float s) {
    if (KIND == 2) return s * sc;
    int kpos = tile * 64 + kb * 16 + fq * 4 + j;
    float v = s * sc;
    if (KIND == 1) v += cq[rb] - *(const float*)(curslot + RingGeo<64>::ACO + (kb * 16 + fq * 4 + j) * 4);
    return kpos <= t[rb] ? v : -INFINITY;
  };
  float m[2] = {-1e30f, -1e30f}, l[2] = {0.f, 0.f};
  f32x4 o[5][2];
#pragma unroll
  for (int db = 0; db < 5; ++db) { o[db][0] = f32x4{0.f, 0.f, 0.f, 0.f}; o[db][1] = f32x4{0.f, 0.f, 0.f, 0.f}; }
  __syncthreads();
  const int uw = __builtin_amdgcn_readfirstlane(wid);
  const float cq0 = cq[0], cq1 = cq[1];
  const char* const* cslot = &curslot;
  auto ffm = make_fast_vec(sc, [=](int rb, int tile) { return KIND == 1 ? (rb ? cq1 : cq0) : 0.f; },
                           [=](int kb) { f32x4 z = f32x4{0.f, 0.f, 0.f, 0.f}; return KIND == 1 ? (z - *(const f32x4*)(*cslot + RingGeo<64>::ACO + (kb * 16 + fq * 4) * 4)) : z; });
  auto ffx = make_fast(sc, [=](int rb, int tile) { return 0.f; });
  auto clm = [&](int rb, int tile) { return (KIND == 2 || tile * 64 + 63 <= t0 + uw * 32 + rb * 16) ? 2 : 1; };
  if (KIND == 1) attn_run<DK, 0, false, true>(tiles, wtiles, qf, kpf, vpf, cpf, sf, ffm, clm, NoPost{}, m, l, o, smem, curslot);
  else attn_run<DK, 0, false, false>(tiles, wtiles, qf, kpf, vpf, cpf, sf, ffx, clm, NoPost{}, m, l, o, smem, curslot);
  bf16* dst; long dld;
  if (KIND == 0) { dst = (bf16*)(ws + OFF_OCAT) + 512 + h * 64; dld = 1024; }
  else if (KIND == 1) { dst = (bf16*)(ws + OFF_OCAT) + 768 + h * 64; dld = 1024; }
  else { dst = (bf16*)(ws + OFF_OXA) + h * 64; dld = 256; }
#pragma unroll
  for (int rb = 0; rb < 2; ++rb) {
    float ls = o[4][rb][0];
    float f = ls > 0.f ? 1.f / ls : 0.f;
#pragma unroll
    for (int db = 0; db < 4; ++db) {
      u32x2 v; v[0] = pack2(o[db][rb][0] * f, o[db][rb][1] * f); v[1] = pack2(o[db][rb][2] * f, o[db][rb][3] * f);
      *(u32x2*)(dst + tok[rb] * dld + db * 16 + fq * 4) = v;
    }
  }
}

DEVI int next_item(unsigned* ctr, char* smem) {
  __syncthreads();
  if (opaque_tid() == 0) *(int*)(smem + AITEM) = (int)atomicAdd(ctr, 1u);
  __syncthreads();
  return *(volatile int*)(smem + AITEM);
}

DEVI void phase_attn(const Params& p, int L, char* smem, int rep) {
  unsigned* ctr = (unsigned*)(p.ws + OFF_CNT) + L + 8 * rep;
  for (;;) {
    int it = next_item(ctr, smem);
    if (it >= 4096) break;
    int level = it >> 7, w = it & 127; int q128 = 31 - level;
    if (w < 64) { int sub = w & 3, bg = w >> 2; nsa_item(p, bg >> 1, bg & 1, q128 * 128 + sub * 32, smem); }
    else if (w < 96) { int bh = w - 64; mha_item<0>(p, bh >> 2, bh & 3, q128 * 128, smem); }
    else { int bh = w - 96; mha_item<1>(p, bh >> 2, bh & 3, q128 * 128, smem); }
  }
}

DEVI void phase_xattn(const Params& p, char* smem) {
  for (int it = blockIdx.x; it < 1024; it += gridDim.x) {
    int bh = it & 31, q = it >> 5;
    mha_item<2>(p, bh >> 2, bh & 3, q * 128, smem);
  }
}

DEVI void phase_merge(const Params& p, char* smem) {
  char* ws = opaque_ptr(p.ws);
  const bf16* xb = (const bf16*)(ws + OFF_XB);
  const bf16* ocat = (const bf16*)(ws + OFF_OCAT);
  const bf16* wg = (const bf16*)(ws + OFF_WG);
  u32x4* brg = (u32x4*)(ws + OFF_QMLA) + (size_t)blockIdx.x * 8 * 256 + opaque_tid();
  int t = blockIdx.x;
  if (t < 256 * 8) {
    int mt, nt; tile_swz(t, 256, 8, mt, nt);
    __syncthreads();
    gemm_prefetch0<4>(ocat, RowLinear{1024}, (const bf16*)(ws + OFF_WBN), 512, mt * 128, nt * 128, smem);
  }
  for (; t < 256 * 8; t += gridDim.x) {
    int mt, nt; tile_swz(t, 256, 8, mt, nt);
    f32x4 res[4][4]; zero_acc(res);
#pragma unroll 1
    for (int i = 0; i < 3; ++i) {
      const bf16* wb = (const bf16*)(ws + (i == 0 ? OFF_WBN : (i == 1 ? OFF_WBM : OFF_WBF)));
      const int kk = i == 0 ? 512 : 256;
      const int ko = i == 0 ? 0 : (i == 1 ? 512 : 768);
      f32x4 acc[4][4]; zero_acc(acc);
      gemm_mainloop_g<4, true, RowLinear, true>(acc, ocat + ko, RowLinear{1024}, 64, wb, kk, kk, mt * 128, nt * 128, smem);
      gemm_prefetch0<4>(xb, RowLinear{1024}, wg + (long)i * 1024 * 1024, 1024, mt * 128, nt * 128, smem);
#pragma unroll
      for (int m = 0; m < 4; ++m)
#pragma unroll
        for (int n = 0; n < 4; n += 2)
          brg[(m * 2 + (n >> 1)) * 256] = u32x4{pack2(acc[m][n][0], acc[m][n][1]), pack2(acc[m][n][2], acc[m][n][3]),
                                                pack2(acc[m][n + 1][0], acc[m][n + 1][1]), pack2(acc[m][n + 1][2], acc[m][n + 1][3])};
      zero_acc(acc);
      gemm_mainloop_g<4, true, RowLinear, true>(acc, xb, RowLinear{1024}, 64, wg + (long)i * 1024 * 1024, 1024, 1024, mt * 128, nt * 128, smem);
      if (i < 2) {
        const bf16* wb2 = (const bf16*)(ws + (i == 0 ? OFF_WBM : OFF_WBF));
        gemm_prefetch0<4>(ocat + (i == 0 ? 512 : 768), RowLinear{1024}, wb2, 256, mt * 128, nt * 128, smem);
      } else if (t + (int)gridDim.x < 256 * 8) {
        int mt2, nt2; tile_swz(t + gridDim.x, 256, 8, mt2, nt2);
        gemm_prefetch0<4>(ocat, RowLinear{1024}, (const bf16*)(ws + OFF_WBN), 512, mt2 * 128, nt2 * 128, smem);
      }
#pragma unroll
      for (int m = 0; m < 4; ++m)
#pragma unroll
        for (int n = 0; n < 4; ++n) {
          const u32x4 bq = brg[(m * 2 + (n >> 1)) * 256];
          const unsigned b0 = bq[(n & 1) * 2], b1 = bq[(n & 1) * 2 + 1];
          res[m][n][0] += sigmoidf(acc[m][n][0]) * bf2f(b0 & 0xffffu);
          res[m][n][1] += sigmoidf(acc[m][n][1]) * __uint_as_float(b0 & 0xffff0000u);
          res[m][n][2] += sigmoidf(acc[m][n][2]) * bf2f(b1 & 0xffffu);
          res[m][n][3] += sigmoidf(acc[m][n][3]) * __uint_as_float(b1 & 0xffff0000u);
        }
    }
    store_rm_sw(res, (bf16*)(ws + OFF_MERGED), 1024, mt * 128, nt * 128);
  }
}

enum { EPI_RESID = 0, EPI_RM = 1, EPI_RELU2 = 2 };
template <int EPI>
DEVI void phase_gemm(const Params& p, const bf16* A, int lda, const bf16* Bt, int K, int NT, bf16* dst, int ldd, char* smem, bool nostore = false,
                     const float* lng = nullptr, const float* lnb = nullptr) {
  int t = blockIdx.x;
  if (t < 256 * NT) {
    int mt, nt; tile_swz(t, 256, NT, mt, nt);
    __syncthreads();
    gemm_prefetch0<4>(A, RowLinear{lda}, Bt, K, mt * 128, nt * 128, smem, KROT ? k_rot(mt, nt, K >> 6) : 0);
  }
  for (; t < 256 * NT; t += gridDim.x) {
    int mt, nt; tile_swz(t, 256, NT, mt, nt);
    f32x4 acc[4][4]; zero_acc(acc);
    gemm_mainloop_g<4, true, RowLinear, true, DEEP_FRAG != 0>(acc, A, RowLinear{lda}, 64, Bt, K, K, mt * 128, nt * 128, smem, KROT ? k_rot(mt, nt, K >> 6) : 0);
    if (t + (int)gridDim.x < 256 * NT) {
      int mt2, nt2; tile_swz(t + gridDim.x, 256, NT, mt2, nt2);
      gemm_prefetch0<4>(A, RowLinear{lda}, Bt, K, mt2 * 128, nt2 * 128, smem, KROT ? k_rot(mt2, nt2, K >> 6) : 0);
    }
    if (EPI == EPI_RESID) {
      const int tid = opaque_tid(), lane = tid & 63, wid = tid >> 6, wr = wid >> 1, wc = wid & 1, fr = lane & 15, fq = lane >> 4;
      float* x = p.out;
      const float* stats = (const float*)(p.ws + OFF_STATS);
      const int cb0 = nt * 128 + wc * 64 + fq * 4;
      f32x4 gv[4], bv[4];
      if (lng) {
#pragma unroll
        for (int n = 0; n < 4; ++n) { gv[n] = *(const f32x4*)(lng + cb0 + n * 16); bv[n] = *(const f32x4*)(lnb + cb0 + n * 16); }
      }
#pragma unroll
      for (int m = 0; m < 4; ++m) {
        const int row = mt * 128 + wr * 64 + m * 16 + fr;
        float* rp = x + (long)row * 1024 + cb0;
        float mu = 0.f, rstd = 1.f;
        if (lng) { mu = stats[row * 2]; rstd = stats[row * 2 + 1]; }
        f32x4 v[4];
#pragma unroll
        for (int n = 0; n < 4; ++n) v[n] = *(const f32x4*)(rp + n * 16);
#pragma unroll
        for (int n = 0; n < 4; ++n) {
          f32x4 xv = v[n];
          if (lng) xv = (xv - mu) * rstd * gv[n] + bv[n];
          *(f32x4*)(rp + n * 16) = xv * DN_ALPHA + acc[m][n];
        }
      }
    } else if (EPI == EPI_RELU2) {
#pragma unroll
      for (int m = 0; m < 4; ++m)
#pragma unroll
        for (int n = 0; n < 4; ++n)
#pragma unroll
          for (int j = 0; j < 4; ++j) { float v = fmaxf(acc[m][n][j], 0.f); acc[m][n][j] = v * v; }
      if (!nostore || acc[0][0][0] == 123.456f) store_rm_sw(acc, dst, ldd, mt * 128, nt * 128);
    } else {
      store_rm_sw(acc, dst, ldd, mt * 128, nt * 128);
    }
  }
}

DEVI void phase_ln(const Params& p, int L, int which) {
  const int lane = opaque_tid() & 63, wid = opaque_tid() >> 6;
  const int gw = blockIdx.x * 4 + wid, nw = gridDim.x * 4;
  const float* g = p.in[22] + (L * 3 + which) * 1024;
  const float* bb = p.in[23] + (L * 3 + which) * 1024;
  char* ws = opaque_ptr(p.ws);
  bf16* xb = (bf16*)(ws + OFF_XB);
  float* stats = (float*)(ws + OFF_STATS);
  const bool final_out = (L == 3 && which == 2);
  const f32x4 g0 = *(const f32x4*)(g + lane * 4), g1 = *(const f32x4*)(g + 256 + lane * 4), g2 = *(const f32x4*)(g + 512 + lane * 4), g3 = *(const f32x4*)(g + 768 + lane * 4);
  const f32x4 b0 = *(const f32x4*)(bb + lane * 4), b1 = *(const f32x4*)(bb + 256 + lane * 4), b2 = *(const f32x4*)(bb + 512 + lane * 4), b3 = *(const f32x4*)(bb + 768 + lane * 4);
  for (int row = gw; row < T_TOK; row += nw) {
    float* xr = p.out + (long)row * 1024;
    f32x4 v0 = *(const f32x4*)(xr + lane * 4), v1 = *(const f32x4*)(xr + 256 + lane * 4);
    f32x4 v2 = *(const f32x4*)(xr + 512 + lane * 4), v3 = *(const f32x4*)(xr + 768 + lane * 4);
    f32x4 sv = v0 + v1 + v2 + v3;
    float s = sv[0] + sv[1] + sv[2] + sv[3];
    s = wave_sum(s);
    const float mu = s * (1.f / 1024.f);
    v0 -= mu; v1 -= mu; v2 -= mu; v3 -= mu;
    f32x4 qv = v0 * v0 + v1 * v1 + v2 * v2 + v3 * v3;
    float q = qv[0] + qv[1] + qv[2] + qv[3];
    q = wave_sum(q);
    const float rstd = rsqrtf(q * (1.f / 1024.f) + 1e-5f);
    if (lane == 0) { stats[row * 2] = mu; stats[row * 2 + 1] = rstd; }
#define LN_OUT(V, GG, BB, I)                                                                           \
    {                                                                                                  \
      f32x4 o = V * rstd * GG + BB;                                                                    \
      if (final_out) *(f32x4*)(xr + I * 256 + lane * 4) = o;                                           \
      *(u32x2*)(xb + (long)row * 1024 + I * 256 + lane * 4) = u32x2{pack2(o[0], o[1]), pack2(o[2], o[3])}; \
    }
    LN_OUT(v0, g0, b0, 0) LN_OUT(v1, g1, b1, 1) LN_OUT(v2, g2, b2, 2) LN_OUT(v3, g3, b3, 3)
#undef LN_OUT
  }
}

__global__ void __launch_bounds__(256, 2) mega(Params p) {
  __shared__ __attribute__((aligned(16))) char smem[SMEM_BYTES];
  cg::grid_group grid = cg::this_grid();
  char* ws = opaque_ptr(p.ws);
  volatile LAS unsigned* xst = (volatile LAS unsigned*)(smem + XBST);
  if (opaque_tid() < 4) xst[opaque_tid()] = 0u;
  __syncthreads();
  XcdBarrier xb = xcd_barrier_post((unsigned*)(ws + OFF_BAR), xst);
  grid.sync();
#pragma unroll 1
  for (int L = -1; L < 4; ++L) {
    char* ws = opaque_ptr(p.ws);
    if (L >= 0) {
    for (int r = 0; r < REP_PROJ; ++r) { phase_proj(p, L, smem);
    xcd_barrier(xb); }
    for (int r = 0; r < REP_DERIVED; ++r) { phase_derived(p, L, smem);
    xcd_barrier(xb); }
    for (int r = 0; r < REP_ATTN; ++r) { phase_attn(p, L, smem, r);
    xcd_barrier(xb); }
    for (int r = 0; r < REP_MERGE; ++r) { phase_merge(p, smem);
    xcd_barrier(xb); }
    phase_gemm<EPI_RESID>(p, (const bf16*)(ws + OFF_MERGED), 1024, (const bf16*)(ws + OFF_WOUT), 1024, 8, nullptr, 0, smem, false,
                          L ? p.in[22] + ((L - 1) * 3 + 2) * 1024 : nullptr, L ? p.in[23] + ((L - 1) * 3 + 2) * 1024 : nullptr);
    xcd_barrier(xb);
    phase_ln(p, L, 0);
    xcd_barrier(xb);
    phase_gemm<EPI_RM>(p, (const bf16*)(ws + OFF_XB), 1024, (const bf16*)(ws + OFF_WXQ), 1024, 2, (bf16*)(ws + OFF_XQ), 256, smem);
    xcd_barrier(xb);
    for (int r = 0; r < REP_XA; ++r) { phase_xattn(p, smem);
    xcd_barrier(xb); }
    phase_gemm<EPI_RESID>(p, (const bf16*)(ws + OFF_OXA), 256, (const bf16*)(ws + OFF_WXO), 256, 8, nullptr, 0, smem, false,
                          p.in[22] + (L * 3 + 0) * 1024, p.in[23] + (L * 3 + 0) * 1024);
    xcd_barrier(xb);
    phase_ln(p, L, 1);
    xcd_barrier(xb);
    for (int r = 0; r < REP_UP; ++r) { phase_gemm<EPI_RELU2>(p, (const bf16*)(ws + OFF_XB), 1024, (const bf16*)(ws + OFF_WUP), 1024, 32, (bf16*)(ws + OFF_HID), 4096, smem, (PROBE_NOSTORE && r > 0));
    xcd_barrier(xb); }
    phase_gemm<EPI_RESID>(p, (const bf16*)(ws + OFF_HID), 4096, (const bf16*)(ws + OFF_WDN), 4096, 8, nullptr, 0, smem, false,
                          p.in[22] + (L * 3 + 1) * 1024, p.in[23] + (L * 3 + 1) * 1024);
    xcd_barrier(xb);
    phase_ln(p, L, 2);
    }
    if (L < 3) { phase_prep(p, L + 1, smem); xcd_barrier(xb); }
  }
}

extern "C" void kernel_launch(void* const* d_in, const int* in_sizes, int n_in, void* d_out, int out_size,
                              void* d_ws, size_t ws_size, hipStream_t stream) {
  static int grid_blocks = 0;
  if (!grid_blocks) {
    int dev = 0, cus = 0, per_cu = 0;
    (void)hipGetDevice(&dev);
    (void)hipDeviceGetAttribute(&cus, hipDeviceAttributeMultiprocessorCount, dev);
    (void)hipOccupancyMaxActiveBlocksPerMultiprocessor(&per_cu, mega, 256, 0);
    if (per_cu > 2) per_cu = 2;
    if (per_cu < 1) per_cu = 1;
    grid_blocks = cus * per_cu;
    grid_blocks &= ~7;
    if (grid_blocks > 512) grid_blocks = 512;
  }
  if (ws_size < WS_TOTAL) fprintf(stderr, "workspace too small: %zu < %zu\n", ws_size, (size_t)WS_TOTAL);
  Params p{};
  for (int i = 0; i < 24; ++i) p.in[i] = (const float*)d_in[i];
  p.out = (float*)d_out;
  p.ws = (char*)d_ws;
  (void)hipMemsetAsync((char*)d_ws + OFF_BAR, 0, 16384, stream);
  void* args[] = {&p};
  hipError_t e = hipLaunchCooperativeKernel((void*)mega, dim3(grid_blocks), dim3(256), args, 0, stream);
  if (e != hipSuccess) fprintf(stderr, "cooperative launch failed: %s (grid %d)\n", hipGetErrorString(e), grid_blocks);
}
```

```cpp
#include <hip/hip_runtime.h>
#include <hip/hip_cooperative_groups.h>
#include <cstdio>
#include <cstdint>
namespace cg = cooperative_groups;

typedef unsigned short bf16;
typedef __attribute__((ext_vector_type(8))) short bf16x8;
typedef __attribute__((ext_vector_type(4))) float f32x4;
typedef __attribute__((ext_vector_type(2))) __bf16 bf2_t;
typedef __attribute__((ext_vector_type(4))) unsigned u32x4;
typedef unsigned long long u64;
typedef __attribute__((ext_vector_type(2))) unsigned u32x2;

#ifndef EXTRA_SYNC
#define EXTRA_SYNC 0
#endif
#ifndef PROBE_NOSTORE
#define PROBE_NOSTORE 0
#endif
#ifndef USE_RING
#define USE_RING 0
#endif
#if USE_RING
#define GEMM_ML gemm_mainloop_r
#else
#define GEMM_ML gemm_mainloop_g
#endif
#ifndef SWZ_MODE
#define SWZ_MODE 0
#endif
#ifndef KROT
#define KROT 0
#endif
#ifndef DEEP_FRAG
#define DEEP_FRAG 1
#endif
#ifndef REP_ATTN
#define REP_ATTN 1
#endif
#ifndef REP_PROJ
#define REP_PROJ 1
#endif
#ifndef REP_UP
#define REP_UP 1
#endif
#ifndef REP_MERGE
#define REP_MERGE 1
#endif
#ifndef REP_DERIVED
#define REP_DERIVED 1
#endif
#ifndef REP_PREP
#define REP_PREP 1
#endif
#ifndef REP_XA
#define REP_XA 1
#endif
#define DEVI __device__ __forceinline__

DEVI int opaque_tid() { int t = __builtin_amdgcn_workitem_id_x(); asm volatile("" : "+v"(t)); return t; }
DEVI char* opaque_ptr(char* p) { asm volatile("" : "+s"(p)); return p; }
DEVI float opq(float x) { asm("" : "+v"(x)); return x; }
DEVI unsigned pack2(float a, float b) { bf2_t v; v[0] = (__bf16)a; v[1] = (__bf16)b; return __builtin_bit_cast(unsigned, v); }
DEVI bf16 f2bf(float a) { return __builtin_bit_cast(unsigned short, (__bf16)a); }
DEVI float bf2f(unsigned u) { return __uint_as_float(u << 16); }
DEVI float fexp2(float x) { return __builtin_amdgcn_exp2f(x); }
DEVI float sigmoidf(float x) { return 1.f / (1.f + __expf(-x)); }

constexpr int T_TOK = 32768;
constexpr int PROJ_LD = 2688;
constexpr float LOG2E = 1.4426950408889634f;
constexpr float DN_ALPHA = 1.681792830507429f;

constexpr size_t al256(size_t x) { return (x + 255) & ~(size_t)255; }
constexpr size_t OFF_BAR = 0;
constexpr size_t OFF_CNT = 14336;
constexpr size_t OFF_WIN = 16384;
constexpr size_t OFF_WG = OFF_WIN + (size_t)2688 * 1024 * 2;
constexpr size_t OFF_WBN = OFF_WG + (size_t)3072 * 1024 * 2;
constexpr size_t OFF_WBM = OFF_WBN + (size_t)1024 * 512 * 2;
constexpr size_t OFF_WBF = OFF_WBM + (size_t)1024 * 256 * 2;
constexpr size_t OFF_WOUT = OFF_WBF + (size_t)1024 * 256 * 2;
constexpr size_t OFF_WXQ = OFF_WOUT + (size_t)1024 * 1024 * 2;
constexpr size_t OFF_WXKV = OFF_WXQ + (size_t)256 * 1024 * 2;
constexpr size_t OFF_WXO = OFF_WXKV + (size_t)512 * 1024 * 2;
constexpr size_t OFF_WUP = OFF_WXO + (size_t)1024 * 256 * 2;
constexpr size_t OFF_WDN = OFF_WUP + (size_t)4096 * 1024 * 2;
constexpr size_t OFF_WUQ = OFF_WDN + (size_t)4096 * 1024 * 2;
constexpr size_t OFF_WUKV = OFF_WUQ + (size_t)384 * 384 * 2;
constexpr size_t OFF_WC1 = OFF_WUKV + (size_t)512 * 128 * 2;
constexpr size_t OFF_WC2 = OFF_WC1 + (size_t)2 * 128 * 2048 * 2;
constexpr size_t OFF_B1 = OFF_WC2 + (size_t)2 * 64 * 128 * 2;
constexpr size_t OFF_XB = al256(OFF_B1 + 2 * 32 * 128 * 4);
constexpr size_t OFF_MEMB = OFF_XB + (size_t)32768 * 1024 * 2;
constexpr size_t OFF_PROJ = OFF_MEMB + (size_t)2048 * 1024 * 2;
constexpr size_t OFF_OCAT = OFF_PROJ + (size_t)32768 * 2688 * 2;
constexpr size_t OFF_QMLA = OFF_OCAT + (size_t)32768 * 1024 * 2;
constexpr size_t OFF_KMLA = OFF_QMLA + (size_t)32768 * 384 * 2;
constexpr size_t OFF_VMT = OFF_KMLA + (size_t)32768 * 384 * 2;
constexpr size_t OFF_VST = OFF_VMT + (size_t)8 * 4 * 64 * 4096 * 2;
constexpr size_t OFF_VWT = OFF_VST + (size_t)8 * 2 * 64 * 4096 * 2;
constexpr size_t OFF_VFT = OFF_VWT + (size_t)8 * 2 * 64 * 4096 * 2;
constexpr size_t OFF_KC = OFF_VFT + (size_t)8 * 4 * 64 * 4096 * 2;
constexpr size_t OFF_VCT = OFF_KC + (size_t)16 * 256 * 64 * 2;
constexpr size_t OFF_GAUX = OFF_VCT + (size_t)16 * 256 * 64 * 2;
constexpr size_t OFF_FLOG = OFF_GAUX + (size_t)32768 * 32 * 4;
constexpr size_t OFF_CUM = OFF_FLOG + (size_t)32768 * 4 * 4;
constexpr size_t OFF_KXA = OFF_CUM + (size_t)32768 * 4 * 4;
constexpr size_t OFF_VXA = OFF_KXA + (size_t)2048 * 256 * 2;
constexpr size_t OFF_XQ = OFF_VXA + (size_t)2048 * 256 * 2;
constexpr size_t OFF_OXA = OFF_XQ + (size_t)32768 * 256 * 2;
constexpr size_t OFF_STATS = OFF_OXA + (size_t)32768 * 256 * 2;
constexpr size_t WS_TOTAL = OFF_STATS + (size_t)32768 * 2 * 4;
constexpr size_t OFF_HID = OFF_PROJ;
constexpr size_t OFF_MERGED = OFF_PROJ;

constexpr int LDS_ROW = 144;
constexpr int TILE_B = 128 * LDS_ROW;
constexpr int SM_ROWSS = 2 * TILE_B;
constexpr int ARING = 66560;
constexpr int XBST = 77216;
constexpr int SMEM_BYTES = XBST + 16;
constexpr int ALUT = ARING, AIMP = ALUT + 2176, ASEL = AIMP + 8192, AITEM = ASEL + 256;
template <int DK> struct RingGeo { static constexpr int AVO = DK == 64 ? 8192 : 12288, ACO = AVO + 8192, STRIDE = DK == 64 ? 16640 : 20992; };
static_assert(4 * 16640 <= ARING && 3 * 20992 <= ARING, "ring");
static_assert(AITEM + 16 <= XBST, "LDS map");


#define XB_TMO      128
#define XB_XCNT(j)  (256  + 64 * (j))
#define XB_XSUB(j)  (1280 + 64 * (j))
#define XB_XGEN(j)  (2304 + 64 * (j))
#define XB_TOP      3328
#define XB_TOPGEN   3392
#define XCD_BAR_WORDS 3456
#define XB_SPIN_CAP (1u << 18)
#define LAS __attribute__((address_space(3)))
DEVI unsigned xb_ld(unsigned* p) { return __hip_atomic_load(p, __ATOMIC_RELAXED, __HIP_MEMORY_SCOPE_AGENT); }
DEVI unsigned xb_add(unsigned* p, unsigned v) { return __hip_atomic_fetch_add(p, v, __ATOMIC_RELAXED, __HIP_MEMORY_SCOPE_AGENT); }
DEVI unsigned xb_xcc_id() { return (unsigned)__builtin_amdgcn_s_getreg((3 << 11) | 20) & 0xFu; }
#define XB_SPIN(cond, bar) do { unsigned _sp = 0; while (cond) { __builtin_amdgcn_s_sleep(1); \
    if ((++_sp & 255u) == 0u) { if (xb_ld(&(bar)[XB_TMO])) break; if (_sp > XB_SPIN_CAP) { atomicAdd(&(bar)[XB_TMO], 1u); break; } } } } while (0)
struct XcdBarrier { unsigned* bar; unsigned x; volatile LAS unsigned* st; };
DEVI XcdBarrier xcd_barrier_post(unsigned* bar, volatile LAS unsigned* st) {
  XcdBarrier b; b.bar = bar; b.x = xb_xcc_id(); b.st = st;
  if (opaque_tid() == 0) (void)xb_add(&bar[XB_XCNT(b.x)], 1u);
  return b;
}
DEVI void xcd_barrier_complete(unsigned* bar, unsigned x, unsigned& nloc, unsigned& nx) {
  const unsigned G = gridDim.x * gridDim.y * gridDim.z;
  unsigned sum, cnt, mine, sp = 0u;
  for (;;) {
    sum = 0u; cnt = 0u; mine = 0u;
#pragma unroll
    for (unsigned j = 0; j < 16; ++j) { const unsigned c = xb_ld(&bar[XB_XCNT(j)]); sum += c; cnt += (c > 0u) ? 1u : 0u; mine = (j == x) ? c : mine; }
    if (sum == G) break;
    __builtin_amdgcn_s_sleep(1);
    if ((++sp & 255u) == 0u) { if (xb_ld(&bar[XB_TMO])) break; if (sp > XB_SPIN_CAP) { atomicAdd(&bar[XB_TMO], 1u); break; } }
  }
  nloc = mine > 0u ? mine : 1u; nx = cnt > 0u ? cnt : 1u;
}
DEVI void xcd_barrier(const XcdBarrier& b) {
  asm volatile("s_waitcnt vmcnt(0)" ::: "memory");
  __syncthreads();
  if (opaque_tid() == 0) {
    unsigned* bar = b.bar;
    __builtin_amdgcn_s_waitcnt(0);
    unsigned nloc = b.st[0], nx = b.st[1];
    if (nloc == 0u) { xcd_barrier_complete(bar, b.x, nloc, nx); b.st[0] = nloc; b.st[1] = nx; }
    const unsigned old = xb_add(&bar[XB_XSUB(b.x)], 1u);
    const unsigned gen = old / nloc;
    if (old + 1u == (gen + 1u) * nloc) {
      __builtin_amdgcn_fence(__ATOMIC_RELEASE, "agent");
      asm volatile("s_waitcnt vmcnt(0)" ::: "memory");
      const unsigned og = xb_add(&bar[XB_TOP], 1u);
      const unsigned tg = og / nx;
      if (og + 1u == (tg + 1u) * nx) xb_add(&bar[XB_TOPGEN], 1u);
      else XB_SPIN(xb_ld(&bar[XB_TOPGEN]) == tg, bar);
      __builtin_amdgcn_fence(__ATOMIC_ACQUIRE, "agent");
      xb_add(&bar[XB_XGEN(b.x)], 1u);
      asm volatile("s_waitcnt vmcnt(0)" ::: "memory");
    } else {
      XB_SPIN(xb_ld(&bar[XB_XGEN(b.x)]) == gen, bar);
      __builtin_amdgcn_fence(__ATOMIC_ACQUIRE, "agent");
      asm volatile("s_waitcnt vmcnt(0)" ::: "memory");
    }
  }
  __syncthreads();
}

struct Params {
  const float* in[24];
  float* out;
  char* ws;
};

__device__ const unsigned char T5BUCKET[128] = {
  0, 1, 2, 3, 4, 5, 6, 7, 8, 9, 10, 11, 12, 13, 14, 15, 16, 16, 16, 17, 17, 18, 18, 18, 19, 19, 19, 20, 20, 20, 20, 21,
  21, 21, 21, 22, 22, 22, 22, 22, 23, 23, 23, 23, 23, 23, 24, 24, 24, 24, 24, 24, 25, 25, 25, 25, 25, 25, 25, 26, 26, 26, 26, 26,
  26, 26, 26, 27, 27, 27, 27, 27, 27, 27, 27, 27, 27, 28, 28, 28, 28, 28, 28, 28, 28, 28, 28, 29, 29, 29, 29, 29, 29, 29, 29, 29,
  29, 29, 29, 30, 30, 30, 30, 30, 30, 30, 30, 30, 30, 30, 30, 30, 30, 31, 31, 31, 31, 31, 31, 31, 31, 31, 31, 31, 31, 31, 31, 31};

struct RowLinear { long ld; DEVI long operator()(int r) const { return (long)r * ld; } };
struct RowCmp {
  int colbase;
  DEVI long operator()(int r) const {
    int bg = r >> 8, c = r & 255; if (c > 254) c = 254;
    int b = bg >> 1, g = bg & 1;
    return ((long)(b * 4096 + c * 16)) * PROJ_LD + colbase + g * 64;
  }
};

DEVI float sumsq8(u32x4 v) {
  float s = 0.f;
  unsigned w[4] = {v[0], v[1], v[2], v[3]};
#pragma unroll
  for (int i = 0; i < 4; ++i) { float a = bf2f(w[i] & 0xffffu), b = __uint_as_float(w[i] & 0xffff0000u); s += a * a + b * b; }
  return s;
}

template <bool ROWSS, int NF, class ARow>
DEVI void gemm_mainloop_t(f32x4 (&acc)[4][NF], const bf16* __restrict__ A, ARow arow, int kstrideA,
                          const bf16* __restrict__ Bt, int ldb, int K, int m0, int n0, char* smem) {
  constexpr int NBI = NF;
  char* As = smem; char* Bs = smem + TILE_B;
  const int tid = opaque_tid(), lane = tid & 63, wid = tid >> 6, wr = wid >> 1, wc = wid & 1, fr = lane & 15, fq = lane >> 4;
  const int lrow = tid >> 3, lkc = tid & 7;
  unsigned aoff[4], boff[NBI];
#pragma unroll
  for (int i = 0; i < 4; ++i) aoff[i] = (unsigned)(arow(m0 + lrow + 32 * i) + lkc * 8);
#pragma unroll
  for (int i = 0; i < NBI; ++i) boff[i] = (unsigned)((n0 + lrow + 32 * i) * ldb + lkc * 8);
  u32x4 ra[4], rb[NBI];
  float ss[4] = {0.f, 0.f, 0.f, 0.f};
  const int nk = K >> 6;
#pragma unroll
  for (int i = 0; i < 4; ++i) ra[i] = *(const u32x4*)(A + aoff[i]);
#pragma unroll
  for (int i = 0; i < NBI; ++i) rb[i] = *(const u32x4*)(Bt + boff[i]);
  for (int kt = 0; kt < nk; ++kt) {
    __syncthreads();
#pragma unroll
    for (int i = 0; i < 4; ++i) {
      *(u32x4*)(As + (lrow + 32 * i) * LDS_ROW + lkc * 16) = ra[i];
      if (ROWSS) ss[i] += sumsq8(ra[i]);
    }
#pragma unroll
    for (int i = 0; i < NBI; ++i) *(u32x4*)(Bs + (lrow + 32 * i) * LDS_ROW + lkc * 16) = rb[i];
    __syncthreads();
    if (kt + 1 < nk) {
      const unsigned ka = (unsigned)((kt + 1) * kstrideA), kb = (unsigned)((kt + 1) * 64);
#pragma unroll
      for (int i = 0; i < 4; ++i) ra[i] = *(const u32x4*)(A + (aoff[i] + ka));
#pragma unroll
      for (int i = 0; i < NBI; ++i) rb[i] = *(const u32x4*)(Bt + (boff[i] + kb));
    }
#pragma unroll
    for (int ks = 0; ks < 2; ++ks) {
      bf16x8 af[4], bfr[NF];
#pragma unroll
      for (int m = 0; m < 4; ++m) af[m] = *(const bf16x8*)(As + (wr * 64 + m * 16 + fr) * LDS_ROW + ks * 64 + fq * 16);
#pragma unroll
      for (int n = 0; n < NF; ++n) bfr[n] = *(const bf16x8*)(Bs + (wc * 16 * NF + n * 16 + fr) * LDS_ROW + ks * 64 + fq * 16);
#pragma unroll
      for (int m = 0; m < 4; ++m)
#pragma unroll
        for (int n = 0; n < NF; ++n) acc[m][n] = __builtin_amdgcn_mfma_f32_16x16x32_bf16(af[m], bfr[n], acc[m][n], 0, 0, 0);
    }
  }
  if (ROWSS) {
    float* rowss = (float*)(smem + SM_ROWSS);
#pragma unroll
    for (int i = 0; i < 4; ++i) {
      float s = ss[i];
      s += __shfl_xor(s, 1); s += __shfl_xor(s, 2); s += __shfl_xor(s, 4);
      if (lkc == 0) rowss[lrow + 32 * i] = s;
    }
    __syncthreads();
  }
}
template <bool ROWSS, class ARow>
DEVI void gemm_mainloop(f32x4 (&acc)[4][4], const bf16* __restrict__ A, ARow arow, int kstrideA,
                        const bf16* __restrict__ Bt, int ldb, int K, int m0, int n0, char* smem) {
  gemm_mainloop_t<ROWSS, 4>(acc, A, arow, kstrideA, Bt, ldb, K, m0, n0, smem);
}

DEVI int k_rot(int mt, int nt, int nk) { return (((mt & 7) + (nt & 7)) & 7) * nk >> 3; }

template <int NF, class ARow>
DEVI void gemm_prefetch0(const bf16* __restrict__ A, ARow arow, const bf16* __restrict__ Bt, int ldb, int m0, int n0, char* smem, int koff = 0) {
  const int tid = opaque_tid();
  const int lrow = tid >> 3, lpos = tid & 7;
  const int gch = (lpos ^ (lrow & 7)) * 8 + koff * 64;
  char* ab = smem + tid * 16;
#pragma unroll
  for (int i = 0; i < 4; ++i)
    __builtin_amdgcn_global_load_lds((const unsigned*)(A + (unsigned)(arow(m0 + lrow + 32 * i) + gch)), (unsigned*)(ab + i * 4096), 16, 0, 0);
#pragma unroll
  for (int i = 0; i < NF; ++i)
    __builtin_amdgcn_global_load_lds((const unsigned*)(Bt + (unsigned)((n0 + lrow + 32 * i) * ldb + gch)), (unsigned*)(ab + 16384 + i * 4096), 16, 0, 0);
}

template <int NF, bool SWAP, class ARow, bool PRE = false, bool DEEP = false>
DEVI void gemm_mainloop_g(f32x4 (&acc)[4][NF], const bf16* __restrict__ A, ARow arow, int kstrideA,
                          const bf16* __restrict__ Bt, int ldb, int K, int m0, int n0, char* smem, int koff = 0) {
  const int tid = opaque_tid(), lane = tid & 63, wid = tid >> 6, wr = wid >> 1, wc = wid & 1, fr = lane & 15, fq = lane >> 4;
  const int lrow = tid >> 3, lpos = tid & 7;
  const int gch = (lpos ^ (lrow & 7)) * 8;
  unsigned aoff[4], boff[NF];
#pragma unroll
  for (int i = 0; i < 4; ++i) aoff[i] = (unsigned)(arow(m0 + lrow + 32 * i) + gch);
#pragma unroll
  for (int i = 0; i < NF; ++i) boff[i] = (unsigned)((n0 + lrow + 32 * i) * ldb + gch);
  const int nk = K >> 6;
  if (!PRE) __syncthreads();
#define GL_ISSUE(KT, BUF)                                                                                  \
  {                                                                                                        \
    char* ab = smem + (BUF) * 32768 + tid * 16;                                                            \
    const int kr_ = ((KT) + koff) & (nk - 1);                                                              \
    const unsigned ka = (unsigned)(kr_ * kstrideA), kb = (unsigned)(kr_ * 64);                             \
    _Pragma("unroll") for (int i = 0; i < 4; ++i)                                                          \
      __builtin_amdgcn_global_load_lds((const unsigned*)(A + (aoff[i] + ka)), (unsigned*)(ab + i * 4096), 16, 0, 0); \
    _Pragma("unroll") for (int i = 0; i < NF; ++i)                                                         \
      __builtin_amdgcn_global_load_lds((const unsigned*)(Bt + (boff[i] + kb)), (unsigned*)(ab + 16384 + i * 4096), 16, 0, 0); \
  }
  if (!PRE) GL_ISSUE(0, 0)
  asm volatile("s_waitcnt vmcnt(0)" ::: "memory");
  __syncthreads();
  const int swz = fr & 7;
  for (int kt = 0; kt < nk; ++kt) {
    if (kt + 1 < nk) GL_ISSUE(kt + 1, (kt + 1) & 1)
    const char* As = smem + (kt & 1) * 32768;
    const char* Bs = As + 16384;
    if (DEEP) {
    bf16x8 af[2][4], bfr[2][NF];
#pragma unroll
    for (int ks = 0; ks < 2; ++ks) {
      const int co = ((ks * 4 + fq) ^ swz) * 16;
#pragma unroll
      for (int m = 0; m < 4; ++m) af[ks][m] = *(const bf16x8*)(As + (wr * 64 + m * 16 + fr) * 128 + co);
#pragma unroll
      for (int n = 0; n < NF; ++n) bfr[ks][n] = *(const bf16x8*)(Bs + (wc * 16 * NF + n * 16 + fr) * 128 + co);
    }
    __builtin_amdgcn_s_setprio(1);
#pragma unroll
    for (int ks = 0; ks < 2; ++ks)
#pragma unroll
      for (int m = 0; m < 4; ++m)
#pragma unroll
        for (int n = 0; n < NF; ++n) {
          if (SWAP) acc[m][n] = __builtin_amdgcn_mfma_f32_16x16x32_bf16(bfr[ks][n], af[ks][m], acc[m][n], 0, 0, 0);
          else acc[m][n] = __builtin_amdgcn_mfma_f32_16x16x32_bf16(af[ks][m], bfr[ks][n], acc[m][n], 0, 0, 0);
        }
    __builtin_amdgcn_s_setprio(0);
    __builtin_amdgcn_sched_group_barrier(0x100, 4 + NF, 0);
#pragma unroll
    for (int i = 0; i < 4 + NF; ++i) { __builtin_amdgcn_sched_group_barrier(0x008, 2, 0); __builtin_amdgcn_sched_group_barrier(0x100, 1, 0); }
    __builtin_amdgcn_sched_group_barrier(0x008, 8 * NF - 2 * (4 + NF), 0);
    } else {
#pragma unroll
    for (int ks = 0; ks < 2; ++ks) {
      const int co = ((ks * 4 + fq) ^ swz) * 16;
      bf16x8 af[4], bfr[NF];
#pragma unroll
      for (int m = 0; m < 4; ++m) af[m] = *(const bf16x8*)(As + (wr * 64 + m * 16 + fr) * 128 + co);
#pragma unroll
      for (int n = 0; n < NF; ++n) bfr[n] = *(const bf16x8*)(Bs + (wc * 16 * NF + n * 16 + fr) * 128 + co);
      __builtin_amdgcn_s_setprio(1);
#pragma unroll
      for (int m = 0; m < 4; ++m)
#pragma unroll
        for (int n = 0; n < NF; ++n) {
          if (SWAP) acc[m][n] = __builtin_amdgcn_mfma_f32_16x16x32_bf16(bfr[n], af[m], acc[m][n], 0, 0, 0);
          else acc[m][n] = __builtin_amdgcn_mfma_f32_16x16x32_bf16(af[m], bfr[n], acc[m][n], 0, 0, 0);
        }
      __builtin_amdgcn_s_setprio(0);
    }
    }
    asm volatile("s_waitcnt vmcnt(0)" ::: "memory");
    __syncthreads();
  }
#undef GL_ISSUE
}

template <int NF, bool SWAP, class ARow>
DEVI void gemm_mainloop_r(f32x4 (&acc)[4][NF], const bf16* __restrict__ A, ARow arow, int kstrideA,
                          const bf16* __restrict__ Bt, int ldb, int K, int m0, int n0, char* smem) {
  constexpr int NBI = NF / 2;
  const int tid = opaque_tid(), lane = tid & 63, wid = tid >> 6, wr = wid >> 1, wc = wid & 1, fr = lane & 15, fq = lane >> 4;
  const int lrow = tid >> 2, lpos = tid & 3;
  const int gch = (lpos ^ ((4 - ((lrow >> 2) & 3)) & 3)) * 8;
  unsigned aoff[2], boff[NBI];
#pragma unroll
  for (int i = 0; i < 2; ++i) aoff[i] = (unsigned)(arow(m0 + lrow + 64 * i) + gch);
#pragma unroll
  for (int i = 0; i < NBI; ++i) boff[i] = (unsigned)((n0 + lrow + 64 * i) * ldb + gch);
  const int nh = K >> 5;
  __syncthreads();
#define GR_ISSUE(H)                                                                                        \
  {                                                                                                        \
    char* ab = smem + ((H) & 3) * 16384 + tid * 16;                                                        \
    const unsigned ka = (unsigned)(((H) >> 1) * kstrideA + ((H) & 1) * 32), kb = (unsigned)((H) * 32);     \
    _Pragma("unroll") for (int i = 0; i < 2; ++i)                                                          \
      __builtin_amdgcn_global_load_lds((const unsigned*)(A + (aoff[i] + ka)), (unsigned*)(ab + i * 4096), 16, 0, 0); \
    _Pragma("unroll") for (int i = 0; i < NBI; ++i)                                                        \
      __builtin_amdgcn_global_load_lds((const unsigned*)(Bt + (boff[i] + kb)), (unsigned*)(ab + 8192 + i * 4096), 16, 0, 0); \
  }
  GR_ISSUE(0) GR_ISSUE(1) GR_ISSUE(2)
  const int co = (fq ^ ((4 - ((fr >> 2) & 3)) & 3)) * 16;
  for (int h = 0; h < nh; ++h) {
    if (h + 2 < nh) { if (NF == 4) asm volatile("s_waitcnt vmcnt(8)" ::: "memory"); else asm volatile("s_waitcnt vmcnt(6)" ::: "memory"); }
    else if (h + 1 < nh) { if (NF == 4) asm volatile("s_waitcnt vmcnt(4)" ::: "memory"); else asm volatile("s_waitcnt vmcnt(3)" ::: "memory"); }
    else asm volatile("s_waitcnt vmcnt(0)" ::: "memory");
    __builtin_amdgcn_s_barrier();
    if (h + 3 < nh) GR_ISSUE(h + 3)
    const char* As = smem + (h & 3) * 16384;
    const char* Bs = As + 8192;
    bf16x8 af[4], bfr[NF];
#pragma unroll
    for (int m = 0; m < 4; ++m) af[m] = *(const bf16x8*)(As + (wr * 64 + m * 16 + fr) * 64 + co);
#pragma unroll
    for (int n = 0; n < NF; ++n) bfr[n] = *(const bf16x8*)(Bs + (wc * 16 * NF + n * 16 + fr) * 64 + co);
#pragma unroll
    for (int m = 0; m < 4; ++m)
#pragma unroll
      for (int n = 0; n < NF; ++n) {
        if (SWAP) acc[m][n] = __builtin_amdgcn_mfma_f32_16x16x32_bf16(bfr[n], af[m], acc[m][n], 0, 0, 0);
        else acc[m][n] = __builtin_amdgcn_mfma_f32_16x16x32_bf16(af[m], bfr[n], acc[m][n], 0, 0, 0);
      }
  }
#undef GR_ISSUE
  __syncthreads();
}

DEVI void zero_acc(f32x4 (&acc)[4][4]) {
#pragma unroll
  for (int m = 0; m < 4; ++m)
#pragma unroll
    for (int n = 0; n < 4; ++n) acc[m][n] = f32x4{0.f, 0.f, 0.f, 0.f};
}

DEVI void tile_swz(int t, int MT, int NT, int& mt, int& nt) {
#if SWZ_MODE == 1
  mt = t / NT; nt = t - mt * NT; return;
#elif SWZ_MODE == 2
  nt = t / MT; mt = t - nt * MT; return;
#endif
  int per = (MT * NT) >> 3;
  int v = (t & 7) * per + (t >> 3);
  int band = v / (8 * NT);
  int w = v - band * 8 * NT;
  mt = band * 8 + (w & 7);
  nt = w >> 3;
}

DEVI void store_rm(const f32x4 (&acc)[4][4], bf16* dst, long ld, int m0, int n0) {
  const int tid = opaque_tid(), lane = tid & 63, wid = tid >> 6, wr = wid >> 1, wc = wid & 1, fr = lane & 15, fq = lane >> 4;
#pragma unroll
  for (int m = 0; m < 4; ++m)
#pragma unroll
    for (int j = 0; j < 4; ++j) {
      bf16* rp = dst + (long)(m0 + wr * 64 + m * 16 + fq * 4 + j) * ld + n0 + wc * 64 + fr;
#pragma unroll
      for (int n = 0; n < 4; ++n) rp[n * 16] = f2bf(acc[m][n][j]);
    }
}

DEVI void store_rm_sw(const f32x4 (&acc)[4][4], bf16* dst, long ld, int m0, int n0) {
  const int tid = opaque_tid(), lane = tid & 63, wid = tid >> 6, wr = wid >> 1, wc = wid & 1, fr = lane & 15, fq = lane >> 4;
  const int cofs = (fq & 1) * 16 + (fq & 2) * 4;
#pragma unroll
  for (int m = 0; m < 4; ++m) {
    bf16* rp = dst + (long)(m0 + wr * 64 + m * 16 + fr) * ld + n0 + wc * 64 + cofs;
#pragma unroll
    for (int n = 0; n < 4; n += 2) {
      const unsigned x0 = pack2(acc[m][n][0], acc[m][n][1]), x1 = pack2(acc[m][n][2], acc[m][n][3]);
      const unsigned y0 = pack2(acc[m][n + 1][0], acc[m][n + 1][1]), y1 = pack2(acc[m][n + 1][2], acc[m][n + 1][3]);
      const u32x2 s0 = __builtin_amdgcn_permlane16_swap(x0, y0, false, false);
      const u32x2 s1 = __builtin_amdgcn_permlane16_swap(x1, y1, false, false);
      *(u32x4*)(rp + n * 16) = u32x4{s0[0], s1[0], s0[1], s1[1]};
    }
  }
}

DEVI void store_tr_wave(const f32x4 (&acc)[4][4], bf16* dstplane, long rowlen, int pos0  ) {
  const int lane = opaque_tid() & 63, fr = lane & 15, fq = lane >> 4;
#pragma unroll
  for (int m = 0; m < 4; ++m)
#pragma unroll
    for (int n = 0; n < 4; n += 2) {
      const unsigned x0 = pack2(acc[m][n][0], acc[m][n][1]), x1 = pack2(acc[m][n][2], acc[m][n][3]);
      const unsigned y0 = pack2(acc[m][n + 1][0], acc[m][n + 1][1]), y1 = pack2(acc[m][n + 1][2], acc[m][n + 1][3]);
      const u32x2 s0 = __builtin_amdgcn_permlane16_swap(x0, y0, false, false);
      const u32x2 s1 = __builtin_amdgcn_permlane16_swap(x1, y1, false, false);
      *(u32x4*)(dstplane + (long)((n + (fq & 1)) * 16 + fr) * rowlen + pos0 + m * 16 + (fq & 2) * 4) = u32x4{s0[0], s1[0], s0[1], s1[1]};
    }
}

DEVI void rope_sincos(int t, int i, float& sn, float& cs) {
  float inv = __powf(10000.f, -(float)i * (1.f / 16.f));
  float ang = (float)t * inv;
  float k = rintf(ang * 0.15915494309189535f);
  float r = fmaf(-k, 6.28125f, ang);
  r = fmaf(-k, 1.9353071795864769e-3f, r);
  sn = __sinf(r); cs = __cosf(r);
}

DEVI int win_srccol(int n) {
  if (n < 1280) return n;
  if (n < 1664) return 1304 + (n - 1280);
  if (n < 1792) return 1688 + (n - 1664);
  if (n < 2560) return 1848 + (n - 1792);
  if (n < 2592) return 1816 + (n - 2560);
  if (n < 2616) return 1280 + (n - 2592);
  if (n < 2620) return n;
  return -1;
}

template <int MODE>
DEVI void prep_transpose(const float* __restrict__ src, int ldsrc, int K, int Ndst, bf16* __restrict__ dst,
                         const float* __restrict__ kscale, char* smem, int rot) {
  float(*tile)[65] = (float(*)[65])smem;
  const int tid = opaque_tid();
  const int KT = K >> 6, NTL = Ndst >> 6, ntiles = KT * NTL;
  const int c4 = (tid & 15) * 4, r16 = tid >> 4;
  int start = (int)blockIdx.x - rot; if (start < 0) start += gridDim.x;
  for (int t = start; t < ntiles; t += gridDim.x) {
    int kt = t % KT, nt = t / KT;
    int n = nt * 64 + c4;
    int sc = MODE == 1 ? win_srccol(n) : n;
    __syncthreads();
#pragma unroll
    for (int i = 0; i < 4; ++i) {
      int k = i * 16 + r16;
      f32x4 v = f32x4{0.f, 0.f, 0.f, 0.f};
      if (sc >= 0) v = *(const f32x4*)(src + (long)(kt * 64 + k) * ldsrc + sc);
      if (kscale) v *= kscale[kt * 64 + k];
      tile[k][c4] = v[0]; tile[k][c4 + 1] = v[1]; tile[k][c4 + 2] = v[2]; tile[k][c4 + 3] = v[3];
    }
    __syncthreads();
    int nn = tid >> 2, kq = tid & 3;
    unsigned w[8];
#pragma unroll
    for (int e = 0; e < 8; ++e) w[e] = pack2(tile[kq * 16 + 2 * e][nn], tile[kq * 16 + 2 * e + 1][nn]);
    u32x4* dp = (u32x4*)(dst + (long)(nt * 64 + nn) * K + kt * 64 + kq * 16);
    dp[0] = u32x4{w[0], w[1], w[2], w[3]};
    dp[1] = u32x4{w[4], w[5], w[6], w[7]};
  }
}

DEVI void phase_prep(const Params& p, int L, char* smem) {
  char* ws = opaque_ptr(p.ws);
  const int G = gridDim.x;
  int rot = 0;
#define PREP(MODE, SRC, LDS_, KK, ND, DST, SC) \
  { prep_transpose<MODE>(SRC, LDS_, KK, ND, (bf16*)(ws + DST), SC, smem, rot); rot = (rot + ((KK) >> 6) * ((ND) >> 6)) % G; }
  PREP(1, p.in[2] + (size_t)L * 1024 * 2620, 2620, 1024, 2688, OFF_WIN, nullptr)
  PREP(0, p.in[12] + (size_t)L * 1024 * 3072, 3072, 1024, 3072, OFF_WG, nullptr)
  PREP(0, p.in[13] + (size_t)L * 512 * 1024, 1024, 512, 1024, OFF_WBN, nullptr)
  PREP(0, p.in[14] + (size_t)L * 256 * 1024, 1024, 256, 1024, OFF_WBM, nullptr)
  PREP(0, p.in[15] + (size_t)L * 256 * 1024, 1024, 256, 1024, OFF_WBF, nullptr)
  PREP(0, p.in[16] + (size_t)L * 1024 * 1024, 1024, 1024, 1024, OFF_WOUT, nullptr)
  PREP(0, p.in[17] + (size_t)L * 1024 * 256, 256, 1024, 256, OFF_WXQ, nullptr)
  PREP(0, p.in[18] + (size_t)L * 1024 * 512, 512, 1024, 512, OFF_WXKV, nullptr)
  PREP(0, p.in[19] + (size_t)L * 256 * 1024, 1024, 256, 1024, OFF_WXO, nullptr)
  PREP(0, p.in[20] + (size_t)L * 1024 * 4096, 4096, 1024, 4096, OFF_WUP, nullptr)
  PREP(0, p.in[21] + (size_t)L * 4096 * 1024, 1024, 4096, 1024, OFF_WDN, nullptr)
  PREP(0, p.in[8] + (size_t)L * 384 * 384, 384, 384, 384, OFF_WUQ, p.in[7] + L * 384)
  PREP(0, p.in[10] + (size_t)L * 128 * 512, 512, 128, 512, OFF_WUKV, p.in[9] + L * 128)
  PREP(0, p.in[4] + (size_t)(L * 2 + 0) * 2048 * 128, 128, 2048, 128, OFF_WC1, nullptr)
  PREP(0, p.in[4] + (size_t)(L * 2 + 1) * 2048 * 128, 128, 2048, 128, OFF_WC1 + (size_t)128 * 2048 * 2, nullptr)
  PREP(0, p.in[5] + (size_t)(L * 2 + 0) * 128 * 64, 64, 128, 64, OFF_WC2, nullptr)
  PREP(0, p.in[5] + (size_t)(L * 2 + 1) * 128 * 64, 64, 128, 64, OFF_WC2 + (size_t)64 * 128 * 2, nullptr)
#undef PREP
  {
    int bsel = (int)blockIdx.x - (G - 64);
    if (bsel >= 0) {
      const int tid = opaque_tid();
      const int kv = bsel >> 5, chunk = bsel & 31;
      const float* pe = p.in[3] + (size_t)(L * 2 + kv) * 2048 + chunk * 64;
      const float* w1 = p.in[4] + (size_t)(L * 2 + kv) * 2048 * 128 + (size_t)chunk * 64 * 128;
      int n = tid & 127, half = tid >> 7;
      float s = 0.f;
#pragma unroll 8
      for (int k = half * 32; k < half * 32 + 32; ++k) s += pe[k] * w1[(long)k * 128 + n];
      float* red = (float*)smem;
      __syncthreads();
      red[tid] = s;
      __syncthreads();
      if (tid < 128) ((float*)(ws + OFF_B1))[(kv * 32 + chunk) * 128 + tid] = red[tid] + red[tid + 128];
      __syncthreads();
    }
  }
  if (L == 0) {
    const long gt = (long)blockIdx.x * 256 + opaque_tid(), gn = (long)G * 256;
    const f32x4* xs = (const f32x4*)p.in[0];
    f32x4* xo = (f32x4*)p.out;
    u32x2* xb = (u32x2*)(ws + OFF_XB);
    for (long i = gt; i < (long)T_TOK * 1024 / 4; i += gn) {
      f32x4 v = xs[i]; xo[i] = v;
      xb[i] = u32x2{pack2(v[0], v[1]), pack2(v[2], v[3])};
    }
    const f32x4* ms = (const f32x4*)p.in[1];
    u32x2* mb = (u32x2*)(ws + OFF_MEMB);
    for (long i = gt; i < (long)2048 * 1024 / 4; i += gn) {
      f32x4 v = ms[i];
      mb[i] = u32x2{pack2(v[0], v[1]), pack2(v[2], v[3])};
    }
  }
}

DEVI void epi_proj(const Params& p, int L, f32x4 (&acc)[4][4], int m0, int nt) {
  char* ws = opaque_ptr(p.ws);
  const int tid = opaque_tid(), lane = tid & 63, wid = tid >> 6, wr = wid >> 1, wc = wid & 1, fr = lane & 15, fq = lane >> 4;
  const int mbase = m0 + wr * 64;
  if (nt == 7 || nt == 9 || nt == 18 || nt == 19) {
    const int b = mbase >> 12, t0 = mbase & 4095;
    bf16* dstp;
    if (nt == 7) dstp = (bf16*)(ws + OFF_VST) + (long)(b * 2 + wc) * 64 * 4096;
    else if (nt == 9) dstp = (bf16*)(ws + OFF_VWT) + (long)(b * 2 + wc) * 64 * 4096;
    else dstp = (bf16*)(ws + OFF_VFT) + (long)(b * 4 + (nt - 18) * 2 + wc) * 64 * 4096;
    store_tr_wave(acc, dstp, 4096, t0);
  } else if (nt == 20) {
    if (wc == 0) {
      float* mb = (float*)(ws + OFF_XQ);
#pragma unroll
      for (int m = 0; m < 4; ++m)
#pragma unroll
        for (int j = 0; j < 4; ++j) {
          float* rp = mb + (long)(mbase + m * 16 + fq * 4 + j) * 64 + fr;
#pragma unroll
          for (int n = 0; n < 4; ++n) rp[n * 16] = acc[m][n][j];
        }
      if (fr >= 8 && fr < 12) {
        float* flog = (float*)(ws + OFF_FLOG);
        const float bfh = p.in[11][L * 4 + (fr - 8)];
#pragma unroll
        for (int m = 0; m < 4; ++m)
#pragma unroll
          for (int j = 0; j < 4; ++j) {
            const float x = acc[m][3][j] + bfh;
            flog[(long)(mbase + m * 16 + fq * 4 + j) * 4 + (fr - 8)] = fminf(x, 0.f) - log1pf(__expf(-fabsf(x)));
          }
      }
    }
  } else {
    store_rm(acc, (bf16*)(ws + OFF_PROJ), PROJ_LD, m0, nt * 128);
  }
}

DEVI void phase_proj(const Params& p, int L, char* smem) {
  char* ws = opaque_ptr(p.ws);
  const bf16* xb = (const bf16*)(ws + OFF_XB);
  constexpr int NTILE = 256 * 21;
  for (int t = blockIdx.x; t < NTILE + 64; t += gridDim.x) {
    f32x4 acc[4][4];
    zero_acc(acc);
    if (t < NTILE) {
      int mt, nt; tile_swz(t, 256, 21, mt, nt);
      if (nt == 7 || nt == 9 || nt >= 18) {
        gemm_mainloop_g<4, false, RowLinear, false, true>(acc, xb, RowLinear{1024}, 64, (const bf16*)(ws + OFF_WIN), 1024, 1024, mt * 128, nt * 128, smem);
        epi_proj(p, L, acc, mt * 128, nt);
      } else {
        gemm_mainloop_g<4, true, RowLinear, false, true>(acc, xb, RowLinear{1024}, 64, (const bf16*)(ws + OFF_WIN), 1024, 1024, mt * 128, nt * 128, smem);
        store_rm_sw(acc, (bf16*)(ws + OFF_PROJ), PROJ_LD, mt * 128, nt * 128);
      }
    } else {
      int u = t - NTILE; int mt = u >> 2, nt = u & 3;
      GEMM_ML<4, false>(acc, (const bf16*)(ws + OFF_MEMB), RowLinear{1024}, 64, (const bf16*)(ws + OFF_WXKV), 1024, 1024, mt * 128, nt * 128, smem);
      const int wid = opaque_tid() >> 6, wr = wid >> 1, wc = wid & 1;
      if (nt < 2) store_rm(acc, (bf16*)(ws + OFF_KXA), 256, mt * 128, nt * 128);
      else {
        int row0 = mt * 128 + wr * 64; int b = row0 >> 8, mm = row0 & 255;
        int h = (nt - 2) * 2 + wc;
        store_tr_wave(acc, (bf16*)(ws + OFF_VXA) + (long)(b * 4 + h) * 64 * 256, 256, mm);
      }
    }
  }
}

DEVI float gelu_tanh(float x) {
  float u = 0.7978845608028654f * (x + 0.044715f * x * x * x);
  return 0.5f * x * (1.f + tanhf(u));
}

DEVI void phase_derived(const Params& p, int L, char* smem) {
  char* ws = opaque_ptr(p.ws);
  const int tid = opaque_tid(), lane = tid & 63, wid = tid >> 6, wr = wid >> 1, wc = wid & 1, fr = lane & 15, fq = lane >> 4;
  const bf16* proj = (const bf16*)(ws + OFF_PROJ);
  constexpr int N_CMP = 64, N_CUM = 8, N_MISC = 512, N_QUP = 768, N_KVUP = 1024;
  const bool cmpblk = (int)gridDim.x > 2 * N_CMP && (int)blockIdx.x < N_CMP;
  const int dstride = (int)gridDim.x > 2 * N_CMP ? (int)gridDim.x - N_CMP : (int)gridDim.x;
  for (int t0_ = blockIdx.x; t0_ < N_CMP + N_CUM + N_MISC + N_QUP + N_KVUP; t0_ += cmpblk ? (1 << 20) : dstride) {
    int t;
    if (t0_ < N_CMP) t = t0_;
    else if (t0_ < N_CMP + N_CUM) t = N_CMP + N_QUP + N_KVUP + (t0_ - N_CMP);
    else if (t0_ < N_CMP + N_CUM + N_MISC) t = N_CMP + N_QUP + N_KVUP + N_CUM + (t0_ - N_CMP - N_CUM);
    else t = N_CMP + (t0_ - N_CMP - N_CUM - N_MISC);
    if (t < N_CMP) {
      const int kv = t >> 5, mt = t & 31;
      f32x4 acc[4][4]; zero_acc(acc);
      GEMM_ML<4, false>(acc, proj, RowCmp{kv ? 640 : 512}, PROJ_LD, (const bf16*)(ws + OFF_WC1) + (long)kv * 128 * 2048, 2048, 2048, mt * 128, 0, smem);
      __syncthreads();
      bf16* Hs = (bf16*)smem;
      const float* b1 = (const float*)(ws + OFF_B1) + kv * 32 * 128;
#pragma unroll
      for (int n = 0; n < 4; ++n) {
        const int col = wc * 64 + n * 16 + fr;
        float bb = 0.f;
#pragma unroll 8
        for (int ch = 0; ch < 32; ++ch) bb += b1[ch * 128 + col];
#pragma unroll
        for (int m = 0; m < 4; ++m)
#pragma unroll
          for (int j = 0; j < 4; ++j) Hs[(wr * 64 + m * 16 + fq * 4 + j) * 136 + col] = f2bf(gelu_tanh(acc[m][n][j] + bb));
      }
      __syncthreads();
      f32x4 a2[4][2];
#pragma unroll
      for (int m = 0; m < 4; ++m) { a2[m][0] = f32x4{0.f, 0.f, 0.f, 0.f}; a2[m][1] = f32x4{0.f, 0.f, 0.f, 0.f}; }
      const bf16* w2 = (const bf16*)(ws + OFF_WC2) + (long)kv * 64 * 128;
#pragma unroll
      for (int ks = 0; ks < 4; ++ks) {
        bf16x8 af[4], bq[2];
#pragma unroll
        for (int m = 0; m < 4; ++m) af[m] = *(const bf16x8*)(Hs + (wr * 64 + m * 16 + fr) * 136 + ks * 32 + fq * 8);
#pragma unroll
        for (int n = 0; n < 2; ++n) bq[n] = *(const bf16x8*)(w2 + (wc * 32 + n * 16 + fr) * 128 + ks * 32 + fq * 8);
#pragma unroll
        for (int m = 0; m < 4; ++m)
#pragma unroll
          for (int n = 0; n < 2; ++n) a2[m][n] = __builtin_amdgcn_mfma_f32_16x16x32_bf16(af[m], bq[n], a2[m][n], 0, 0, 0);
      }
#pragma unroll
      for (int m = 0; m < 4; ++m)
#pragma unroll
        for (int n = 0; n < 2; ++n) {
          const int r0 = mt * 128 + wr * 64 + m * 16 + fq * 4;
          const int col = wc * 32 + n * 16 + fr;
          if (kv == 0) {
            bf16* kc = (bf16*)(ws + OFF_KC);
#pragma unroll
            for (int j = 0; j < 4; ++j) kc[(long)(r0 + j) * 64 + col] = f2bf(a2[m][n][j]);
          } else {
            bf16* vct = (bf16*)(ws + OFF_VCT);
            u32x2 v; v[0] = pack2(a2[m][n][0], a2[m][n][1]); v[1] = pack2(a2[m][n][2], a2[m][n][3]);
            *(u32x2*)(vct + ((long)(r0 >> 8) * 64 + col) * 256 + (r0 & 255)) = v;
          }
        }
    } else if (t < N_CMP + N_QUP) {
      const int u = t - N_CMP; const int mt = u / 3, nt = u - mt * 3;
      f32x4 acc[4][4]; zero_acc(acc);
      gemm_mainloop<true>(acc, proj + 1280, RowLinear{PROJ_LD}, 64, (const bf16*)(ws + OFF_WUQ), 384, 384, mt * 128, nt * 128, smem);
      const float* rowss = (const float*)(smem + SM_ROWSS);
      bf16* qmla = (bf16*)(ws + OFF_QMLA);
      const int nbase = nt * 128 + wc * 64;
#pragma unroll
      for (int m = 0; m < 4; ++m)
#pragma unroll
        for (int j = 0; j < 4; ++j) {
          const int lr = wr * 64 + m * 16 + fq * 4 + j;
          const int row = mt * 128 + lr;
          const float rinv = rsqrtf(rowss[lr] * (1.f / 384.f) + 1e-6f);
          float v[4];
#pragma unroll
          for (int n = 0; n < 4; ++n) v[n] = acc[m][n][j] * rinv;
#pragma unroll
          for (int n = 0; n < 3; ++n) {
            if (((nbase + n * 16) % 96) == 64) {
              float sn, cs; rope_sincos(row & 4095, fr, sn, cs);
              float x1 = v[n], x2 = v[n + 1];
              v[n] = x1 * cs - x2 * sn; v[n + 1] = x1 * sn + x2 * cs;
            }
          }
#pragma unroll
          for (int n = 0; n < 4; ++n) qmla[(long)row * 384 + nbase + n * 16 + fr] = f2bf(v[n]);
        }
    } else if (t < N_CMP + N_QUP + N_KVUP) {
      const int u = t - N_CMP - N_QUP; const int mt = u >> 2, nt = u & 3;
      f32x4 acc[4][4]; zero_acc(acc);
      gemm_mainloop<true>(acc, proj + 1664, RowLinear{PROJ_LD}, 64, (const bf16*)(ws + OFF_WUKV), 128, 128, mt * 128, nt * 128, smem);
      const float* rowss = (const float*)(smem + SM_ROWSS);
#pragma unroll
      for (int m = 0; m < 4; ++m)
#pragma unroll
        for (int j = 0; j < 4; ++j) {
          const float rinv = rsqrtf(rowss[wr * 64 + m * 16 + fq * 4 + j] * (1.f / 128.f) + 1e-6f);
#pragma unroll
          for (int n = 0; n < 4; ++n) acc[m][n][j] *= rinv;
        }
      const int mbase = mt * 128 + wr * 64;
      if (wc == 0) {
        bf16* kmla = (bf16*)(ws + OFF_KMLA);
#pragma unroll
        for (int m = 0; m < 4; ++m)
#pragma unroll
          for (int j = 0; j < 4; ++j) {
            bf16* rp = kmla + (long)(mbase + m * 16 + fq * 4 + j) * 384 + nt * 96 + fr;
#pragma unroll
            for (int n = 0; n < 4; ++n) rp[n * 16] = f2bf(acc[m][n][j]);
          }
      } else {
        const int b = mbase >> 12, t0 = mbase & 4095;
        store_tr_wave(acc, (bf16*)(ws + OFF_VMT) + (long)(b * 4 + nt) * 64 * 4096, 4096, t0);
      }
    } else if (t < N_CMP + N_QUP + N_KVUP + N_CUM) {
      const int u = t - N_CMP - N_QUP - N_KVUP;
      const int seq = u * 4 + wid;
      const int b = seq >> 2, h = seq & 3;
      const float* flog = (const float*)(ws + OFF_FLOG) + (long)b * 4096 * 4 + h;
      float* cum = (float*)(ws + OFF_CUM) + (long)seq * 4096;
      float s = 0.f;
      for (int i = 0; i < 64; ++i) s += flog[(long)(lane * 64 + i) * 4];
      float incl = s;
#pragma unroll
      for (int off = 1; off < 64; off <<= 1) { float o = __shfl_up(incl, off); if (lane >= off) incl += o; }
      float run = incl - s;
      for (int i = 0; i < 64; ++i) { run += flog[(long)(lane * 64 + i) * 4]; cum[lane * 64 + i] = run * LOG2E; }
    } else {
      const int u = t - N_CMP - N_QUP - N_KVUP - N_CUM;
      const int row = u * 64 + (tid >> 2), sub = tid & 3;
      const float* mb = (const float*)(ws + OFF_XQ) + (long)row * 64;
      bf16* kmla = (bf16*)(ws + OFF_KMLA) + (long)row * 384;
      float* gaux = (float*)(ws + OFF_GAUX) + (long)row * 32;
      const int tpos = row & 4095;
#pragma unroll
      for (int q = 0; q < 4; ++q) {
        const int i = sub * 4 + q;
        float sn, cs; rope_sincos(tpos, i, sn, cs);
        const float x1 = mb[i], x2 = mb[16 + i];
        const bf16 y1 = f2bf(x1 * cs - x2 * sn), y2 = f2bf(x1 * sn + x2 * cs);
#pragma unroll
        for (int hh = 0; hh < 4; ++hh) { kmla[hh * 96 + 64 + i] = y1; kmla[hh * 96 + 80 + i] = y2; }
      }
#pragma unroll
      for (int q = 0; q < 6; ++q) { const int gi = sub * 6 + q; gaux[gi] = sigmoidf(mb[32 + gi]); }
    }
  }
}

DEVI float xmax16(float x) {
  u32x2 r = __builtin_amdgcn_permlane16_swap(__float_as_uint(x), __float_as_uint(x), false, false);
  return fmaxf(__uint_as_float(r[0]), __uint_as_float(r[1]));
}
DEVI float xmax32(float x) {
  u32x2 r = __builtin_amdgcn_permlane32_swap(__float_as_uint(x), __float_as_uint(x), false, false);
  return fmaxf(__uint_as_float(r[0]), __uint_as_float(r[1]));
}
template <int CTRL> DEVI float dppf(float v) { return __int_as_float(__builtin_amdgcn_update_dpp(0, __float_as_int(v), CTRL, 0xF, 0xF, true)); }
template <int CTRL> DEVI unsigned dppu(unsigned v) { return (unsigned)__builtin_amdgcn_update_dpp(0, (int)v, CTRL, 0xF, 0xF, true); }
constexpr int DPP_X1 = 0xB1, DPP_X2 = 0x4E, DPP_HM = 0x141, DPP_M = 0x140;
DEVI float quad_sum(float v) { v += dppf<DPP_X1>(v); v += dppf<DPP_X2>(v); return v; }
DEVI float row16_sum(float v) { v = quad_sum(v); v += dppf<DPP_HM>(v); v += dppf<DPP_M>(v); return v; }
DEVI float wave_sum(float v) {
  v = row16_sum(v);
  u32x2 r = __builtin_amdgcn_permlane16_swap(__float_as_uint(v), __float_as_uint(v), false, false);
  v = __uint_as_float(r[0]) + __uint_as_float(r[1]);
  r = __builtin_amdgcn_permlane32_swap(__float_as_uint(v), __float_as_uint(v), false, false);
  return __uint_as_float(r[0]) + __uint_as_float(r[1]);
}
DEVI float max3f(float a, float b, float c) { return fmaxf(fmaxf(a, b), c); }
DEVI float max16(const f32x4& a, const f32x4& b, const f32x4& c, const f32x4& d) {
  const float t0 = max3f(a[0], a[1], a[2]), t1 = max3f(a[3], b[0], b[1]), t2 = max3f(b[2], b[3], c[0]);
  const float t3 = max3f(c[1], c[2], c[3]), t4 = max3f(d[0], d[1], d[2]);
  return fmaxf(max3f(t0, t1, t2), max3f(t3, t4, d[3]));
}
constexpr float DEFER_THR = 8.f;

template <int DK, int MODE, int RBM, class SF, class FF, class POST>
DEVI void attn_tile_body(const bf16x8 (&qf)[2][DK / 32], const char* Ks, const char* Vs, SF& sf, FF& ff, POST& post,
                         int cur, int c0, int c1, float (&m)[2], float (&l)[2], f32x4 (&o)[5][2], int fr, int fq) {
  constexpr int NKC = DK / 32;
  f32x4 s[4][2];
#pragma unroll
  for (int kb = 0; kb < 4; ++kb) { s[kb][0] = f32x4{0.f, 0.f, 0.f, 0.f}; s[kb][1] = f32x4{0.f, 0.f, 0.f, 0.f}; }
#pragma unroll
  for (int ks = 0; ks < NKC; ++ks)
#pragma unroll
    for (int kb = 0; kb < 4; ++kb) {
      const int koff = DK == 64 ? (kb * 16 + fr) * 128 + (((ks * 4 + fq) ^ (fr & 7)) * 16)
                                : (kb * 16 + fr) * 192 + ((ks * 4 + (fq ^ ((fr >> 2) & 3))) * 16);
      bf16x8 kf = *(const bf16x8*)(Ks + koff);
      if (RBM & 1) s[kb][0] = __builtin_amdgcn_mfma_f32_16x16x32_bf16(kf, qf[0][ks], s[kb][0], 0, 0, 0);
      if (RBM & 2) s[kb][1] = __builtin_amdgcn_mfma_f32_16x16x32_bf16(kf, qf[1][ks], s[kb][1], 0, 0, 0);
    }
#pragma unroll
  for (int rb = 0; rb < 2; ++rb) {
    if (!(RBM & (1 << rb))) continue;
    const int cm = rb == 0 ? c0 : c1;
    if (cm == 2) {
      const float cl = ff.cl(rb, cur);
      const float fsc = ff.sc;
      if (FF::HASVEC) {
#pragma unroll
        for (int kb = 0; kb < 4; ++kb) {
          const f32x4 av = ff.vec(kb);
#pragma unroll
          for (int j = 0; j < 4; ++j) s[kb][rb][j] = opq(fmaf(s[kb][rb][j], fsc, av[j]));
        }
      }
      if (MODE == 2) {
        const float c = cl - m[rb];
#pragma unroll
        for (int kb = 0; kb < 4; ++kb)
#pragma unroll
          for (int j = 0; j < 4; ++j) {
            const float e = FF::HASVEC ? opq(s[kb][rb][j] + c) : opq(fmaf(s[kb][rb][j], fsc, c));
            s[kb][rb][j] = opq(fexp2(e) * l[rb]);
          }
      } else if (MODE == 0) {
        float mx = max16(s[0][rb], s[1][rb], s[2][rb], s[3][rb]);
        mx = xmax16(mx); mx = xmax32(mx);
        const float cand = FF::HASVEC ? (mx + cl) : fmaf(mx, fsc, cl);
        if (__builtin_amdgcn_ballot_w64(cand > m[rb] + DEFER_THR) != 0) {
          const float mn = fmaxf(m[rb], cand);
          const float alpha = fexp2(m[rb] - mn);
          m[rb] = mn;
#pragma unroll
          for (int db = 0; db < 5; ++db)
#pragma unroll
            for (int j = 0; j < 4; ++j) o[db][rb][j] = opq(o[db][rb][j] * alpha);
        }
        const float c = cl - m[rb];
#pragma unroll
        for (int kb = 0; kb < 4; ++kb)
#pragma unroll
          for (int j = 0; j < 4; ++j) {
            const float e = FF::HASVEC ? opq(s[kb][rb][j] + c) : opq(fmaf(s[kb][rb][j], fsc, c));
            s[kb][rb][j] = fexp2(e);
          }
      } else {
        float mx = max16(s[0][rb], s[1][rb], s[2][rb], s[3][rb]);
        mx = xmax16(mx); mx = xmax32(mx);
        const float cand = FF::HASVEC ? (mx + cl) : fmaf(mx, fsc, cl);
        const float mn = fmaxf(m[rb], cand);
        const float alpha = fexp2(m[rb] - mn);
        m[rb] = mn;
        const float c = cl - mn;
        float rs0 = 0.f, rs1 = 0.f;
#pragma unroll
        for (int kb = 0; kb < 4; ++kb)
#pragma unroll
          for (int j = 0; j < 4; ++j) {
            const float e = FF::HASVEC ? opq(s[kb][rb][j] + c) : opq(fmaf(s[kb][rb][j], fsc, c));
            const float pv = fexp2(e);
            s[kb][rb][j] = pv;
            if (j & 1) rs1 = opq(rs1 + pv); else rs0 = opq(rs0 + pv);
          }
        l[rb] = fmaf(l[rb], alpha, rs0 + rs1);
      }
      continue;
    }
#pragma unroll
    for (int kb = 0; kb < 4; ++kb)
#pragma unroll
      for (int j = 0; j < 4; ++j) s[kb][rb][j] = sf(rb, kb, j, cur, s[kb][rb][j]);
    if (MODE == 2) {
#pragma unroll
      for (int kb = 0; kb < 4; ++kb)
#pragma unroll
        for (int j = 0; j < 4; ++j) s[kb][rb][j] = fexp2(s[kb][rb][j] - m[rb]) * l[rb];
    } else if (MODE == 0) {
      float mx = max16(s[0][rb], s[1][rb], s[2][rb], s[3][rb]);
      mx = xmax16(mx); mx = xmax32(mx);
      if (__builtin_amdgcn_ballot_w64(mx > m[rb] + DEFER_THR) != 0) {
        const float mn = fmaxf(m[rb], mx);
        const float alpha = fexp2(m[rb] - mn);
        m[rb] = mn;
#pragma unroll
        for (int db = 0; db < 5; ++db)
#pragma unroll
          for (int j = 0; j < 4; ++j) o[db][rb][j] = opq(o[db][rb][j] * alpha);
      }
      const float mm = m[rb];
#pragma unroll
      for (int kb = 0; kb < 4; ++kb)
#pragma unroll
        for (int j = 0; j < 4; ++j) s[kb][rb][j] = fexp2(s[kb][rb][j] - mm);
    } else {
      float mx = -INFINITY;
#pragma unroll
      for (int kb = 0; kb < 4; ++kb)
#pragma unroll
        for (int j = 0; j < 4; ++j) mx = fmaxf(mx, s[kb][rb][j]);
      mx = xmax16(mx); mx = xmax32(mx);
      const float mn = fmaxf(m[rb], mx);
      const float alpha = fexp2(m[rb] - mn);
      m[rb] = mn;
      float rs = 0.f;
#pragma unroll
      for (int kb = 0; kb < 4; ++kb)
#pragma unroll
        for (int j = 0; j < 4; ++j) { float pv = fexp2(s[kb][rb][j] - mn); s[kb][rb][j] = pv; rs += pv; }
      l[rb] = l[rb] * alpha + rs;
    }
  }
  if (MODE == 2) post(cur, s);
  if (MODE != 1) {
    bf16x8 pf[2][2];
#pragma unroll
    for (int rb = 0; rb < 2; ++rb) {
      if (!(RBM & (1 << rb))) continue;
#pragma unroll
      for (int kp2 = 0; kp2 < 2; ++kp2) {
        u32x4 w;
        w[0] = pack2(s[2 * kp2][rb][0], s[2 * kp2][rb][1]); w[1] = pack2(s[2 * kp2][rb][2], s[2 * kp2][rb][3]);
        w[2] = pack2(s[2 * kp2 + 1][rb][0], s[2 * kp2 + 1][rb][1]); w[3] = pack2(s[2 * kp2 + 1][rb][2], s[2 * kp2 + 1][rb][3]);
        pf[rb][kp2] = __builtin_bit_cast(bf16x8, w);
      }
    }
#pragma unroll
    for (int kp2 = 0; kp2 < 2; ++kp2)
#pragma unroll
      for (int db = 0; db < 4; ++db) {
        const char* base = Vs + (db * 16 + fr) * 128 + (fq & 1) * 8;
        const int c = kp2 * 4 + (fq >> 1);
        u32x2 lo = *(const u32x2*)(base + ((c ^ (fr & 7)) * 16));
        u32x2 hi = *(const u32x2*)(base + (((c + 2) ^ (fr & 7)) * 16));
        u32x4 w; w[0] = lo[0]; w[1] = lo[1]; w[2] = hi[0]; w[3] = hi[1];
        bf16x8 vf = __builtin_bit_cast(bf16x8, w);
        if (RBM & 1) o[db][0] = __builtin_amdgcn_mfma_f32_16x16x32_bf16(vf, pf[0][kp2], o[db][0], 0, 0, 0);
        if (RBM & 2) o[db][1] = __builtin_amdgcn_mfma_f32_16x16x32_bf16(vf, pf[1][kp2], o[db][1], 0, 0, 0);
      }
    if (MODE == 0) {
      u32x4 w1; w1[0] = w1[1] = w1[2] = w1[3] = 0x3F803F80u;
      const bf16x8 ones = __builtin_bit_cast(bf16x8, w1);
#pragma unroll
      for (int kp2 = 0; kp2 < 2; ++kp2) {
        if (RBM & 1) o[4][0] = __builtin_amdgcn_mfma_f32_16x16x32_bf16(ones, pf[0][kp2], o[4][0], 0, 0, 0);
        if (RBM & 2) o[4][1] = __builtin_amdgcn_mfma_f32_16x16x32_bf16(ones, pf[1][kp2], o[4][1], 0, 0, 0);
      }
    }
  }
}

template <int DK, int MODE, bool RBSKIP, bool HASCUM, class KP, class VP, class CP, class SF, class FF, class CLS, class POST>
DEVI void attn_run(u64 tiles, u64 wtiles, const bf16x8 (&qf)[2][DK / 32], KP kp, VP vp, CP cp, SF sf, FF ff, CLS cls, POST post,
                   float (&m)[2], float (&l)[2], f32x4 (&o)[5][2], char* smem, const char*& curslot) {
  constexpr int NKC = DK / 32;
  constexpr int CPR = DK / 8;
  const int tid = opaque_tid(), lane = tid & 63, fr = lane & 15, fq = lane >> 4;
  if (tiles == 0) return;
#define ATT_ISSUE(TILE, SLOT)                                                                             \
  {                                                                                                       \
    char* sb = smem + (SLOT) * GEO::STRIDE;                                                               \
    _Pragma("unroll") for (int i = 0; i < NKC; ++i) {                                                     \
      const int q = tid + 256 * i; const int row = q / CPR, pos = q - row * CPR;                          \
      const int gc = DK == 64 ? (pos ^ (row & 7)) : ((pos & ~3) | ((pos & 3) ^ ((row >> 2) & 3)));        \
      __builtin_amdgcn_global_load_lds((const unsigned*)(kp(TILE, row) + gc * 8), (unsigned*)(sb + q * 16), 16, 0, 0); \
    }                                                                                                     \
    if (MODE != 1) {                                                                                      \
      _Pragma("unroll") for (int i = 0; i < 2; ++i) {                                                     \
        const int q = tid + 256 * i; const int d = q >> 3, pos = q & 7;                                   \
        __builtin_amdgcn_global_load_lds((const unsigned*)(vp(TILE, d) + ((pos ^ (d & 7)) * 8)), (unsigned*)(sb + GEO::AVO + q * 16), 16, 0, 0); \
      }                                                                                                   \
    }                                                                                                     \
    if (HASCUM) {                                                                                         \
      if (lane < 16) __builtin_amdgcn_global_load_lds((const unsigned*)(cp(TILE) + lane * 4), (unsigned*)(sb + GEO::ACO + lane * 16), 16, 0, 0); \
    }                                                                                                     \
  }
#define ATT_POP(VAR) { VAR = -1; if (tiles) { VAR = __builtin_ctzll(tiles); tiles &= tiles - 1; } }
#define ATT_COMPUTE(TILE, SLOT)                                                                           \
  if ((wtiles >> (TILE)) & 1) {                                                                           \
    const char* sb = smem + (SLOT) * GEO::STRIDE;                                                         \
    curslot = sb;                                                                                         \
    const int c0 = cls(0, (TILE)), c1 = cls(1, (TILE));                                                   \
    if (RBSKIP) {                                                                                         \
      if (c0) attn_tile_body<DK, MODE, 1>(qf, sb, sb + GEO::AVO, sf, ff, post, (TILE), c0, c1, m, l, o, fr, fq); \
      if (c1) attn_tile_body<DK, MODE, 2>(qf, sb, sb + GEO::AVO, sf, ff, post, (TILE), c0, c1, m, l, o, fr, fq); \
    } else {                                                                                              \
      attn_tile_body<DK, MODE, 3>(qf, sb, sb + GEO::AVO, sf, ff, post, (TILE), c0, c1, m, l, o, fr, fq);  \
    }                                                                                                     \
  }
  using GEO = RingGeo<DK>;
  __syncthreads();
  if (DK == 64) {
    int ta, tb;
    ATT_POP(ta) ATT_ISSUE(ta, 0)
    ATT_POP(tb) if (tb >= 0) ATT_ISSUE(tb, 1)
    int sp = 0;
    for (;;) {
      asm volatile("s_waitcnt vmcnt(0)" ::: "memory");
      __builtin_amdgcn_s_barrier();
      int tc, td = -1;
      ATT_POP(tc)
      if (tc >= 0) { ATT_ISSUE(tc, sp ^ 2) ATT_POP(td) if (td >= 0) ATT_ISSUE(td, (sp ^ 2) + 1) }
      ATT_COMPUTE(ta, sp)
      if (tb >= 0) ATT_COMPUTE(tb, sp + 1)
      if (tc < 0) break;
      ta = tc; tb = td; sp ^= 2;
    }
  } else {
    int cur, n1;
    ATT_POP(cur) ATT_ISSUE(cur, 0)
    ATT_POP(n1) if (n1 >= 0) ATT_ISSUE(n1, 1)
    int si = 0;
    for (;;) {
      if (n1 >= 0) {
        constexpr int G = NKC + (MODE != 1 ? 2 : 0) + (HASCUM ? 1 : 0);
        if (G == 2) asm volatile("s_waitcnt vmcnt(2)" ::: "memory");
        else if (G == 4) asm volatile("s_waitcnt vmcnt(4)" ::: "memory");
        else if (G == 5) asm volatile("s_waitcnt vmcnt(5)" ::: "memory");
        else asm volatile("s_waitcnt vmcnt(0)" ::: "memory");
      } else {
        asm volatile("s_waitcnt vmcnt(0)" ::: "memory");
      }
      __builtin_amdgcn_s_barrier();
      int n2;
      ATT_POP(n2)
      if (n2 >= 0) { const int s2 = si >= 1 ? si - 1 : 2; ATT_ISSUE(n2, s2) }
      ATT_COMPUTE(cur, si)
      if (n1 < 0) break;
      cur = n1; n1 = n2; si = si == 2 ? 0 : si + 1;
    }
  }
#undef ATT_COMPUTE
#undef ATT_POP
#undef ATT_ISSUE
  __syncthreads();
}

template <class CL>
struct FastConst { static constexpr bool HASVEC = false; float sc; CL clf; DEVI float cl(int rb, int tile) const { return clf(rb, tile); } DEVI f32x4 vec(int) const { return f32x4{0.f, 0.f, 0.f, 0.f}; } };
template <class CL, class VF>
struct FastVec { static constexpr bool HASVEC = true; float sc; CL clf; VF vf; DEVI float cl(int rb, int tile) const { return clf(rb, tile); } DEVI f32x4 vec(int kb) const { return vf(kb); } };
template <class CL> DEVI FastConst<CL> make_fast(float sc, CL cl) { return FastConst<CL>{sc, cl}; }
template <class CL, class VF> DEVI FastVec<CL, VF> make_fast_vec(float sc, CL cl, VF vf) { return FastVec<CL, VF>{sc, cl, vf}; }

DEVI float row_lsum(float l) { l += __shfl_xor(l, 16); l += __shfl_xor(l, 32); return l; }

struct NoCum { DEVI const float* operator()(int) const { return nullptr; } };
struct NoPost { DEVI void operator()(int, f32x4 (&)[4][2]) const {} };

DEVI void nsa_item(const Params& p, int b, int g, int t0, char* smem) {
  char* ws = opaque_ptr(p.ws);
  const int tid = opaque_tid(), lane = tid & 63, wid = tid >> 6, fr = lane & 15, fq = lane >> 4;
  const bf16* proj = (const bf16*)(ws + OFF_PROJ);
  float* lut = (float*)(smem + ALUT);
  float* imp = (float*)(smem + AIMP);
  u64* selm = (u64*)(smem + ASEL);
  __syncthreads();
  const float* t5 = p.in[6];
  for (int e = tid; e < 512; e += 256) { int r = e >> 7, d = e & 127; lut[e] = t5[T5BUCKET[d] * 8 + g * 4 + r] * LOG2E; }
  for (int e = tid; e < 2048; e += 256) imp[e] = 0.f;
  const int hl = fr & 3, h = g * 4 + hl;
  int tl[2], t[2];
  tl[0] = wid * 8 + (fr >> 2); tl[1] = tl[0] + 4;
#pragma unroll
  for (int rb = 0; rb < 2; ++rb) t[rb] = t0 + tl[rb];
  bf16x8 qf[2][2];
#pragma unroll
  for (int rb = 0; rb < 2; ++rb)
#pragma unroll
    for (int ks = 0; ks < 2; ++ks) qf[rb][ks] = *(const bf16x8*)(proj + ((long)b * 4096 + t[rb]) * PROJ_LD + h * 64 + ks * 32 + fq * 8);
  const float* gaux = (const float*)(ws + OFF_GAUX);
  f32x4* totl = (f32x4*)(ws + OFF_OXA) + (size_t)blockIdx.x * 8 * 256 + tid;
  const char* curslot = smem;
  const float* lutr = lut + hl * 128;
  const float sc = 0.125f * LOG2E;
  const int uw = __builtin_amdgcn_readfirstlane(wid);
  const int tmin0 = t0 + uw * 8, tmin1 = tmin0 + 4;
  __syncthreads();

  float m[2], l[2]; f32x4 o[5][2];
#define RESET_STATE                                                                                   \
  {                                                                                                   \
    m[0] = m[1] = -1e30f; l[0] = l[1] = 0.f;                                                          \
    _Pragma("unroll") for (int db = 0; db < 5; ++db) { o[db][0] = f32x4{0.f, 0.f, 0.f, 0.f}; o[db][1] = f32x4{0.f, 0.f, 0.f, 0.f}; } \
  }
#define ACCUM_BRANCH(GI, NORMALIZED)                                                                  \
  {                                                                                                   \
    _Pragma("unroll") for (int rb = 0; rb < 2; ++rb) {                                                \
      float f = gaux[((long)b * 4096 + t[rb]) * 32 + h * 3 + GI];                                     \
      if (!(NORMALIZED)) { float ls = o[4][rb][0]; f = ls > 0.f ? f / ls : 0.f; }                     \
      _Pragma("unroll") for (int db = 0; db < 4; ++db) {                                              \
        f32x4* tp = totl + (rb * 4 + db) * 256;                                                       \
        if (GI == 0) *tp = o[db][rb] * f; else *tp = *tp + o[db][rb] * f;                             \
      }                                                                                               \
    }                                                                                                 \
  }

  {
    const bf16* kc = (const bf16*)(ws + OFF_KC) + (long)(b * 2 + g) * 256 * 64;
    const bf16* vct = (const bf16*)(ws + OFF_VCT) + (long)(b * 2 + g) * 64 * 256;
    const int nct = (t0 >> 10) + 1;
    const u64 ctiles = (1ull << nct) - 1;
    auto kpc = [&](int tile, int row) { return kc + (long)(tile * 64 + row) * 64; };
    auto vpc = [&](int tile, int d) { return vct + (long)d * 256 + tile * 64; };
    auto sfc = [&](int rb, int kb, int j, int tile, float s) {
      int cend = (tile * 64 + kb * 16 + fq * 4 + j) * 16 + 31;
      int dist = t[rb] - cend;
      int di = min(max(dist, 0), 127);
      return dist >= 0 ? fmaf(s, sc, lutr[di]) : -INFINITY;
    };
    const float cbf = lutr[127];
    auto ffc = make_fast(sc, [=](int rb, int tile) { return cbf; });
    auto clc = [&](int rb, int tile) { return ((rb ? tmin1 : tmin0) - ((tile * 64 + 63) * 16 + 31) >= 113) ? 2 : 1; };
    RESET_STATE
    attn_run<64, 1, false, false>(ctiles, ctiles, qf, kpc, vpc, NoCum{}, sfc, ffc, clc, NoPost{}, m, l, o, smem, curslot);
#pragma unroll
    for (int rb = 0; rb < 2; ++rb) { float ls = row_lsum(l[rb]); l[rb] = ls > 0.f ? 1.f / ls : 0.f; }
    auto postc = [&](int tile, f32x4 (&s)[4][2]) {
#pragma unroll
      for (int rb = 0; rb < 2; ++rb)
#pragma unroll
        for (int kb = 0; kb < 4; ++kb) {
          float P[4];
#pragma unroll
          for (int j = 0; j < 4; ++j) P[j] = quad_sum(s[kb][rb][j]);
          if (hl == 0) {
            int n = tile * 16 + kb * 4 + fq;
            atomicAdd(&imp[tl[rb] * 64 + n], 2.f * (P[0] + P[1] + P[2]) + P[3]);
            if (n + 1 < 64) atomicAdd(&imp[tl[rb] * 64 + n + 1], P[3]);
          }
        }
    };
    attn_run<64, 2, false, false>(ctiles, ctiles, qf, kpc, vpc, NoCum{}, sfc, ffc, clc, postc, m, l, o, smem, curslot);
    ACCUM_BRANCH(0, true)
  }
  __syncthreads();
  {
    const int tli = wid * 8 + (lane >> 3), sub = lane & 7;
    const int curb = (t0 + tli) >> 6;
    float v[8];
#pragma unroll
    for (int i = 0; i < 8; ++i) {
      int n = sub * 8 + i;
      float x = imp[tli * 64 + n];
      bool cand = (n <= curb) && (n != 0) && (n != curb) && (n != curb - 1);
      v[i] = cand ? x : -1.f;
    }
    u64 mask = 1ull | (1ull << curb) | (1ull << (curb > 0 ? curb - 1 : 0));
#pragma unroll 1
    for (int round = 0; round < 5; ++round) {
      float bv = v[0]; int bi = 0;
#pragma unroll
      for (int i = 1; i < 8; ++i) if (v[i] > bv) { bv = v[i]; bi = i; }
      int bn = sub * 8 + bi;
#pragma unroll
      for (int off = 1; off < 8; off <<= 1) {
        float ov = __shfl_xor(bv, off); int on = __shfl_xor(bn, off);
        if (ov > bv || (ov == bv && on < bn)) { bv = ov; bn = on; }
      }
      if (bv >= 0.f) mask |= 1ull << bn;
      const bool owner = (bn >> 3) == sub;
#pragma unroll
      for (int i = 0; i < 8; ++i) v[i] = (owner && i == (bn & 7)) ? -2.f : v[i];
    }
    if (curb < 8) mask = (2ull << curb) - 1;
    if (sub == 0) selm[tli] = mask;
  }
  __syncthreads();
  {
    u64 msk[2] = {selm[tl[0]], selm[tl[1]]};
    u64 U = 0;
    for (int i = 0; i < 32; ++i) U |= selm[i];
    const bf16* kb_ = proj + (long)b * 4096 * PROJ_LD + 768 + g * 64;
    const bf16* vst = (const bf16*)(ws + OFF_VST) + (long)(b * 2 + g) * 64 * 4096;
    auto kps = [&](int tile, int row) { return kb_ + (long)(tile * 64 + row) * PROJ_LD; };
    auto vps = [&](int tile, int d) { return vst + (long)d * 4096 + tile * 64; };
    auto sfs = [&](int rb, int kb, int j, int tile, float s) {
      int dist = t[rb] - (tile * 64 + kb * 16 + fq * 4 + j);
      int di = min(max(dist, 0), 127);
      bool ok = dist >= 0 && ((msk[rb] >> tile) & 1);
      return ok ? fmaf(s, sc, lutr[di]) : -INFINITY;
    };
    u64 orm[2], andm[2];
#pragma unroll
    for (int rb = 0; rb < 2; ++rb) {
      unsigned olo = (unsigned)msk[rb], ohi = (unsigned)(msk[rb] >> 32), alo = olo, ahi = ohi;
      olo |= dppu<DPP_X1>(olo); ohi |= dppu<DPP_X1>(ohi); alo &= dppu<DPP_X1>(alo); ahi &= dppu<DPP_X1>(ahi);
      olo |= dppu<DPP_X2>(olo); ohi |= dppu<DPP_X2>(ohi); alo &= dppu<DPP_X2>(alo); ahi &= dppu<DPP_X2>(ahi);
      olo |= dppu<DPP_HM>(olo); ohi |= dppu<DPP_HM>(ohi); alo &= dppu<DPP_HM>(alo); ahi &= dppu<DPP_HM>(ahi);
      olo |= dppu<DPP_M>(olo); ohi |= dppu<DPP_M>(ohi); alo &= dppu<DPP_M>(alo); ahi &= dppu<DPP_M>(ahi);
      orm[rb] = ((u64)(unsigned)__builtin_amdgcn_readfirstlane((int)ohi) << 32) | (unsigned)__builtin_amdgcn_readfirstlane((int)olo);
      andm[rb] = ((u64)(unsigned)__builtin_amdgcn_readfirstlane((int)ahi) << 32) | (unsigned)__builtin_amdgcn_readfirstlane((int)alo);
    }
    const float cbf = lutr[127];
    const u64 msk0 = msk[0], msk1 = msk[1];
    auto ffs = make_fast(sc, [=](int rb, int tile) { return (((rb ? msk1 : msk0) >> tile) & 1) ? cbf : -INFINITY; });
    auto cls = [&](int rb, int tile) {
      const u64 om = rb ? orm[1] : orm[0], am = rb ? andm[1] : andm[0];
      if (!((om >> tile) & 1)) return 0;
      return ((rb ? tmin1 : tmin0) - (tile * 64 + 63) >= 113) ? 2 : 1;
    };
    RESET_STATE
    attn_run<64, 0, true, false>(U, orm[0] | orm[1], qf, kps, vps, NoCum{}, sfs, ffs, cls, NoPost{}, m, l, o, smem, curslot);
    ACCUM_BRANCH(1, false)
  }
  {
    const int lo = (t0 >= 511 ? t0 - 511 : 0) >> 6, hi = (t0 + 31) >> 6;
    const u64 wt = ((hi == 63) ? ~0ull : ((1ull << (hi + 1)) - 1)) & ~((1ull << lo) - 1);
    const bf16* kb_ = proj + (long)b * 4096 * PROJ_LD + 1024 + g * 64;
    const bf16* vwt = (const bf16*)(ws + OFF_VWT) + (long)(b * 2 + g) * 64 * 4096;
    auto kpw = [&](int tile, int row) { return kb_ + (long)(tile * 64 + row) * PROJ_LD; };
    auto vpw = [&](int tile, int d) { return vwt + (long)d * 4096 + tile * 64; };
    auto sfw = [&](int rb, int kb, int j, int tile, float s) {
      int dist = t[rb] - (tile * 64 + kb * 16 + fq * 4 + j);
      int di = min(max(dist, 0), 127);
      bool ok = dist >= 0 && dist < 512;
      return ok ? fmaf(s, sc, lutr[di]) : -INFINITY;
    };
    const float cbf = lutr[127];
    auto ffw = make_fast(sc, [=](int rb, int tile) { return cbf; });
    auto clw = [&](int rb, int tile) {
      const int tm = rb ? tmin1 : tmin0;
      return (tm - (tile * 64 + 63) >= 113 && tm + 3 - tile * 64 < 512) ? 2 : 1;
    };
    RESET_STATE
    attn_run<64, 0, false, false>(wt, wt, qf, kpw, vpw, NoCum{}, sfw, ffw, clw, NoPost{}, m, l, o, smem, curslot);
    ACCUM_BRANCH(2, false)
  }
#undef RESET_STATE
#undef ACCUM_BRANCH
  bf16* ocat = (bf16*)(ws + OFF_OCAT);
#pragma unroll
  for (int rb = 0; rb < 2; ++rb)
#pragma unroll
    for (int db = 0; db < 4; ++db) {
      const f32x4 tv = totl[(rb * 4 + db) * 256];
      u32x2 v; v[0] = pack2(tv[0], tv[1]); v[1] = pack2(tv[2], tv[3]);
      *(u32x2*)(ocat + ((long)b * 4096 + t[rb]) * 1024 + h * 64 + db * 16 + fq * 4) = v;
    }
}

template <int KIND>
DEVI void mha_item(const Params& p, int b, int h, int t0, char* smem) {
  constexpr int DK = KIND == 0 ? 96 : 64;
  char* ws = opaque_ptr(p.ws);
  const int tid = opaque_tid(), lane = tid & 63, wid = tid >> 6, fr = lane & 15, fq = lane >> 4;
  int t[2]; long tok[2];
#pragma unroll
  for (int rb = 0; rb < 2; ++rb) { t[rb] = t0 + wid * 32 + rb * 16 + fr; tok[rb] = (long)b * 4096 + t[rb]; }
  const bf16* qb; long qld; const bf16* kbase; long kld; const bf16* vbase; long vld;
  if (KIND == 0) {
    qb = (const bf16*)(ws + OFF_QMLA) + h * 96; qld = 384;
    kbase = (const bf16*)(ws + OFF_KMLA) + (long)b * 4096 * 384 + h * 96; kld = 384;
    vbase = (const bf16*)(ws + OFF_VMT) + (long)(b * 4 + h) * 64 * 4096; vld = 4096;
  } else if (KIND == 1) {
    qb = (const bf16*)(ws + OFF_PROJ) + 1792 + h * 64; qld = PROJ_LD;
    kbase = (const bf16*)(ws + OFF_PROJ) + (long)b * 4096 * PROJ_LD + 2048 + h * 64; kld = PROJ_LD;
    vbase = (const bf16*)(ws + OFF_VFT) + (long)(b * 4 + h) * 64 * 4096; vld = 4096;
  } else {
    qb = (const bf16*)(ws + OFF_XQ) + h * 64; qld = 256;
    kbase = (const bf16*)(ws + OFF_KXA) + (long)b * 256 * 256 + h * 64; kld = 256;
    vbase = (const bf16*)(ws + OFF_VXA) + (long)(b * 4 + h) * 64 * 256; vld = 256;
  }
  bf16x8 qf[2][DK / 32];
#pragma unroll
  for (int rb = 0; rb < 2; ++rb)
#pragma unroll
    for (int ks = 0; ks < DK / 32; ++ks) qf[rb][ks] = *(const bf16x8*)(qb + tok[rb] * qld + ks * 32 + fq * 8);
  u64 tiles, wtiles;
  if (KIND == 2) { tiles = 0xF; wtiles = 0xF; }
  else {
    int nt = (t0 >> 6) + 2; tiles = nt >= 64 ? ~0ull : ((1ull << nt) - 1);
    int nw = ((t0 + wid * 32 + 31) >> 6) + 1; wtiles = nw >= 64 ? ~0ull : ((1ull << nw) - 1);
  }
  const float sc = (KIND == 0 ? 0.10206207261596575f : 0.125f) * LOG2E;
  const float* cum = (const float*)(ws + OFF_CUM) + (long)(b * 4 + h) * 4096;
  float cq[2] = {0.f, 0.f};
  const char* curslot = smem;
  if (KIND == 1) { cq[0] = cum[t[0]]; cq[1] = cum[t[1]]; }
  auto kpf = [&](int tile, int row) { return kbase + (long)(tile * 64 + row) * kld; };
  auto vpf = [&](int tile, int d) { return vbase + (long)d * vld + tile * 64; };
  auto cpf = [&](int tile) { return cum + tile * 64; };
  auto sf = [&](int rb, int kb, int j, int tile, float s) {
    if (KIND == 2) return s * sc;
    int kpos = tile * 64 + kb * 16 + fq * 4 + j;
    float v = s * sc;
    if (KIND == 1) v += cq[rb] - *(const float*)(curslot + RingGeo<64>::ACO + (kb * 16 + fq * 4 + j) * 4);
    return kpos <= t[rb] ? v : -INFINITY;
  };
  float m[2] = {-1e30f, -1e30f}, l[2] = {0.f, 0.f};
  f32x4 o[5][2];
#pragma unroll
  for (int db = 0; db < 5; ++db) { o[db][0] = f32x4{0.f, 0.f, 0.f, 0.f}; o[db][1] = f32x4{0.f, 0.f, 0.f, 0.f}; }
  __syncthreads();
  const int uw = __builtin_amdgcn_readfirstlane(wid);
  const float cq0 = cq[0], cq1 = cq[1];
  const char* const* cslot = &curslot;
  auto ffm = make_fast_vec(sc, [=](int rb, int tile) { return KIND == 1 ? (rb ? cq1 : cq0) : 0.f; },
                           [=](int kb) { f32x4 z = f32x4{0.f, 0.f, 0.f, 0.f}; return KIND == 1 ? (z - *(const f32x4*)(*cslot + RingGeo<64>::ACO + (kb * 16 + fq * 4) * 4)) : z; });
  auto ffx = make_fast(sc, [=](int rb, int tile) { return 0.f; });
  auto clm = [&](int rb, int tile) { return (KIND == 2 || tile * 64 + 63 <= t0 + uw * 32 + rb * 16) ? 2 : 1; };
  if (KIND == 1) attn_run<DK, 0, false, true>(tiles, wtiles, qf, kpf, vpf, cpf, sf, ffm, clm, NoPost{}, m, l, o, smem, curslot);
  else attn_run<DK, 0, false, false>(tiles, wtiles, qf, kpf, vpf, cpf, sf, ffx, clm, NoPost{}, m, l, o, smem, curslot);
  bf16* dst; long dld;
  if (KIND == 0) { dst = (bf16*)(ws + OFF_OCAT) + 512 + h * 64; dld = 1024; }
  else if (KIND == 1) { dst = (bf16*)(ws + OFF_OCAT) + 768 + h * 64; dld = 1024; }
  else { dst = (bf16*)(ws + OFF_OXA) + h * 64; dld = 256; }
#pragma unroll
  for (int rb = 0; rb < 2; ++rb) {
    float ls = o[4][rb][0];
    float f = ls > 0.f ? 1.f / ls : 0.f;
#pragma unroll
    for (int db = 0; db < 4; ++db) {
      u32x2 v; v[0] = pack2(o[db][rb][0] * f, o[db][rb][1] * f); v[1] = pack2(o[db][rb][2] * f, o[db][rb][3] * f);
      *(u32x2*)(dst + tok[rb] * dld + db * 16 + fq * 4) = v;
    }
  }
}

DEVI int next_item(unsigned* ctr, char* smem) {
  __syncthreads();
  if (opaque_tid() == 0) *(int*)(smem + AITEM) = (int)atomicAdd(ctr, 1u);
  __syncthreads();
  return *(volatile int*)(smem + AITEM);
}

DEVI void phase_attn(const Params& p, int L, char* smem, int rep) {
  unsigned* ctr = (unsigned*)(p.ws + OFF_CNT) + L + 8 * rep;
  for (;;) {
    int it = next_item(ctr, smem);
    if (it >= 4096) break;
    int level = it >> 7, w = it & 127; int q128 = 31 - level;
    if (w < 64) { int sub = w & 3, bg = w >> 2; nsa_item(p, bg >> 1, bg & 1, q128 * 128 + sub * 32, smem); }
    else if (w < 96) { int bh = w - 64; mha_item<0>(p, bh >> 2, bh & 3, q128 * 128, smem); }
    else { int bh = w - 96; mha_item<1>(p, bh >> 2, bh & 3, q128 * 128, smem); }
  }
}

DEVI void phase_xattn(const Params& p, char* smem) {
  for (int it = blockIdx.x; it < 1024; it += gridDim.x) {
    int bh = it & 31, q = it >> 5;
    mha_item<2>(p, bh >> 2, bh & 3, q * 128, smem);
  }
}

DEVI void phase_merge(const Params& p, char* smem) {
  char* ws = opaque_ptr(p.ws);
  const bf16* xb = (const bf16*)(ws + OFF_XB);
  const bf16* ocat = (const bf16*)(ws + OFF_OCAT);
  const bf16* wg = (const bf16*)(ws + OFF_WG);
  u32x4* brg = (u32x4*)(ws + OFF_QMLA) + (size_t)blockIdx.x * 8 * 256 + opaque_tid();
  int t = blockIdx.x;
  if (t < 256 * 8) {
    int mt, nt; tile_swz(t, 256, 8, mt, nt);
    __syncthreads();
    gemm_prefetch0<4>(ocat, RowLinear{1024}, (const bf16*)(ws + OFF_WBN), 512, mt * 128, nt * 128, smem);
  }
  for (; t < 256 * 8; t += gridDim.x) {
    int mt, nt; tile_swz(t, 256, 8, mt, nt);
    f32x4 res[4][4]; zero_acc(res);
#pragma unroll 1
    for (int i = 0; i < 3; ++i) {
      const bf16* wb = (const bf16*)(ws + (i == 0 ? OFF_WBN : (i == 1 ? OFF_WBM : OFF_WBF)));
      const int kk = i == 0 ? 512 : 256;
      const int ko = i == 0 ? 0 : (i == 1 ? 512 : 768);
      f32x4 acc[4][4]; zero_acc(acc);
      gemm_mainloop_g<4, true, RowLinear, true>(acc, ocat + ko, RowLinear{1024}, 64, wb, kk, kk, mt * 128, nt * 128, smem);
      gemm_prefetch0<4>(xb, RowLinear{1024}, wg + (long)i * 1024 * 1024, 1024, mt * 128, nt * 128, smem);
#pragma unroll
      for (int m = 0; m < 4; ++m)
#pragma unroll
        for (int n = 0; n < 4; n += 2)
          brg[(m * 2 + (n >> 1)) * 256] = u32x4{pack2(acc[m][n][0], acc[m][n][1]), pack2(acc[m][n][2], acc[m][n][3]),
                                                pack2(acc[m][n + 1][0], acc[m][n + 1][1]), pack2(acc[m][n + 1][2], acc[m][n + 1][3])};
      zero_acc(acc);
      gemm_mainloop_g<4, true, RowLinear, true>(acc, xb, RowLinear{1024}, 64, wg + (long)i * 1024 * 1024, 1024, 1024, mt * 128, nt * 128, smem);
      if (i < 2) {
        const bf16* wb2 = (const bf16*)(ws + (i == 0 ? OFF_WBM : OFF_WBF));
        gemm_prefetch0<4>(ocat + (i == 0 ? 512 : 768), RowLinear{1024}, wb2, 256, mt * 128, nt * 128, smem);
      } else if (t + (int)gridDim.x < 256 * 8) {
        int mt2, nt2; tile_swz(t + gridDim.x, 256, 8, mt2, nt2);
        gemm_prefetch0<4>(ocat, RowLinear{1024}, (const bf16*)(ws + OFF_WBN), 512, mt2 * 128, nt2 * 128, smem);
      }
#pragma unroll
      for (int m = 0; m < 4; ++m)
#pragma unroll
        for (int n = 0; n < 4; ++n) {
          const u32x4 bq = brg[(m * 2 + (n >> 1)) * 256];
          const unsigned b0 = bq[(n & 1) * 2], b1 = bq[(n & 1) * 2 + 1];
          res[m][n][0] += sigmoidf(acc[m][n][0]) * bf2f(b0 & 0xffffu);
          res[m][n][1] += sigmoidf(acc[m][n][1]) * __uint_as_float(b0 & 0xffff0000u);
          res[m][n][2] += sigmoidf(acc[m][n][2]) * bf2f(b1 & 0xffffu);
          res[m][n][3] += sigmoidf(acc[m][n][3]) * __uint_as_float(b1 & 0xffff0000u);
        }
    }
    store_rm_sw(res, (bf16*)(ws + OFF_MERGED), 1024, mt * 128, nt * 128);
  }
}

enum { EPI_RESID = 0, EPI_RM = 1, EPI_RELU2 = 2 };
template <int EPI>
DEVI void phase_gemm(const Params& p, const bf16* A, int lda, const bf16* Bt, int K, int NT, bf16* dst, int ldd, char* smem, bool nostore = false,
                     const float* lng = nullptr, const float* lnb = nullptr) {
  int t = blockIdx.x;
  if (t < 256 * NT) {
    int mt, nt; tile_swz(t, 256, NT, mt, nt);
    __syncthreads();
    gemm_prefetch0<4>(A, RowLinear{lda}, Bt, K, mt * 128, nt * 128, smem, KROT ? k_rot(mt, nt, K >> 6) : 0);
  }
  for (; t < 256 * NT; t += gridDim.x) {
    int mt, nt; tile_swz(t, 256, NT, mt, nt);
    f32x4 acc[4][4]; zero_acc(acc);
    gemm_mainloop_g<4, true, RowLinear, true, DEEP_FRAG != 0>(acc, A, RowLinear{lda}, 64, Bt, K, K, mt * 128, nt * 128, smem, KROT ? k_rot(mt, nt, K >> 6) : 0);
    if (t + (int)gridDim.x < 256 * NT) {
      int mt2, nt2; tile_swz(t + gridDim.x, 256, NT, mt2, nt2);
      gemm_prefetch0<4>(A, RowLinear{lda}, Bt, K, mt2 * 128, nt2 * 128, smem, KROT ? k_rot(mt2, nt2, K >> 6) : 0);
    }
    if (EPI == EPI_RESID) {
      const int tid = opaque_tid(), lane = tid & 63, wid = tid >> 6, wr = wid >> 1, wc = wid & 1, fr = lane & 15, fq = lane >> 4;
      float* x = p.out;
      const float* stats = (const float*)(p.ws + OFF_STATS);
      const int cb0 = nt * 128 + wc * 64 + fq * 4;
      f32x4 gv[4], bv[4];
      if (lng) {
#pragma unroll
        for (int n = 0; n < 4; ++n) { gv[n] = *(const f32x4*)(lng + cb0 + n * 16); bv[n] = *(const f32x4*)(lnb + cb0 + n * 16); }
      }
#pragma unroll
      for (int m = 0; m < 4; ++m) {
        const int row = mt * 128 + wr * 64 + m * 16 + fr;
        float* rp = x + (long)row * 1024 + cb0;
        float mu = 0.f, rstd = 1.f;
        if (lng) { mu = stats[row * 2]; rstd = stats[row * 2 + 1]; }
        f32x4 v[4];
#pragma unroll
        for (int n = 0; n < 4; ++n) v[n] = *(const f32x4*)(rp + n * 16);
#pragma unroll
        for (int n = 0; n < 4; ++n) {
          f32x4 xv = v[n];
          if (lng) xv = (xv - mu) * rstd * gv[n] + bv[n];
          *(f32x4*)(rp + n * 16) = xv * DN_ALPHA + acc[m][n];
        }
      }
    } else if (EPI == EPI_RELU2) {
#pragma unroll
      for (int m = 0; m < 4; ++m)
#pragma unroll
        for (int n = 0; n < 4; ++n)
#pragma unroll
          for (int j = 0; j < 4; ++j) { float v = fmaxf(acc[m][n][j], 0.f); acc[m][n][j] = v * v; }
      if (!nostore || acc[0][0][0] == 123.456f) store_rm_sw(acc, dst, ldd, mt * 128, nt * 128);
    } else {
      store_rm_sw(acc, dst, ldd, mt * 128, nt * 128);
    }
  }
}

DEVI void phase_ln(const Params& p, int L, int which) {
  const int lane = opaque_tid() & 63, wid = opaque_tid() >> 6;
  const int gw = blockIdx.x * 4 + wid, nw = gridDim.x * 4;
  const float* g = p.in[22] + (L * 3 + which) * 1024;
  const float* bb = p.in[23] + (L * 3 + which) * 1024;
  char* ws = opaque_ptr(p.ws);
  bf16* xb = (bf16*)(ws + OFF_XB);
  float* stats = (float*)(ws + OFF_STATS);
  const bool final_out = (L == 3 && which == 2);
  const f32x4 g0 = *(const f32x4*)(g + lane * 4), g1 = *(const f32x4*)(g + 256 + lane * 4), g2 = *(const f32x4*)(g + 512 + lane * 4), g3 = *(const f32x4*)(g + 768 + lane * 4);
  const f32x4 b0 = *(const f32x4*)(bb + lane * 4), b1 = *(const f32x4*)(bb + 256 + lane * 4), b2 = *(const f32x4*)(bb + 512 + lane * 4), b3 = *(const f32x4*)(bb + 768 + lane * 4);
  for (int row = gw; row < T_TOK; row += nw) {
    float* xr = p.out + (long)row * 1024;
    f32x4 v0 = *(const f32x4*)(xr + lane * 4), v1 = *(const f32x4*)(xr + 256 + lane * 4);
    f32x4 v2 = *(const f32x4*)(xr + 512 + lane * 4), v3 = *(const f32x4*)(xr + 768 + lane * 4);
    f32x4 sv = v0 + v1 + v2 + v3;
    float s = sv[0] + sv[1] + sv[2] + sv[3];
    s = wave_sum(s);
    const float mu = s * (1.f / 1024.f);
    v0 -= mu; v1 -= mu; v2 -= mu; v3 -= mu;
    f32x4 qv = v0 * v0 + v1 * v1 + v2 * v2 + v3 * v3;
    float q = qv[0] + qv[1] + qv[2] + qv[3];
    q = wave_sum(q);
    const float rstd = rsqrtf(q * (1.f / 1024.f) + 1e-5f);
    if (lane == 0) { stats[row * 2] = mu; stats[row * 2 + 1] = rstd; }
#define LN_OUT(V, GG, BB, I)                                                                           \
    {                                                                                                  \
      f32x4 o = V * rstd * GG + BB;                                                                    \
      if (final_out) *(f32x4*)(xr + I * 256 + lane * 4) = o;                                           \
      *(u32x2*)(xb + (long)row * 1024 + I * 256 + lane * 4) = u32x2{pack2(o[0], o[1]), pack2(o[2], o[3])}; \
    }
    LN_OUT(v0, g0, b0, 0) LN_OUT(v1, g1, b1, 1) LN_OUT(v2, g2, b2, 2) LN_OUT(v3, g3, b3, 3)
#undef LN_OUT
  }
}

__global__ void __launch_bounds__(256, 2) mega(Params p) {
  __shared__ __attribute__((aligned(16))) char smem[SMEM_BYTES];
  cg::grid_group grid = cg::this_grid();
  char* ws = opaque_ptr(p.ws);
  volatile LAS unsigned* xst = (volatile LAS unsigned*)(smem + XBST);
  if (opaque_tid() < 4) xst[opaque_tid()] = 0u;
  __syncthreads();
  XcdBarrier xb = xcd_barrier_post((unsigned*)(ws + OFF_BAR), xst);
#pragma unroll 1
  for (int L = -1; L < 4; ++L) {
    char* ws = opaque_ptr(p.ws);
    if (L >= 0) {
    for (int r = 0; r < REP_PROJ; ++r) { phase_proj(p, L, smem);
    xcd_barrier(xb); }
    for (int r = 0; r < REP_DERIVED; ++r) { phase_derived(p, L, smem);
    xcd_barrier(xb); }
    for (int r = 0; r < REP_ATTN; ++r) { phase_attn(p, L, smem, r);
    xcd_barrier(xb); }
    for (int r = 0; r < REP_MERGE; ++r) { phase_merge(p, smem);
    xcd_barrier(xb); }
    phase_gemm<EPI_RESID>(p, (const bf16*)(ws + OFF_MERGED), 1024, (const bf16*)(ws + OFF_WOUT), 1024, 8, nullptr, 0, smem, false,
                          L ? p.in[22] + ((L - 1) * 3 + 2) * 1024 : nullptr, L ? p.in[23] + ((L - 1) * 3 + 2) * 1024 : nullptr);
    xcd_barrier(xb);
    phase_ln(p, L, 0);
    xcd_barrier(xb);
    phase_gemm<EPI_RM>(p, (const bf16*)(ws + OFF_XB), 1024, (const bf16*)(ws + OFF_WXQ), 1024, 2, (bf16*)(ws + OFF_XQ), 256, smem);
    xcd_barrier(xb);
    for (int r = 0; r < REP_XA; ++r) { phase_xattn(p, smem);
    xcd_barrier(xb); }
    phase_gemm<EPI_RESID>(p, (const bf16*)(ws + OFF_OXA), 256, (const bf16*)(ws + OFF_WXO), 256, 8, nullptr, 0, smem, false,
                          p.in[22] + (L * 3 + 0) * 1024, p.in[23] + (L * 3 + 0) * 1024);
    xcd_barrier(xb);
    phase_ln(p, L, 1);
    xcd_barrier(xb);
    for (int r = 0; r < REP_UP; ++r) { phase_gemm<EPI_RELU2>(p, (const bf16*)(ws + OFF_XB), 1024, (const bf16*)(ws + OFF_WUP), 1024, 32, (bf16*)(ws + OFF_HID), 4096, smem, (PROBE_NOSTORE && r > 0));
    xcd_barrier(xb); }
    phase_gemm<EPI_RESID>(p, (const bf16*)(ws + OFF_HID), 4096, (const bf16*)(ws + OFF_WDN), 4096, 8, nullptr, 0, smem, false,
                          p.in[22] + (L * 3 + 1) * 1024, p.in[23] + (L * 3 + 1) * 1024);
    xcd_barrier(xb);
    phase_ln(p, L, 2);
    }
    if (L < 3) {
      phase_prep(p, L + 1, smem);
      if (L < 0) grid.sync();
      else xcd_barrier(xb);
    }
  }
}

extern "C" void kernel_launch(void* const* d_in, const int* in_sizes, int n_in, void* d_out, int out_size,
                              void* d_ws, size_t ws_size, hipStream_t stream) {
  static int grid_blocks = 0;
  if (!grid_blocks) {
    int dev = 0, cus = 0, per_cu = 0;
    (void)hipGetDevice(&dev);
    (void)hipDeviceGetAttribute(&cus, hipDeviceAttributeMultiprocessorCount, dev);
    (void)hipOccupancyMaxActiveBlocksPerMultiprocessor(&per_cu, mega, 256, 0);
    if (per_cu > 2) per_cu = 2;
    if (per_cu < 1) per_cu = 1;
    grid_blocks = cus * per_cu;
    grid_blocks &= ~7;
    if (grid_blocks > 512) grid_blocks = 512;
  }
  if (ws_size < WS_TOTAL) fprintf(stderr, "workspace too small: %zu < %zu\n", ws_size, (size_t)WS_TOTAL);
  Params p{};
  for (int i = 0; i < 24; ++i) p.in[i] = (const float*)d_in[i];
  p.out = (float*)d_out;
  p.ws = (char*)d_ws;
  (void)hipMemsetAsync((char*)d_ws + OFF_BAR, 0, 16384, stream);
  void* args[] = {&p};
  hipError_t e = hipLaunchCooperativeKernel((void*)mega, dim3(grid_blocks), dim3(256), args, 0, stream);
  if (e != hipSuccess) fprintf(stderr, "cooperative launch failed: %s (grid %d)\n", hipGetErrorString(e), grid_blocks);
}
```
